# Optimizing an MI355X kernel written in HIP

```python
import math
import jax, jax.numpy as jnp
from jax import lax
import numpy as np

D_MODEL = 1024
BATCH = 2
SEQ = 16384
DEPTH = 4

GRID_W = 64
CTX_LEN = 256
F32 = jnp.float32
EPS = 1e-6

HY_WIDTH = 256
POOL_WINDOWS = (2, 4, 8, 16)
POOL_WIDTH = 256
POOL_GROUP = POOL_WIDTH // len(POOL_WINDOWS)
MLA_HEADS = 8
QK_NOPE = 64
QK_ROPE = 32
V_DIM = 64
Q_LORA = 384
KV_LORA = 256
MLA_WIDTH = MLA_HEADS * V_DIM
D_MIX = HY_WIDTH + POOL_WIDTH + MLA_WIDTH
IN_WIDTH = 3 * HY_WIDTH + POOL_WIDTH + Q_LORA + KV_LORA + QK_ROPE
IN_SPLITS = (3 * HY_WIDTH,
             3 * HY_WIDTH + POOL_WIDTH,
             3 * HY_WIDTH + POOL_WIDTH + Q_LORA,
             3 * HY_WIDTH + POOL_WIDTH + Q_LORA + KV_LORA)
SM_SCALE = (QK_NOPE + QK_ROPE) ** -0.5
ROPE_THETA = 10000.0
Q_BLOCK = 128

SHORT_CONV = 3
FILT_EMB = 33
FILT_BANDS = (FILT_EMB - 1) // 2
FILT_HIDDEN = 64
DECAY_TARGET = 1e-2
FAST_DECAY_PCT = 0.3
SLOW_DECAY_PCT = 1.5

D_FF = 2816
N_EXPERTS = 8
TOP_K = 2
EXPERT_FF = 2816
N_DENSE = (DEPTH + 1) // 2
N_MOE = DEPTH // 2

kernel_name = 'hybrid_hyena_pool_mla_moe_dit'


def rmsnorm(x, g):
    x32 = x.astype(F32)
    y = x32 * lax.rsqrt(jnp.mean(x32 * x32, axis=-1, keepdims=True) + EPS)
    return (y * g.astype(F32)).astype(x.dtype)


def modulate(h, shift, scale):
    return h * (1 + scale) + shift


def short_conv(u, w, b):
    L = u.shape[1]
    p = SHORT_CONV // 2
    up = jnp.pad(u, ((0, 0), (p, p), (0, 0)))
    out = up[:, 0:L] * w[0]
    for j in range(1, SHORT_CONV):
        out = out + up[:, j:j + L] * w[j]
    return out + b


def implicit_filter(L, w1, b1, freq1, w2, b2, freq2, w3):
    pos = jnp.arange(L, dtype=F32)
    t = (pos / max(L - 1, 1))[:, None]
    w = 2.0 * math.pi * pos[:, None] / L
    f = jnp.linspace(1e-4, FILT_BANDS - 1, FILT_BANDS, dtype=F32)[None, :]
    feat = jnp.concatenate([t, jnp.cos(f * w), -jnp.sin(f * w)], axis=-1)
    hdn = jnp.sin(freq1.astype(F32) * (feat @ w1.astype(F32) + b1.astype(F32)))
    hdn = jnp.sin(freq2.astype(F32) * (hdn @ w2.astype(F32) + b2.astype(F32)))
    h = hdn @ w3.astype(F32)
    max_decay = math.log(DECAY_TARGET) / FAST_DECAY_PCT
    min_decay = math.log(DECAY_TARGET) / SLOW_DECAY_PCT
    deltas = jnp.linspace(min_decay, max_decay, HY_WIDTH, dtype=F32)
    decay = jnp.exp(-t * jnp.abs(deltas))
    h = h * jnp.concatenate([decay, decay], axis=-1)
    h_fwd, h_bwd = h[:, :HY_WIDTH], h[:, HY_WIDTH:]
    filt2 = jnp.concatenate([h_fwd, jnp.zeros((1, HY_WIDTH), F32), h_bwd[1:][::-1]], axis=0)
    return filt2 / jnp.sum(jnp.abs(filt2), axis=0, keepdims=True)


def fft_conv(z, filt2):
    L = z.shape[1]
    zf = jnp.fft.rfft(z, n=2 * L, axis=1)
    hf = jnp.fft.rfft(filt2, n=2 * L, axis=0)
    return jnp.fft.irfft(zf * hf[None], n=2 * L, axis=1)[:, :L]


def hyena_mix(u, sw, sb, filt, bias):
    uc = short_conv(u, sw, sb)
    x0, x1, v = jnp.split(uc, 3, axis=-1)
    z = (x1 * v).astype(F32)
    h = implicit_filter(u.shape[1], *filt)
    y = fft_conv(z, h) + bias.astype(F32) * z
    return (x0.astype(F32) * y).astype(u.dtype)


def pool_mix(p, pool_w, pool_scale):
    B, L, _ = p.shape
    p32 = p.astype(F32)
    cs = jnp.concatenate([jnp.zeros((B, 1, POOL_WIDTH), F32), jnp.cumsum(p32, axis=1)], axis=1)
    t = jnp.arange(L)
    parts = []
    for g, win in enumerate(POOL_WINDOWS):
        lo = jnp.clip(t - win // 2, 0, L)
        hi = jnp.clip(t + win // 2, 0, L)
        sl = slice(g * POOL_GROUP, (g + 1) * POOL_GROUP)
        cg = cs[..., sl]
        mean = (cg[:, hi] - cg[:, lo]) / (hi - lo).astype(F32)[None, :, None]
        parts.append(mean - p32[..., sl])
    d = jnp.stack(parts, axis=2)
    y = jnp.einsum('blgc,gcd->blgd', d, pool_w.astype(F32)).reshape(B, L, POOL_WIDTH)
    return (y * pool_scale.astype(F32)).astype(p.dtype)


def axial_rope(rows):
    n_freq = QK_ROPE // 4
    inv_freq = 1.0 / (ROPE_THETA ** (jnp.arange(n_freq, dtype=F32) / n_freq))
    row = jnp.repeat(jnp.arange(rows, dtype=F32), GRID_W)
    col = jnp.tile(jnp.arange(GRID_W, dtype=F32), rows)
    ang = jnp.concatenate([row[:, None] * inv_freq, col[:, None] * inv_freq], axis=-1)
    return jnp.cos(ang), jnp.sin(ang)


def apply_rope(x, cos, sin):
    x32 = x.astype(F32)
    half = x.shape[-1] // 2
    x1, x2 = x32[..., :half], x32[..., half:]
    return jnp.concatenate([x1 * cos - x2 * sin, x1 * sin + x2 * cos], axis=-1).astype(x.dtype)


def mla_q(cq, g, w_uq, rope):
    B, L, _ = cq.shape
    q = (rmsnorm(cq, g) @ w_uq).reshape(B, L, MLA_HEADS, QK_NOPE + QK_ROPE)
    q_nope, q_pe = q[..., :QK_NOPE], q[..., QK_NOPE:]
    if rope is not None:
        q_pe = apply_rope(q_pe, rope[0][:, None], rope[1][:, None])
    return jnp.concatenate([q_nope, q_pe], axis=-1)


def mla_kv(ckv, kpe, g, w_ukv, rope):
    B, L, _ = ckv.shape
    kv = (rmsnorm(ckv, g) @ w_ukv).reshape(B, L, MLA_HEADS, QK_NOPE + V_DIM)
    k_nope, v = kv[..., :QK_NOPE], kv[..., QK_NOPE:]
    if rope is not None:
        kpe = apply_rope(kpe, rope[0], rope[1])
    k_pe = jnp.broadcast_to(kpe[:, :, None, :], (B, L, MLA_HEADS, QK_ROPE))
    return jnp.concatenate([k_nope, k_pe], axis=-1), v


def attention(q, k, v):
    s = jnp.einsum('bqhd,bkhd->bhqk', q.astype(F32), k.astype(F32)) * SM_SCALE
    p = jax.nn.softmax(s, axis=-1)
    return jnp.einsum('bhqk,bkhd->bqhd', p, v.astype(F32)).astype(v.dtype)


def blocked_attention(q, k, v):
    B, L, H, Dq = q.shape
    nb = L // Q_BLOCK
    qb = q.reshape(B, nb, Q_BLOCK, H, Dq).swapaxes(0, 1)
    ob = lax.map(lambda qi: attention(qi, k, v), qb)
    return ob.swapaxes(0, 1).reshape(B, L, H, V_DIM)


def swiglu(h, wg, wu, wd):
    return (jax.nn.silu(h @ wg) * (h @ wu)) @ wd


def moe_swiglu(h, w_router, wg, wu, wd):
    logits = (h @ w_router).astype(F32)
    top_val, top_idx = lax.top_k(logits, TOP_K)
    gates = jax.nn.softmax(top_val, axis=-1)
    comb = jnp.sum(jax.nn.one_hot(top_idx, N_EXPERTS, dtype=F32) * gates[..., None], axis=-2)
    out = jnp.zeros(h.shape, F32)
    for e in range(N_EXPERTS):
        out = out + comb[..., e:e + 1] * swiglu(h, wg[e], wu[e], wd[e]).astype(F32)
    return out.astype(h.dtype)


def channel_mix(h, layer, ffn_wg, ffn_wu, ffn_wd, moe_router, moe_wg, moe_wu, moe_wd):
    i = layer // 2
    if layer % 2 == 0:
        return swiglu(h, ffn_wg[i], ffn_wu[i], ffn_wd[i])
    return moe_swiglu(h, moe_router[i], moe_wg[i], moe_wu[i], moe_wd[i])


def setup_inputs(seed: int = 0) -> dict:
    key = jax.random.key(seed)
    keys = iter(jax.random.split(key, 48))
    D = D_MODEL

    def normal(shape, scale=1.0):
        return jax.random.normal(next(keys), shape, F32) * scale

    def gain(shape):
        return 1.0 + normal(shape, 0.02)

    return {
        'x': normal((BATCH, SEQ, D)),
        'c': normal((BATCH, D)),
        'ctx': normal((BATCH, CTX_LEN, D)),
        'c_ctx': normal((D,)),
        'norm1_g': gain((DEPTH, D)),
        'norm2_g': gain((DEPTH, D)),
        'w_ada': normal((DEPTH, D, 6 * D), 0.5 * D ** -0.5),
        'b_ada': normal((DEPTH, 6 * D), 0.02),
        'w_in': normal((DEPTH, D, IN_WIDTH), D ** -0.5),
        'hy_short_w': normal((DEPTH, SHORT_CONV, 3 * HY_WIDTH), SHORT_CONV ** -0.5),
        'hy_short_b': normal((DEPTH, 3 * HY_WIDTH), 0.02),
        'filt_w1': normal((DEPTH, FILT_EMB, FILT_HIDDEN), FILT_EMB ** -0.5),
        'filt_b1': normal((DEPTH, FILT_HIDDEN), 0.02),
        'filt_freq1': gain((DEPTH, FILT_HIDDEN)),
        'filt_w2': normal((DEPTH, FILT_HIDDEN, FILT_HIDDEN), FILT_HIDDEN ** -0.5),
        'filt_b2': normal((DEPTH, FILT_HIDDEN), 0.02),
        'filt_freq2': gain((DEPTH, FILT_HIDDEN)),
        'filt_w3': normal((DEPTH, FILT_HIDDEN, 2 * HY_WIDTH), FILT_HIDDEN ** -0.5),
        'hy_bias': normal((DEPTH, HY_WIDTH), 0.5),
        'pool_w': normal((DEPTH, len(POOL_WINDOWS), POOL_GROUP, POOL_GROUP), POOL_GROUP ** -0.5),
        'pool_scale': gain((DEPTH, POOL_WIDTH)),
        'q_norm_g': gain((DEPTH, Q_LORA)),
        'w_uq': normal((DEPTH, Q_LORA, MLA_HEADS * (QK_NOPE + QK_ROPE)), Q_LORA ** -0.5),
        'kv_norm_g': gain((DEPTH, KV_LORA)),
        'w_ukv': normal((DEPTH, KV_LORA, MLA_HEADS * (QK_NOPE + V_DIM)), KV_LORA ** -0.5),
        'w_out': normal((DEPTH, D_MIX, D), D_MIX ** -0.5),
        'ffn_wg': normal((N_DENSE, D, D_FF), D ** -0.5),
        'ffn_wu': normal((N_DENSE, D, D_FF), D ** -0.5),
        'ffn_wd': normal((N_DENSE, D_FF, D), D_FF ** -0.5),
        'moe_router': normal((N_MOE, D, N_EXPERTS), D ** -0.5),
        'moe_wg': normal((N_MOE, N_EXPERTS, D, EXPERT_FF), D ** -0.5),
        'moe_wu': normal((N_MOE, N_EXPERTS, D, EXPERT_FF), D ** -0.5),
        'moe_wd': normal((N_MOE, N_EXPERTS, EXPERT_FF, D), EXPERT_FF ** -0.5),
        'final_g': gain((D,)),
    }


def reference(x, c, ctx, c_ctx, norm1_g, norm2_g, w_ada, b_ada, w_in, hy_short_w, hy_short_b,
              filt_w1, filt_b1, filt_freq1, filt_w2, filt_b2, filt_freq2, filt_w3, hy_bias,
              pool_w, pool_scale, q_norm_g, w_uq, kv_norm_g, w_ukv, w_out,
              ffn_wg, ffn_wu, ffn_wd, moe_router, moe_wg, moe_wu, moe_wd, final_g):
    B, L, _ = x.shape
    ROWS = L // GRID_W
    rope = axial_rope(ROWS)
    silu_c = jax.nn.silu(c)
    silu_ctx = jax.nn.silu(c_ctx)
    xl, xc = x, ctx
    for l in range(DEPTH):
        last = l == DEPTH - 1
        mod_l = jnp.split((silu_c @ w_ada[l] + b_ada[l])[:, None, :], 6, axis=-1)
        mod_c = jnp.split(silu_ctx @ w_ada[l] + b_ada[l], 6, axis=-1)
        filt = (filt_w1[l], filt_b1[l], filt_freq1[l], filt_w2[l], filt_b2[l], filt_freq2[l], filt_w3[l])

        def mix_heads(hy, pool, att):
            y_hy = hyena_mix(hy, hy_short_w[l], hy_short_b[l], filt, hy_bias[l])
            y_pool = pool_mix(pool, pool_w[l], pool_scale[l])
            y_att = att.reshape(att.shape[0], att.shape[1], MLA_WIDTH)
            return jnp.concatenate([y_hy, y_pool, y_att], axis=-1) @ w_out[l]

        hl = modulate(rmsnorm(xl, norm1_g[l]), mod_l[0], mod_l[1])
        hc = modulate(rmsnorm(xc, norm1_g[l]), mod_c[0], mod_c[1])
        hy_l, pool_l, cq_l, ckv_l, kpe_l = jnp.split(hl @ w_in[l], IN_SPLITS, axis=-1)
        hy_c, pool_c, cq_c, ckv_c, kpe_c = jnp.split(hc @ w_in[l], IN_SPLITS, axis=-1)
        k_c, v_c = mla_kv(ckv_c, kpe_c, kv_norm_g[l], w_ukv[l], None)
        k_l, v_l = mla_kv(ckv_l, kpe_l, kv_norm_g[l], w_ukv[l], rope)
        q_l = mla_q(cq_l, q_norm_g[l], w_uq[l], rope)
        att_l = blocked_attention(q_l, jnp.concatenate([k_c, k_l], axis=1),
                                  jnp.concatenate([v_c, v_l], axis=1))
        xl = xl + mod_l[2] * mix_heads(hy_l, pool_l, att_l)
        if not last:
            att_c = attention(mla_q(cq_c, q_norm_g[l], w_uq[l], None), k_c, v_c)
            xc = xc + mod_c[2] * mix_heads(hy_c, pool_c, att_c)
            hc = modulate(rmsnorm(xc, norm2_g[l]), mod_c[3], mod_c[4])
            xc = xc + mod_c[5] * channel_mix(hc, l, ffn_wg, ffn_wu, ffn_wd, moe_router, moe_wg, moe_wu, moe_wd)
        hl = modulate(rmsnorm(xl, norm2_g[l]), mod_l[3], mod_l[4])
        xl = xl + mod_l[5] * channel_mix(hl, l, ffn_wg, ffn_wu, ffn_wd, moe_router, moe_wg, moe_wu, moe_wd)
    return rmsnorm(xl, final_g)
```

```cpp
#include <hip/hip_runtime.h>
#include <cstdio>
#include <cstdint>
namespace pg8 {
#define PG8_LAS __attribute__((address_space(3)))
typedef unsigned short bf16_t;
typedef short bf16x8 __attribute__((ext_vector_type(8)));
typedef float f32x4 __attribute__((ext_vector_type(4)));
typedef unsigned u32x4 __attribute__((ext_vector_type(4)));
constexpr int BM = 256, BK = 64, HALF = 128, HTB = HALF * BK * 2  , STAGE_BYTES = 8 * HTB, NXCD = 8, WGM = 8;

__host__ __device__ __forceinline__ int lds_byte(int r, int c) { const int st = (r >> 4) * 2 + (c >> 5), rr = r & 15, cc = c & 31, ob = rr * 64 + cc * 2; return st * 1024 + (ob ^ (((ob >> 9) & 1) << 5)); }
__host__ __device__ __forceinline__ void stage_rc(int b, int& R, int& C) { const int st = b / 1024, sb = b % 1024, swz = sb ^ (((sb >> 9) & 1) << 5); R = (st >> 1) * 16 + swz / 64; C = (st & 1) * 32 + (swz % 64) / 2; }
__host__ __device__ __forceinline__ int perm32(int rho) { const int n = rho >> 4, i = rho & 15; return 8 * (i >> 2) + 4 * n + (i & 3); }

struct Unit { int pm, pn; };
struct Gemm { const bf16_t* A; const bf16_t* Bt; int M, N, K, lda; };

struct StaticOrder {
    int nM, nN, nwg, G, c;
    __host__ __device__ void init(int M, int N, int G_, int c_) { nM = M / BM; nN = N / BM; nwg = nM * nN; G = G_; c = c_; }
    __host__ __device__ bool next(int i, Unit& u) const {
        const long L = (long)i * G + c; if (L >= nwg) return false;
        int wgid = (int)L; { const int q = nwg / NXCD, r = nwg % NXCD, xcd = wgid % NXCD, off = wgid / NXCD; wgid = (xcd < r ? xcd * (q + 1) : r * (q + 1) + (xcd - r) * q) + off; }
        const int nig = WGM * nN, gid = wgid / nig, fm = gid * WGM, gsz = (nM - fm) < WGM ? (nM - fm) : WGM;
        u.pm = fm + ((wgid % nig) % gsz); u.pn = (wgid % nig) / gsz; return true;
    }
    __device__ __forceinline__ void a_ready(const Unit&) const {}
    __device__ __forceinline__ void done(const Unit&) const {}
};

__device__ __forceinline__ unsigned cvt_pk_bf16(float lo, float hi) { unsigned r; asm volatile("v_cvt_pk_bf16_f32 %0, %1, %2" : "=v"(r) : "v"(lo), "v"(hi)); return r; }
typedef float f32x2 __attribute__((ext_vector_type(2)));
__device__ __forceinline__ f32x2 gelu_pk(f32x2 v) {
    const f32x2 av = __builtin_elementwise_abs(v), d = av * 0.2316418882f + 1.0f;
    f32x2 t; t.x = __builtin_amdgcn_rcpf(d.x); t.y = __builtin_amdgcn_rcpf(d.y);
    f32x2 q = t * 0.5307027145f + (-0.7265760135f); q = q * t + 0.7107068705f; q = q * t + (-0.142248368f); q = q * t + 0.127414796f; q = q * t;
    const f32x2 s = (v * v) * (-0.72134752044f);
    f32x2 e; e.x = __builtin_amdgcn_exp2f(s.x); e.y = __builtin_amdgcn_exp2f(s.y);
    const f32x2 m = v * (q * e), r = v - m;
    f32x2 o; o.x = v.x < 0.f ? m.x : r.x; o.y = v.y < 0.f ? m.y : r.y; return o;
}

template <int ACT  > struct EpiBf16 {
    static constexpr bool PERM = true, AFTER_DRAIN = false; static_assert(ACT == 0 || ACT == 1, "EpiBf16: ACT is 0 (none) or 1 (gelu_pk)");
    bf16_t* O; int ldc; const float* bias; int split_cols; size_t split_stride; float scale0;
    __device__ __forceinline__ void operator()(const f32x4 (&acc)[2][2][4][2], const Unit& u, int wr, int wc, int fr, int fq) const {
        const int row0 = u.pm * BM + wr * 64 + fr; int colt = u.pn * BM; bf16_t* base = O;
        float sc = 1.f; if (split_cols) { const int t = colt / split_cols; base += (size_t)t * split_stride; colt -= t * split_cols; if (t == 0) sc = scale0; }
        const int col0 = colt + wc * 32 + 8 * fq, bcol0 = u.pn * BM + wc * 32 + 8 * fq;
        f32x4 bv[2][2];
#pragma unroll
        for (int bj = 0; bj < 2; ++bj)
#pragma unroll
            for (int n = 0; n < 2; ++n) bv[bj][n] = bias ? *(const f32x4*)(bias + bcol0 + bj * HALF + 4 * n) : (f32x4){0.f, 0.f, 0.f, 0.f};
#pragma unroll
        for (int ai = 0; ai < 2; ++ai)
#pragma unroll
            for (int m = 0; m < 4; ++m) { bf16_t* rowp = base + (size_t)(row0 + ai * HALF + m * 16) * ldc + col0;
#pragma unroll
                for (int bj = 0; bj < 2; ++bj) { f32x4 v0 = acc[ai][bj][m][0] + bv[bj][0], v1 = acc[ai][bj][m][1] + bv[bj][1];
                    if (ACT == 1) { f32x2 a = gelu_pk((f32x2){v0[0], v0[1]}), b = gelu_pk((f32x2){v0[2], v0[3]}), c = gelu_pk((f32x2){v1[0], v1[1]}), d = gelu_pk((f32x2){v1[2], v1[3]});
                        v0 = (f32x4){a.x, a.y, b.x, b.y}; v1 = (f32x4){c.x, c.y, d.x, d.y}; }
                    v0 = v0 * sc; v1 = v1 * sc; u32x4 w; w.x = cvt_pk_bf16(v0[0], v0[1]); w.y = cvt_pk_bf16(v0[2], v0[3]); w.z = cvt_pk_bf16(v1[0], v1[1]); w.w = cvt_pk_bf16(v1[2], v1[3]);
                    *(u32x4*)(rowp + bj * HALF) = w; } }
    }
};

struct PanelStats {
    unsigned* xbuf;
    unsigned* cnt;
    unsigned* tmo;
    int ntn; float eps;
    unsigned code;
    __device__ __forceinline__ bool run(const f32x4 (&v)[2][2][4][2], const Unit& u, int wr, int wc, int fr, int fq, PG8_LAS unsigned char* lds, int wid, int lane) const {
        typedef float f32x2v __attribute__((ext_vector_type(2)));
        PG8_LAS f32x2v* P = (PG8_LAS f32x2v*)lds;
        PG8_LAS f32x2v* S = (PG8_LAS f32x2v*)(lds + 8192);
        PG8_LAS unsigned* flag = (PG8_LAS unsigned*)(lds + 8192 + 2048);
#pragma unroll
        for (int ai = 0; ai < 2; ++ai)
#pragma unroll
            for (int m = 0; m < 4; ++m) {
                float s = 0.f;
#pragma unroll
                for (int bj = 0; bj < 2; ++bj)
#pragma unroll
                    for (int n = 0; n < 2; ++n) { const f32x4 x = v[ai][bj][m][n]; s += (x[0] + x[1]) + (x[2] + x[3]); }
                s += __shfl_xor(s, 16); s += __shfl_xor(s, 32);
                const float mw = s * (1.0f / 64.0f); float q = 0.f;
#pragma unroll
                for (int bj = 0; bj < 2; ++bj)
#pragma unroll
                    for (int n = 0; n < 2; ++n) { const f32x4 d = v[ai][bj][m][n] - mw; q += (d[0] * d[0] + d[1] * d[1]) + (d[2] * d[2] + d[3] * d[3]); }
                q += __shfl_xor(q, 16); q += __shfl_xor(q, 32);
                if (fq == 0) P[(ai * HALF + wr * 64 + m * 16 + fr) * 4 + wc] = (f32x2v){mw, q};
            }
        asm volatile("s_waitcnt lgkmcnt(0)" ::: "memory"); __builtin_amdgcn_s_barrier(); asm volatile("" ::: "memory");
#if defined(BROKEN_EXCHANGE_NO_WAIT)
#warning BROKEN CONTROL BUILD: the row-statistics exchange does not wait; results are wrong by design
        if (blockIdx.x >= 64) { const long long t0_ = clock64(); while (clock64() - t0_ < 60000) __builtin_amdgcn_s_sleep(8); }
#endif
        const int row = wid * 32 + (lane & 31);
        if (lane < 32) {
            const f32x2v a = P[row * 4 + 0], b = P[row * 4 + 1], c = P[row * 4 + 2], d = P[row * 4 + 3];
            const float mt = (a.x + b.x + c.x + d.x) * 0.25f;
            const float da = a.x - mt, db = b.x - mt, dc = c.x - mt, dd = d.x - mt;
            const float m2 = (a.y + b.y) + (c.y + d.y) + 64.0f * ((da * da + db * db) + (dc * dc + dd * dd));
            unsigned long long* slot = (unsigned long long*)xbuf + ((size_t)(u.pm * BM + row) * 4 + u.pn);
            __hip_atomic_store(slot, ((unsigned long long)__float_as_uint(m2) << 32) | __float_as_uint(mt), __ATOMIC_RELAXED, __HIP_MEMORY_SCOPE_AGENT);
        }
        asm volatile("s_waitcnt vmcnt(0)" ::: "memory");
        if (lane == 0) __hip_atomic_fetch_add(cnt + 64 * u.pm, 1u, __ATOMIC_RELAXED, __HIP_MEMORY_SCOPE_AGENT);
        if (wid == 0) {
            bool dead = false; const unsigned long long t0 = __builtin_amdgcn_s_memrealtime(); const unsigned want = 8u * (unsigned)ntn;
            for (;;) {
#if defined(BROKEN_EXCHANGE_NO_WAIT)
                break;
#endif
                if ((unsigned)__builtin_amdgcn_readfirstlane(__hip_atomic_load(cnt + 64 * u.pm, __ATOMIC_RELAXED, __HIP_MEMORY_SCOPE_AGENT)) >= want) break;
                if (__builtin_amdgcn_s_memrealtime() - t0 > 2000000ull) {
                    if (lane == 0) { unsigned expect = 0u; __hip_atomic_compare_exchange_strong(tmo + 1, &expect, code | (unsigned)(u.pm & 0xff), __ATOMIC_RELAXED, __ATOMIC_RELAXED, __HIP_MEMORY_SCOPE_AGENT);
                                     __hip_atomic_store(tmo, 1u, __ATOMIC_RELAXED, __HIP_MEMORY_SCOPE_AGENT); }
                    dead = true; break; }
                __builtin_amdgcn_s_sleep(2);
            }
            __builtin_amdgcn_fence(__ATOMIC_ACQUIRE, "agent");
            if (lane == 0) flag[0] = dead ? 1u : 0u;
        }
        asm volatile("s_waitcnt vmcnt(0) lgkmcnt(0)" ::: "memory"); __builtin_amdgcn_s_barrier(); asm volatile("" ::: "memory");
        const bool bad = flag[0] != 0u;
        if (lane < 32) {
            const unsigned long long* slot = (const unsigned long long*)xbuf + (size_t)(u.pm * BM + row) * 4; float mt[4], m2[4]; float ms = 0.f;
#pragma unroll
            for (int t = 0; t < 4; ++t) { if (t < ntn) { const unsigned long long w = __hip_atomic_load(slot + t, __ATOMIC_RELAXED, __HIP_MEMORY_SCOPE_AGENT); mt[t] = __uint_as_float((unsigned)w); m2[t] = __uint_as_float((unsigned)(w >> 32)); } else { mt[t] = 0.f; m2[t] = 0.f; } ms += mt[t]; }
            const float mean = ms / (float)ntn; float q = 0.f;
#pragma unroll
            for (int t = 0; t < 4; ++t) if (t < ntn) { const float dm = mt[t] - mean; q += m2[t] + 256.0f * dm * dm; }
            S[row] = (f32x2v){mean, 1.0f / sqrtf(q / (256.0f * (float)ntn) + eps)};
        }
        asm volatile("s_waitcnt lgkmcnt(0)" ::: "memory"); __builtin_amdgcn_s_barrier(); asm volatile("" ::: "memory");
        return bad;
    }
};
struct EpiLnRes {
    static constexpr bool PERM = false, AFTER_DRAIN = true;
    const float* base; float* out; int ldc; const float* bias; PanelStats st; unsigned poison;
    __device__ __forceinline__ void fused(f32x4 (&acc)[2][2][4][2], const Unit& u, int wr, int wc, int fr, int fq, PG8_LAS unsigned char* lds, int wid, int lane) const {
        typedef float f32x2v __attribute__((ext_vector_type(2)));
        const PG8_LAS f32x2v* S = (const PG8_LAS f32x2v*)(lds + 8192);
        const int col0 = u.pn * BM + wc * 32 + 4 * fq;
#pragma unroll
        for (int bj = 0; bj < 2; ++bj)
#pragma unroll
            for (int n = 0; n < 2; ++n) { const f32x4 bv = bias ? *(const f32x4*)(bias + col0 + bj * HALF + n * 16) : (f32x4){0.f, 0.f, 0.f, 0.f};
#pragma unroll
                for (int ai = 0; ai < 2; ++ai)
#pragma unroll
                    for (int m = 0; m < 4; ++m) acc[ai][bj][m][n] += bv; }
        f32x4 pre[4][2][2];
#pragma unroll
        for (int m = 0; m < 4; ++m) { const size_t off = (size_t)(u.pm * BM + wr * 64 + m * 16 + fr) * ldc + col0;
#pragma unroll
            for (int bj = 0; bj < 2; ++bj)
#pragma unroll
                for (int n = 0; n < 2; ++n) pre[m][bj][n] = *(const f32x4*)(base + off + bj * HALF + n * 16); }
        const bool bad = st.run(acc, u, wr, wc, fr, fq, lds, wid, lane) || poison != 0u;
        const float qnan = __builtin_nanf("");
#pragma unroll
        for (int ai = 0; ai < 2; ++ai)
#pragma unroll
            for (int m = 0; m < 4; ++m) { const int r = ai * HALF + wr * 64 + m * 16 + fr; const f32x2v sr = S[r]; const size_t off = (size_t)(u.pm * BM + r) * ldc + col0;
#pragma unroll
                for (int bj = 0; bj < 2; ++bj)
#pragma unroll
                    for (int n = 0; n < 2; ++n) { const f32x4 bs = ai == 0 ? pre[m][bj][n] : *(const f32x4*)(base + off + bj * HALF + n * 16); f32x4 o = bs + (acc[ai][bj][m][n] - sr.x) * sr.y;
                        if (bad) o = (f32x4){qnan, qnan, qnan, qnan}; *(f32x4*)(out + off + bj * HALF + n * 16) = o; }
                if (m & 1) asm volatile("" ::: "memory"); }
    }
};
struct EpiLnResLn {
    static constexpr bool PERM = false, AFTER_DRAIN = true;
    const float* base; float* out; bf16_t* xn; int ldc; const float* bias; PanelStats st1, st2; unsigned poison;
    __device__ __forceinline__ void fused(f32x4 (&acc)[2][2][4][2], const Unit& u, int wr, int wc, int fr, int fq, PG8_LAS unsigned char* lds, int wid, int lane) const {
        typedef float f32x2v __attribute__((ext_vector_type(2))); typedef unsigned u32x2v __attribute__((ext_vector_type(2)));
        const PG8_LAS f32x2v* S = (const PG8_LAS f32x2v*)(lds + 8192);
        const int col0 = u.pn * BM + wc * 32 + 4 * fq;
#pragma unroll
        for (int bj = 0; bj < 2; ++bj)
#pragma unroll
            for (int n = 0; n < 2; ++n) { const f32x4 bv = bias ? *(const f32x4*)(bias + col0 + bj * HALF + n * 16) : (f32x4){0.f, 0.f, 0.f, 0.f};
#pragma unroll
                for (int ai = 0; ai < 2; ++ai)
#pragma unroll
                    for (int m = 0; m < 4; ++m) acc[ai][bj][m][n] += bv; }
        bool bad = st1.run(acc, u, wr, wc, fr, fq, lds, wid, lane) || poison != 0u;
        const float qnan = __builtin_nanf("");
#pragma unroll
        for (int ai = 0; ai < 2; ++ai)
#pragma unroll
            for (int m = 0; m < 4; ++m) { const int r = ai * HALF + wr * 64 + m * 16 + fr; const f32x2v sr = S[r]; const size_t off = (size_t)(u.pm * BM + r) * ldc + col0;
#pragma unroll
                for (int bj = 0; bj < 2; ++bj)
#pragma unroll
                    for (int n = 0; n < 2; ++n) { const f32x4 bs = *(const f32x4*)(base + off + bj * HALF + n * 16); acc[ai][bj][m][n] = bs + (acc[ai][bj][m][n] - sr.x) * sr.y; }
                asm volatile("" : "+v"(acc[ai][0][m][0]), "+v"(acc[ai][0][m][1]), "+v"(acc[ai][1][m][0]), "+v"(acc[ai][1][m][1]));
                if (m & 1) asm volatile("" ::: "memory"); }
        const bool bad1 = bad;
        bad = st2.run(acc, u, wr, wc, fr, fq, lds, wid, lane) || bad;
#pragma unroll
        for (int ai = 0; ai < 2; ++ai)
#pragma unroll
            for (int m = 0; m < 4; ++m) { const int r = ai * HALF + wr * 64 + m * 16 + fr; const f32x2v sr = S[r]; const size_t off = (size_t)(u.pm * BM + r) * ldc + col0;
#pragma unroll
                for (int bj = 0; bj < 2; ++bj)
#pragma unroll
                    for (int n = 0; n < 2; ++n) { const f32x4 x1 = acc[ai][bj][m][n]; *(f32x4*)(out + off + bj * HALF + n * 16) = bad1 ? (f32x4){qnan, qnan, qnan, qnan} : x1;
                        const f32x4 o = (x1 - sr.x) * sr.y; u32x2v w; w.x = cvt_pk_bf16(o[0], o[1]); w.y = cvt_pk_bf16(o[2], o[3]);
                        if (bad) { w.x = 0x7fc07fc0u; w.y = 0x7fc07fc0u; } *(u32x2v*)(xn + off + bj * HALF + n * 16) = w; }
                asm volatile("" ::: "memory"); }
    }
};

template <class Epi, class Sched, bool ALIGN_EPI = false, bool SP2 = false>
__device__ __forceinline__ void gemm_phase(PG8_LAS unsigned char* lds, const Gemm g, const Sched& S, const Epi& E) {
    int tid_ = threadIdx.x; asm volatile("" : "+v"(tid_));
    const int tid = tid_, wid = __builtin_amdgcn_readfirstlane(tid >> 6), lane = tid & 63, wr = wid >> 2, wc = wid & 3, fr = lane & 15, fq = lane >> 4;
    int K_ = g.K; asm volatile("" : "+s"(K_)); const int K = K_, nt = K / BK;
    unsigned voffA[2], voffB[2];
#pragma unroll
    for (int i = 0; i < 2; ++i) { int R, C; stage_rc(tid * 16 + i * 8192, R, C); const int Rb = Epi::PERM ? ((R & ~31) + perm32(R & 31)) : R;
        voffA[i] = (unsigned)(R * g.lda + C) * 2u; voffB[i] = (unsigned)(Rb * K + C) * 2u; }
    const size_t kstep = (size_t)(BK * 2);
    const size_t hstepA = (size_t)HALF * g.lda * 2, hstepB = (size_t)HALF * K * 2;
    const size_t tstepA = 2 * hstepA, tstepB = 2 * hstepB;
    const unsigned ldsw = (unsigned)wid * 1024u;
    const int aoff = lds_byte(wr * 64 + fr, fq * 8), boff = lds_byte(wc * 32 + fr, fq * 8);
#define PG8_SA(b, h) (((b) * 2 + (h)) * HTB)
#define PG8_SB(b, h) ((4 + (b) * 2 + (h)) * HTB)
#define PG8_STAGE(bufoff, gbase, voff) do { _Pragma("unroll") for (int _i = 0; _i < 2; ++_i) \
        __builtin_amdgcn_global_load_lds((const unsigned*)((const char*)(gbase) + (voff)[_i]), (PG8_LAS unsigned*)(lds + (bufoff) + ldsw + _i * 8192), 16, 0, 0); } while (0)
#define PG8_LDA(dst, b, h) do { _Pragma("unroll") for (int m = 0; m < 4; ++m) _Pragma("unroll") for (int k = 0; k < 2; ++k) dst[m][k] = *(const PG8_LAS bf16x8*)(lds + PG8_SA(b, h) + aoff + m * 2048 + k * 1024); } while (0)
#define PG8_LDB(dst, b, h) do { _Pragma("unroll") for (int n = 0; n < 2; ++n) _Pragma("unroll") for (int k = 0; k < 2; ++k) dst[n][k] = *(const PG8_LAS bf16x8*)(lds + PG8_SB(b, h) + boff + n * 2048 + k * 1024); } while (0)
#define PG8_MMA(ai, bj, At, Bt) do { __builtin_amdgcn_s_setprio(1); _Pragma("unroll") for (int m = 0; m < 4; ++m) _Pragma("unroll") for (int n = 0; n < 2; ++n) _Pragma("unroll") for (int k = 0; k < 2; ++k) \
        acc[ai][bj][m][n] = __builtin_amdgcn_mfma_f32_16x16x32_bf16(Bt[n][k], At[m][k], acc[ai][bj][m][n], 0, 0, 0); __builtin_amdgcn_s_setprio(0); } while (0)
#define PG8_WAIT_V(n) asm volatile("s_waitcnt vmcnt(" #n ")" ::: "memory")
#define PG8_WAIT_L(n) asm volatile("s_waitcnt lgkmcnt(" #n ")" ::: "memory")
#define PG8_BAR __builtin_amdgcn_s_barrier()
#define PG8_SCHED __builtin_amdgcn_sched_barrier(0)
    Unit cur, nxt; int ui = 0;
    if (!S.next(0, cur)) return;
    f32x4 acc[2][2][4][2];
#pragma unroll
    for (int a = 0; a < 2; ++a)
#pragma unroll
        for (int b = 0; b < 2; ++b)
#pragma unroll
            for (int m = 0; m < 4; ++m)
#pragma unroll
                for (int n = 0; n < 2; ++n) acc[a][b][m][n] = (f32x4){0.f, 0.f, 0.f, 0.f};
    bf16x8 At[4][2], B0[2][2], B1[2][2];
    const char* cA = (const char*)g.A + (size_t)cur.pm * tstepA; const char* cB = (const char*)g.Bt + (size_t)cur.pn * tstepB;
    S.a_ready(cur);
    if constexpr (SP2) {
        PG8_STAGE(PG8_SB(0, 0), cB, voffB); PG8_STAGE(PG8_SB(0, 1), cB + hstepB, voffB); PG8_STAGE(PG8_SA(0, 0), cA, voffA); PG8_STAGE(PG8_SA(0, 1), cA + hstepA, voffA);
        if (wr == 1) PG8_BAR;
        PG8_WAIT_V(2); PG8_BAR;
        PG8_STAGE(PG8_SB(1, 0), cB + kstep, voffB); PG8_STAGE(PG8_SA(1, 0), cA + kstep, voffA); PG8_STAGE(PG8_SB(1, 1), cB + hstepB + kstep, voffB);
        PG8_WAIT_V(6); PG8_BAR;
    } else {
        PG8_STAGE(PG8_SB(0, 0), cB, voffB); PG8_STAGE(PG8_SA(0, 0), cA, voffA); PG8_STAGE(PG8_SB(0, 1), cB + hstepB, voffB); PG8_STAGE(PG8_SA(0, 1), cA + hstepA, voffA);
        if (wr == 1) PG8_BAR;
        PG8_WAIT_V(4); PG8_BAR;
        PG8_STAGE(PG8_SB(1, 0), cB + kstep, voffB); PG8_STAGE(PG8_SA(1, 0), cA + kstep, voffA); PG8_STAGE(PG8_SB(1, 1), cB + hstepB + kstep, voffB);
        PG8_WAIT_V(6); PG8_BAR;
    }
    for (;;) {
        const bool has_next = S.next(ui + 1, nxt);
        const char* nA = has_next ? (const char*)g.A + (size_t)nxt.pm * tstepA : cA; const char* nB = has_next ? (const char*)g.Bt + (size_t)nxt.pn * tstepB : cB;
#pragma unroll 1
        for (int t = 0; t < nt; t += 2) {
            const bool last = (t == nt - 2);
            const char* a1 = cA + (size_t)(t + 1) * kstep;
            const char* a2 = last ? nA : cA + (size_t)(t + 2) * kstep; const char* b2 = last ? nB : cB + (size_t)(t + 2) * kstep;
            const char* a3 = a2 + kstep; const char* b3 = b2 + kstep;
            if (last && has_next) S.a_ready(nxt);
            if constexpr (SP2) {
            PG8_LDB(B0, 0, 0); PG8_LDB(B1, 0, 1); PG8_SCHED; PG8_LDA(At, 0, 0); PG8_STAGE(PG8_SA(1, 1), a1 + hstepA, voffA);
            PG8_WAIT_V(8); PG8_WAIT_L(0); PG8_BAR; PG8_MMA(0, 0, At, B0); PG8_MMA(0, 1, At, B1); PG8_BAR; PG8_SCHED;
            PG8_LDA(At, 0, 1); PG8_STAGE(PG8_SB(0, 0), b2, voffB); PG8_STAGE(PG8_SB(0, 1), b2 + hstepB, voffB); PG8_STAGE(PG8_SA(0, 0), a2, voffA);
            PG8_WAIT_V(8); PG8_WAIT_L(0); PG8_BAR; PG8_MMA(1, 0, At, B0); PG8_MMA(1, 1, At, B1); PG8_BAR; PG8_SCHED;
            PG8_LDB(B0, 1, 0); PG8_LDB(B1, 1, 1); PG8_SCHED; PG8_LDA(At, 1, 0); PG8_STAGE(PG8_SA(0, 1), a2 + hstepA, voffA);
            PG8_WAIT_V(8); PG8_WAIT_L(0); PG8_BAR; PG8_MMA(0, 0, At, B0); PG8_MMA(0, 1, At, B1); PG8_BAR; PG8_SCHED;
            PG8_LDA(At, 1, 1); PG8_STAGE(PG8_SB(1, 0), b3, voffB); PG8_STAGE(PG8_SB(1, 1), b3 + hstepB, voffB); PG8_STAGE(PG8_SA(1, 0), a3, voffA);
            PG8_WAIT_V(8); PG8_WAIT_L(0); PG8_BAR; PG8_MMA(1, 0, At, B0); PG8_MMA(1, 1, At, B1); PG8_BAR; PG8_SCHED;
            } else {
            PG8_LDB(B0, 0, 0); PG8_SCHED; PG8_LDA(At, 0, 0); PG8_STAGE(PG8_SA(1, 1), a1 + hstepA, voffA);
            PG8_WAIT_L(8); PG8_BAR; PG8_WAIT_L(0); PG8_MMA(0, 0, At, B0); PG8_BAR; PG8_SCHED;
            PG8_LDB(B1, 0, 1); PG8_STAGE(PG8_SB(0, 0), b2, voffB);
            PG8_BAR; PG8_WAIT_L(0); PG8_MMA(0, 1, At, B1); PG8_BAR;
            PG8_LDA(At, 0, 1); PG8_STAGE(PG8_SA(0, 0), a2, voffA);
            PG8_BAR; PG8_WAIT_L(0); PG8_MMA(1, 0, At, B0); PG8_BAR; PG8_SCHED;
            PG8_STAGE(PG8_SB(0, 1), b2 + hstepB, voffB);
            PG8_WAIT_V(6); PG8_BAR; PG8_MMA(1, 1, At, B1); PG8_BAR;
            PG8_LDB(B0, 1, 0); PG8_SCHED; PG8_LDA(At, 1, 0); PG8_STAGE(PG8_SA(0, 1), a2 + hstepA, voffA);
            PG8_WAIT_L(8); PG8_BAR; PG8_WAIT_L(0); PG8_MMA(0, 0, At, B0); PG8_BAR; PG8_SCHED;
            PG8_LDB(B1, 1, 1); PG8_STAGE(PG8_SB(1, 0), b3, voffB);
            PG8_BAR; PG8_WAIT_L(0); PG8_MMA(0, 1, At, B1); PG8_BAR;
            PG8_LDA(At, 1, 1); PG8_STAGE(PG8_SA(1, 0), a3, voffA);
            PG8_BAR; PG8_WAIT_L(0); PG8_MMA(1, 0, At, B0); PG8_BAR; PG8_SCHED;
            PG8_STAGE(PG8_SB(1, 1), b3 + hstepB, voffB);
            PG8_WAIT_V(6); PG8_BAR; PG8_MMA(1, 1, At, B1); PG8_BAR;
            }
        }
        if constexpr (ALIGN_EPI) { if (wr == 0) PG8_BAR; }
        if constexpr (!Epi::AFTER_DRAIN) { E(acc, cur, wr, wc, fr, fq); S.done(cur); }
        if (!has_next) break;
#pragma unroll
        for (int a = 0; a < 2; ++a)
#pragma unroll
            for (int b = 0; b < 2; ++b)
#pragma unroll
                for (int m = 0; m < 4; ++m)
#pragma unroll
                    for (int n = 0; n < 2; ++n) acc[a][b][m][n] = (f32x4){0.f, 0.f, 0.f, 0.f};
        cur = nxt; cA = nA; cB = nB; ++ui;
        if constexpr (ALIGN_EPI) { if (wr == 1) PG8_BAR; }
    }
    PG8_WAIT_V(0);
    if constexpr (!ALIGN_EPI) { if (wr == 0) PG8_BAR; }
    PG8_BAR;
    if constexpr (Epi::AFTER_DRAIN) { E.fused(acc, cur, wr, wc, fr, fq, lds, wid, lane); S.done(cur); }
#undef PG8_SA
#undef PG8_SB
#undef PG8_STAGE
#undef PG8_LDA
#undef PG8_LDB
#undef PG8_MMA
#undef PG8_WAIT_V
#undef PG8_WAIT_L
#undef PG8_BAR
#undef PG8_SCHED
}
}
constexpr int D = 1024, NB = 2, SEQ = 16384, LAT = NB * SEQ, CTXL = 256, NCTX = NB * CTXL, MT = LAT + NCTX;
constexpr int DEPTH = 4, NHEAD = 8, DQK = 96, DV = 64, NKEY = CTXL + SEQ;
constexpr int UW = 1792, KVW = 160;
constexpr int C_HY = 0, C_POOL = 768, C_CQ = 1024, C_CKV = 1408, C_KPE = 1664;
constexpr int FF = 2816, NJ_GU = FF / 128, NEXP = 8;
constexpr size_t KV_HEAD_STRIDE = (size_t)NKEY * KVW;

namespace pg8 {
__device__ __forceinline__ u32x4 pack8(f32x4 v0, f32x4 v1) { u32x4 w; w.x = cvt_pk_bf16(v0[0], v0[1]); w.y = cvt_pk_bf16(v0[2], v0[3]); w.z = cvt_pk_bf16(v1[0], v1[1]); w.w = cvt_pk_bf16(v1[2], v1[3]); return w; }

struct EpiQRope {
    static constexpr bool PERM = true, AFTER_DRAIN = false;
    bf16_t* Q; const float* rstd; const float* ropec; const float* ropes;
    __device__ __forceinline__ void operator()(const f32x4 (&acc)[2][2][4][2], const Unit& u, int wr, int wc, int fr, int fq) const {
        asm volatile("" : "+v"(fr), "+v"(fq));
        const int row0 = u.pm * BM + wr * 64 + fr; const bool lat = u.pm < (LAT / BM);
        int c0[2], j0[2]; bool rp[2];
#pragma unroll
        for (int bj = 0; bj < 2; ++bj) { c0[bj] = u.pn * BM + bj * HALF + wc * 32 + 8 * fq; const int dl = c0[bj] % DQK; rp[bj] = lat && dl >= 64; j0[bj] = rp[bj] ? ((dl - 64) >> 1) : 0; }
#pragma unroll
        for (int ai = 0; ai < 2; ++ai)
#pragma unroll
            for (int m = 0; m < 4; ++m) { const int row = row0 + ai * HALF + m * 16; const float rs = rstd[row]; const int t = row & (SEQ - 1);
#pragma unroll
                for (int bj = 0; bj < 2; ++bj) { f32x4 v0 = acc[ai][bj][m][0] * rs, v1 = acc[ai][bj][m][1] * rs;
                    if (rp[bj]) { const f32x4 c = *(const f32x4*)(ropec + t * 16 + j0[bj]), s = *(const f32x4*)(ropes + t * 16 + j0[bj]);
                        const f32x4 a = v0 * c - v1 * s, b = v0 * s + v1 * c; v0 = a; v1 = b; }
                    *(u32x4*)(Q + (unsigned)(row * 768 + c0[bj])) = pack8(v0, v1); }
                asm volatile("" ::: "memory"); }
    }
};
struct EpiKV {
    static constexpr bool PERM = true, AFTER_DRAIN = false;
    bf16_t* KV; const float* rstd;
    __device__ __forceinline__ void operator()(const f32x4 (&acc)[2][2][4][2], const Unit& u, int wr, int wc, int fr, int fq) const {
        asm volatile("" : "+v"(fr), "+v"(fq));
        const int row0 = u.pm * BM + wr * 64 + fr; const bool lat = u.pm < (LAT / BM);
        const int d = wc * 32 + 8 * fq, off = d < 64 ? d : d + 32;
#pragma unroll
        for (int ai = 0; ai < 2; ++ai)
#pragma unroll
            for (int m = 0; m < 4; ++m) { const int row = row0 + ai * HALF + m * 16; const float rs = rstd[row];
                int b, key; if (lat) { b = row >> 14; key = CTXL + (row & (SEQ - 1)); } else { const int rc = row - LAT; b = rc >> 8; key = rc & (CTXL - 1); }
                const unsigned ro = (unsigned)((b * NHEAD + 2 * u.pn) * NKEY + key) * KVW + off;
#pragma unroll
                for (int bj = 0; bj < 2; ++bj) *(u32x4*)(KV + ro + bj * (unsigned)KV_HEAD_STRIDE) = pack8(acc[ai][bj][m][0] * rs, acc[ai][bj][m][1] * rs);
                asm volatile("" ::: "memory"); }
    }
};
struct EpiColScale {
    static constexpr bool PERM = true, AFTER_DRAIN = false;
    bf16_t* O; int ldc; const float* cs;
    __device__ __forceinline__ void operator()(const f32x4 (&acc)[2][2][4][2], const Unit& u, int wr, int wc, int fr, int fq) const {
        asm volatile("" : "+v"(fr), "+v"(fq));
        const int row0 = u.pm * BM + wr * 64 + fr;
#pragma unroll
        for (int bj = 0; bj < 2; ++bj) { const int c = u.pn * BM + bj * HALF + wc * 32 + 8 * fq; const f32x4 s0 = *(const f32x4*)(cs + c), s1 = *(const f32x4*)(cs + c + 4);
#pragma unroll
            for (int ai = 0; ai < 2; ++ai)
#pragma unroll
                for (int m = 0; m < 4; ++m) { *(u32x4*)(O + (unsigned)((row0 + ai * HALF + m * 16) * ldc + c)) = pack8(acc[ai][bj][m][0] * s0, acc[ai][bj][m][1] * s1); if (m & 1) asm volatile("" ::: "memory"); } }
    }
};
struct EpiSwiGLU {
    static constexpr bool PERM = true, AFTER_DRAIN = false;
    bf16_t* H;
    __device__ __forceinline__ void operator()(const f32x4 (&acc)[2][2][4][2], const Unit& u, int wr, int wc, int fr, int fq) const {
        asm volatile("" : "+v"(fr), "+v"(fq));
        const int row0 = u.pm * BM + wr * 64 + fr; const int hc = (u.pn % NJ_GU) * HALF + wc * 32 + 8 * fq;
#pragma unroll
        for (int ai = 0; ai < 2; ++ai)
#pragma unroll
            for (int m = 0; m < 4; ++m) { f32x4 h[2];
#pragma unroll
                for (int n = 0; n < 2; ++n) { const f32x4 g = acc[ai][0][m][n], up = acc[ai][1][m][n];
#pragma unroll
                    for (int j = 0; j < 4; ++j) { const float e = __builtin_amdgcn_exp2f(g[j] * -1.4426950408889634f); h[n][j] = g[j] * __builtin_amdgcn_rcpf(1.0f + e) * up[j]; } }
                *(u32x4*)(H + (size_t)(row0 + ai * HALF + m * 16) * FF + hc) = pack8(h[0], h[1]); if (m & 1) asm volatile("" ::: "memory"); }
    }
};
struct EpiResGate {
    static constexpr bool PERM = false, AFTER_DRAIN = false;
    float* xl_lat; float* xl_ctx; const float* gate;
    __device__ __forceinline__ void operator()(const f32x4 (&acc)[2][2][4][2], const Unit& u, int wr, int wc, int fr, int fq) const {
        asm volatile("" : "+v"(fr), "+v"(fq));
        const int vsel = u.pm < (SEQ / BM) ? 0 : (u.pm < (LAT / BM) ? 1 : 2);
        float* base = (u.pm < (LAT / BM)) ? xl_lat + (size_t)u.pm * BM * D : xl_ctx + (size_t)(u.pm - LAT / BM) * BM * D;
        const int col0 = u.pn * BM + wc * 32 + 4 * fq; const float* gp = gate + vsel * 6 * D + col0;
        f32x4 gv[2][2];
#pragma unroll
        for (int bj = 0; bj < 2; ++bj)
#pragma unroll
            for (int n = 0; n < 2; ++n) gv[bj][n] = *(const f32x4*)(gp + bj * HALF + n * 16);
#pragma unroll
        for (int ai = 0; ai < 2; ++ai)
#pragma unroll
            for (int m = 0; m < 4; ++m) { float* rp = base + (size_t)(ai * HALF + wr * 64 + m * 16 + fr) * D + col0;
#pragma unroll
                for (int bj = 0; bj < 2; ++bj)
#pragma unroll
                    for (int n = 0; n < 2; ++n) { f32x4* p = (f32x4*)(rp + bj * HALF + n * 16); *p = *p + gv[bj][n] * acc[ai][bj][m][n]; }
                if (m & 1) asm volatile("" ::: "memory"); }
    }
};
template <int NJ> struct MoeOrder {
    int t0, nt, G, c; const PG8_LAS int* tstart;
    __device__ __forceinline__ bool next(int i, Unit& u) const {
        const int L = i * G + c; if (L >= nt * NJ) return false;
        const int tile = t0 + L / NJ, j = L % NJ; int e = 0;
#pragma unroll
        for (int k = 1; k < NEXP; ++k) e += (tile >= tstart[k]) ? 1 : 0;
        u.pm = __builtin_amdgcn_readfirstlane(tile); u.pn = __builtin_amdgcn_readfirstlane(e * NJ + j); return true;
    }
    __device__ __forceinline__ void a_ready(const Unit&) const {}
    __device__ __forceinline__ void done(const Unit&) const {}
};
}
namespace att {
using bf16x8 = __attribute__((ext_vector_type(8))) short;
using s16x4  = __attribute__((ext_vector_type(4))) short;
using f32x16 = __attribute__((ext_vector_type(16))) float;
using u32x4  = __attribute__((ext_vector_type(4))) unsigned;
constexpr int NW = 8, QBLK = 32, KVBLK = 64;
constexpr float SCALE = 0.10206207261596577f;
constexpr float THR = 8.f;
constexpr int SHM_K = KVBLK * 256, SHM_V = KVBLK * DV * 2, BUF = SHM_K + SHM_V, SHM_ATTN = 2 * BUF + NW * 64 * 4;
#define ATT_KSWZ(row, colB) ((row) * 256 + ((colB) ^ (((row) & 7) << 4)))
#define ATT_SBAR() __builtin_amdgcn_sched_barrier(0)
__device__ __forceinline__ int crow(int r, int hi) { return (r & 3) + 8 * (r >> 2) + 4 * hi; }
__device__ __forceinline__ unsigned cvtpk(float lo, float hi) { unsigned r; asm volatile("v_cvt_pk_bf16_f32 %0, %1, %2" : "=v"(r) : "v"(lo), "v"(hi)); return r; }
__device__ __forceinline__ void partialSM(f32x16& p0, f32x16& p1, float& m_reg, float& mn, float& alpha) {
  constexpr float C = SCALE * 1.4426950408889634f;
  float pmax = p0[0];
#pragma unroll
  for (int r = 1; r < 16; ++r) pmax = fmaxf(pmax, p0[r]);
#pragma unroll
  for (int r = 0; r < 16; ++r) pmax = fmaxf(pmax, p1[r]);
  { auto rr = __builtin_amdgcn_permlane32_swap(__float_as_uint(pmax), __float_as_uint(pmax), false, false);
    pmax = fmaxf(__uint_as_float(rr[0]), __uint_as_float(rr[1])); }
  if (__builtin_expect(__all(pmax - m_reg <= THR / SCALE), 1)) { mn = m_reg; alpha = 1.f; }
  else { mn = fmaxf(m_reg, pmax); alpha = __builtin_amdgcn_exp2f((m_reg - mn) * C); m_reg = mn; }
  const float mnC = -mn * C;
#pragma unroll
  for (int r = 0; r < 16; ++r) p0[r] = fmaf(p0[r], C, mnC);
#pragma unroll
  for (int r = 0; r < 16; ++r) p1[r] = fmaf(p1[r], C, mnC);
#pragma unroll
  for (int r = 0; r < 16; ++r) p0[r] = __builtin_amdgcn_exp2f(p0[r]);
}
__device__ __forceinline__ void finishSM(f32x16& p0, f32x16& p1, float alpha, float& l_reg, bf16x8& pa0, bf16x8& pa1, bf16x8& pa2, bf16x8& pa3) {
#pragma unroll
  for (int r = 0; r < 16; ++r) p1[r] = __builtin_amdgcn_exp2f(p1[r]);
  float ps = 0;
#pragma unroll
  for (int r = 0; r < 16; ++r) ps += p0[r];
#pragma unroll
  for (int r = 0; r < 16; ++r) ps += p1[r];
  { auto rr = __builtin_amdgcn_permlane32_swap(__float_as_uint(ps), __float_as_uint(ps), false, false);
    ps = __uint_as_float(rr[0]) + __uint_as_float(rr[1]); }
  l_reg = l_reg * alpha + ps;
#define ATT_PK4(P, BASE, OUT) do { unsigned a0 = cvtpk(P[BASE + 0], P[BASE + 1]), a1 = cvtpk(P[BASE + 2], P[BASE + 3]);   \
    unsigned b0 = cvtpk(P[BASE + 4], P[BASE + 5]), b1 = cvtpk(P[BASE + 6], P[BASE + 7]);                              \
    auto r0 = __builtin_amdgcn_permlane32_swap(a0, b0, false, false); auto r1 = __builtin_amdgcn_permlane32_swap(a1, b1, false, false); \
    u32x4 w = {r0[0], r1[0], r0[1], r1[1]}; OUT = *reinterpret_cast<bf16x8*>(&w); } while (0)
  ATT_PK4(p0, 0, pa0); ATT_PK4(p0, 8, pa1); ATT_PK4(p1, 0, pa2); ATT_PK4(p1, 8, pa3);
#undef ATT_PK4
}
__device__ __forceinline__ void qkt(f32x16& p0, f32x16& p1, const char* Ks, const bf16x8* qr, int r32, int hi) {
  p0 = f32x16{}; p1 = f32x16{};
#pragma unroll
  for (int d0 = 0; d0 < DQK / 16; ++d0) { const int cb = (d0 * 16 + hi * 8) * 2;
    const bf16x8 b0 = *reinterpret_cast<const bf16x8*>(Ks + ATT_KSWZ(r32, cb));
    const bf16x8 b1 = *reinterpret_cast<const bf16x8*>(Ks + ATT_KSWZ(32 + r32, cb));
    p0 = __builtin_amdgcn_mfma_f32_32x32x16_bf16(b0, qr[d0], p0, 0, 0, 0);
    p1 = __builtin_amdgcn_mfma_f32_32x32x16_bf16(b1, qr[d0], p1, 0, 0, 0); }
}
__device__ __forceinline__ int v_st(int k, int c) { const int kk = (k & ~0xC) | ((k & 4) << 1) | ((k & 8) >> 1); return ((kk >> 3) * 2 + (c >> 5)) * 512 + ((kk & 7) * 32 + (c & 31)) * 2; }
__device__ __forceinline__ int v_rd_base(int lane) { return ((lane & 3) << 3) | (((lane >> 2) & 3) << 6) | (((lane >> 4) & 1) << 5) | (((lane >> 5) & 1) << 8); }
constexpr int v_rd_off(int d0, int ks, int half) { return d0 * 512 + ks * 2048 + half * 1024; }
template <int OFF> __device__ __forceinline__ s16x4 tr_read(int vb) {
  s16x4 r; asm volatile("ds_read_b64_tr_b16 %0, %1 offset:%2" : "=&v"(r) : "v"(vb), "i"(OFF) : "memory"); return r;
}
template <int D0> __device__ __forceinline__ void pv_one(f32x16& od, int vb, bf16x8 pa0, bf16x8 pa1, bf16x8 pa2, bf16x8 pa3) {
  const s16x4 l0 = tr_read<v_rd_off(D0, 0, 0)>(vb), h0 = tr_read<v_rd_off(D0, 0, 1)>(vb), l1 = tr_read<v_rd_off(D0, 1, 0)>(vb), h1 = tr_read<v_rd_off(D0, 1, 1)>(vb);
  const s16x4 l2 = tr_read<v_rd_off(D0, 2, 0)>(vb), h2 = tr_read<v_rd_off(D0, 2, 1)>(vb), l3 = tr_read<v_rd_off(D0, 3, 0)>(vb), h3 = tr_read<v_rd_off(D0, 3, 1)>(vb);
  asm volatile("s_waitcnt lgkmcnt(0)" ::: "memory"); ATT_SBAR();
#define ATT_PK(L, H) (bf16x8){L[0], L[1], L[2], L[3], H[0], H[1], H[2], H[3]}
  od = __builtin_amdgcn_mfma_f32_32x32x16_bf16(pa0, ATT_PK(l0, h0), od, 0, 0, 0);
  od = __builtin_amdgcn_mfma_f32_32x32x16_bf16(pa1, ATT_PK(l1, h1), od, 0, 0, 0);
  od = __builtin_amdgcn_mfma_f32_32x32x16_bf16(pa2, ATT_PK(l2, h2), od, 0, 0, 0);
  od = __builtin_amdgcn_mfma_f32_32x32x16_bf16(pa3, ATT_PK(l3, h3), od, 0, 0, 0);
#undef ATT_PK
}
__device__ __forceinline__ void pv_d0(f32x16* o, int vb, bf16x8 pa0, bf16x8 pa1, bf16x8 pa2, bf16x8 pa3) {
  pv_one<0>(o[0], vb, pa0, pa1, pa2, pa3); pv_one<1>(o[1], vb, pa0, pa1, pa2, pa3);
}
__device__ __forceinline__ void attn_unit(const unsigned short* __restrict__ Qb, const unsigned short* __restrict__ KVh, unsigned short* __restrict__ Ob, int seq, char* lds, int tid) {
  const int wid = __builtin_amdgcn_readfirstlane(tid >> 6), lane = tid & 63, r32 = lane & 31, hi = lane >> 5;
  float* ws = (float*)(lds + 2 * BUF) + wid * 64; float* li_l = ws; float* al_l = ws + 32;
  float m_reg = -1e30f, l_reg = 0; f32x16 o[2] = {}; bf16x8 qr[DQK / 16];
  const unsigned short* Qw = Qb + (long)(wid * QBLK + r32) * 768 + hi * 8;
#pragma unroll
  for (int d0 = 0; d0 < DQK / 16; ++d0) qr[d0] = *reinterpret_cast<const bf16x8*>(Qw + d0 * 16);
  int dst[3];
#pragma unroll
  for (int i = 0; i < 3; ++i) { const int c = tid + 512 * i, row = c / 20, part = c % 20; dst[i] = part < 12 ? ATT_KSWZ(row, part * 16) : SHM_K + v_st(row, (part - 12) * 8); }
  const bool third = wid < 4;
  const char* src = (const char*)KVh + tid * 16;
  const int vb0 = (int)(uintptr_t)(lds + SHM_K) + v_rd_base(lane);
  bf16x8 sA0, sA1, sA2, sB0, sB1, sB2;
#define ATT_SLOAD(S, k0) do { const char* p_ = src + (long)(k0) * (KVW * 2); S##0 = *reinterpret_cast<const bf16x8*>(p_); S##1 = *reinterpret_cast<const bf16x8*>(p_ + 8192); \
    if (third) S##2 = *reinterpret_cast<const bf16x8*>(p_ + 16384); } while (0)
#define ATT_SWRITE(b, S) do { char* q_ = lds + (b) * BUF; *reinterpret_cast<bf16x8*>(q_ + dst[0]) = S##0; *reinterpret_cast<bf16x8*>(q_ + dst[1]) = S##1; \
    if (third) *reinterpret_cast<bf16x8*>(q_ + dst[2]) = S##2; } while (0)
#define ATT_RESC(a) do { if (__any((a) < 1.f)) { if (hi == 0) al_l[r32] = (a); asm volatile("s_waitcnt lgkmcnt(0)" ::: "memory"); \
    _Pragma("unroll") for (int d = 0; d < 2; ++d) _Pragma("unroll") for (int r = 0; r < 16; ++r) o[d][r] *= al_l[crow(r, hi)]; } } while (0)
  f32x16 pA0, pA1, pB0, pB1; float mnA, mnB, alA, alB; bf16x8 pa0, pa1, pa2, pa3; const int NT = seq / KVBLK;
  ATT_SLOAD(sA, 0); ATT_SWRITE(0, sA); __syncthreads();
  qkt(pA0, pA1, lds, qr, r32, hi); partialSM(pA0, pA1, m_reg, mnA, alA);
  ATT_SLOAD(sB, KVBLK); if (2 < NT) ATT_SLOAD(sA, 2 * KVBLK);
  ATT_SWRITE(1, sB); __syncthreads();
  for (int j = 1; j + 1 < NT; j += 2) {
    ATT_SBAR(); qkt(pB0, pB1, lds + BUF, qr, r32, hi);
    finishSM(pA0, pA1, alA, l_reg, pa0, pa1, pa2, pa3); ATT_SBAR();
    ATT_SLOAD(sB, (j + 2) * KVBLK); ATT_SBAR();
    pv_d0(o, vb0, pa0, pa1, pa2, pa3); partialSM(pB0, pB1, m_reg, mnB, alB);
    __syncthreads(); ATT_SWRITE(0, sA);
    ATT_RESC(alB); __syncthreads();
    ATT_SBAR(); qkt(pA0, pA1, lds, qr, r32, hi);
    finishSM(pB0, pB1, alB, l_reg, pa0, pa1, pa2, pa3); ATT_SBAR();
    if (j + 3 < NT) ATT_SLOAD(sA, (j + 3) * KVBLK); ATT_SBAR();
    pv_d0(o, vb0 + BUF, pa0, pa1, pa2, pa3); partialSM(pA0, pA1, m_reg, mnA, alA);
    __syncthreads(); ATT_SWRITE(1, sB);
    ATT_RESC(alA); __syncthreads();
  }
  ATT_SBAR(); qkt(pB0, pB1, lds + BUF, qr, r32, hi);
  finishSM(pA0, pA1, alA, l_reg, pa0, pa1, pa2, pa3); ATT_SBAR();
  pv_d0(o, vb0, pa0, pa1, pa2, pa3); partialSM(pB0, pB1, m_reg, mnB, alB);
  __syncthreads(); ATT_RESC(alB);
  finishSM(pB0, pB1, alB, l_reg, pa0, pa1, pa2, pa3); ATT_SBAR();
  pv_d0(o, vb0 + BUF, pa0, pa1, pa2, pa3);
  if (hi == 0) li_l[r32] = l_reg; asm volatile("s_waitcnt lgkmcnt(0)" ::: "memory");
  float rli[16];
#pragma unroll
  for (int r = 0; r < 16; ++r) rli[r] = __builtin_amdgcn_rcpf(li_l[crow(r, hi)]);
  unsigned short* Ow = Ob + (long)(wid * QBLK) * D;
#pragma unroll
  for (int r = 0; r < 16; ++r) { const int orow = crow(r, hi);
#pragma unroll
    for (int d0 = 0; d0 < 2; ++d0) { const float v = o[d0][r] * rli[r]; const unsigned u = __builtin_bit_cast(unsigned, v); Ow[(long)orow * D + d0 * 32 + r32] = (unsigned short)((u + 0x7fffu + ((u >> 16) & 1u)) >> 16); } }
  __syncthreads();
#undef ATT_SLOAD
#undef ATT_SWRITE
#undef ATT_RESC
}
#undef ATT_KSWZ
#undef ATT_SBAR
}
#define GAS __attribute__((address_space(1)))
#define LAS __attribute__((address_space(3)))
typedef unsigned short bf16;
typedef unsigned v4u __attribute__((ext_vector_type(4)));
typedef float f32x4 __attribute__((ext_vector_type(4)));
typedef short bf16x8 __attribute__((ext_vector_type(8)));
typedef GAS unsigned gu32;
typedef GAS unsigned long long gu64;
#define RLX_AGENT __ATOMIC_RELAXED, __HIP_MEMORY_SCOPE_AGENT
#define LDS_WAIT() asm volatile("s_waitcnt lgkmcnt(0)" ::: "memory")
#define VM_WAIT() asm volatile("s_waitcnt vmcnt(0)" ::: "memory")
__device__ __forceinline__ unsigned long long rt() { return __builtin_amdgcn_s_memrealtime(); }
__device__ __forceinline__ unsigned f2bf(float f) { unsigned u = __builtin_bit_cast(unsigned, f); return (u + 0x7fffu + ((u >> 16) & 1u)) >> 16; }
__device__ __forceinline__ unsigned pk2(float lo, float hi) { return f2bf(lo) | (f2bf(hi) << 16); }

#define XB_TMO      128
#define XB_XCNT(j)  (256  + 64 * (j))
#define XB_XSUB(j)  (1280 + 64 * (j))
#define XB_XGEN(j)  (2304 + 64 * (j))
#define XB_TOP      3328
#define XB_TOPGEN   3392
#define XCD_BAR_WORDS 3456
#define XB_SPIN_CAP (1u << 18)

__device__ __forceinline__ unsigned xb_ld(unsigned* p)              { return __hip_atomic_load(p, __ATOMIC_RELAXED, __HIP_MEMORY_SCOPE_AGENT); }
__device__ __forceinline__ unsigned xb_add(unsigned* p, unsigned v) { return __hip_atomic_fetch_add(p, v, __ATOMIC_RELAXED, __HIP_MEMORY_SCOPE_AGENT); }
__device__ __forceinline__ unsigned xb_xcc_id() { return (unsigned)__builtin_amdgcn_s_getreg((3 << 11) | 20) & 0xFu; }
#define XB_SPIN(cond, bar) do { unsigned _sp = 0; while (cond) { __builtin_amdgcn_s_sleep(1); \
    if ((++_sp & 255u) == 0u) { if (xb_ld(&(bar)[XB_TMO])) break; if (_sp > XB_SPIN_CAP) { atomicAdd(&(bar)[XB_TMO], 1u); break; } } } } while (0)

struct XcdBarrier {
    unsigned* bar; unsigned x;
    volatile LAS unsigned* st;
};

__device__ __forceinline__ XcdBarrier xcd_barrier_post(unsigned* bar, volatile LAS unsigned* st) {
    XcdBarrier b; b.bar = bar; b.x = xb_xcc_id(); b.st = st;
    if (threadIdx.x == 0) (void)xb_add(&bar[XB_XCNT(b.x)], 1u);
    return b;
}
__device__ __forceinline__ void xcd_barrier_complete(unsigned* bar, unsigned x, unsigned& nloc, unsigned& nx) {
    const unsigned G = gridDim.x * gridDim.y * gridDim.z;
    unsigned sum, cnt, mine, sp = 0u;
    for (;;) {
        sum = 0u; cnt = 0u; mine = 0u;
#pragma unroll
        for (unsigned j = 0; j < 16; ++j) { const unsigned c = xb_ld(&bar[XB_XCNT(j)]); sum += c; cnt += (c > 0u) ? 1u : 0u; mine = (j == x) ? c : mine; }
        if (sum == G) break;
        __builtin_amdgcn_s_sleep(1);
        if ((++sp & 255u) == 0u) { if (xb_ld(&bar[XB_TMO])) break; if (sp > XB_SPIN_CAP) { atomicAdd(&bar[XB_TMO], 1u); break; } }
    }
    nloc = mine > 0u ? mine : 1u; nx = cnt > 0u ? cnt : 1u;
}

__device__ __forceinline__ void xcd_barrier(const XcdBarrier& b) {
    asm volatile("s_waitcnt vmcnt(0)" ::: "memory");
    __syncthreads();
    if (threadIdx.x == 0) {
        unsigned* bar = b.bar;
        __builtin_amdgcn_s_waitcnt(0);
        unsigned nloc = b.st[0], nx = b.st[1];
        if (nloc == 0u) { xcd_barrier_complete(bar, b.x, nloc, nx); b.st[0] = nloc; b.st[1] = nx; }
        const unsigned old = xb_add(&bar[XB_XSUB(b.x)], 1u);
        const unsigned gen = old / nloc;
        if (old + 1u == (gen + 1u) * nloc) {
            __builtin_amdgcn_fence(__ATOMIC_RELEASE, "agent");
            asm volatile("s_waitcnt vmcnt(0)" ::: "memory");
            const unsigned og = xb_add(&bar[XB_TOP], 1u);
            const unsigned tg = og / nx;
            if (og + 1u == (tg + 1u) * nx) xb_add(&bar[XB_TOPGEN], 1u);
            else XB_SPIN(xb_ld(&bar[XB_TOPGEN]) == tg, bar);
            __builtin_amdgcn_fence(__ATOMIC_ACQUIRE, "agent");
            xb_add(&bar[XB_XGEN(b.x)], 1u);
            asm volatile("s_waitcnt vmcnt(0)" ::: "memory");
        } else {
            XB_SPIN(xb_ld(&bar[XB_XGEN(b.x)]) == gen, bar);
            __builtin_amdgcn_fence(__ATOMIC_ACQUIRE, "agent");
            asm volatile("s_waitcnt vmcnt(0)" ::: "memory");
        }
    }
    __syncthreads();
}
constexpr size_t MiB = 1u << 20;
constexpr size_t al4k(size_t x) { return (x + 4095) & ~(size_t)4095; }
constexpr int NFT = 260;
constexpr int XS_TILES = 268, HS_TILES = 134;
constexpr size_t WS_CTL = 0, CTL_BYTES = 1 * MiB;
constexpr size_t WS_MODS = WS_CTL + CTL_BYTES;
constexpr size_t WS_ROPEC = WS_MODS + al4k((size_t)DEPTH * 3 * 6 * D * 4);
constexpr size_t WS_ROPES = WS_ROPEC + al4k((size_t)SEQ * 16 * 4);
constexpr size_t WS_RSQ = WS_ROPES + al4k((size_t)SEQ * 16 * 4);
constexpr size_t WS_RSKV = WS_RSQ + al4k((size_t)MT * 4);
constexpr size_t WS_FPART = WS_RSKV + al4k((size_t)MT * 4);
constexpr size_t WS_TOKE = WS_FPART + al4k((size_t)NFT * 512 * 4);
constexpr size_t WS_TOKP = WS_TOKE + al4k((size_t)MT * 4);
constexpr size_t WS_TOKG = WS_TOKP + al4k((size_t)MT * 8);
constexpr size_t WS_XC = WS_TOKG + al4k((size_t)MT * 8);
constexpr size_t WS_WIN = WS_XC + al4k((size_t)NCTX * D * 4);
constexpr size_t WS_WUQ = WS_WIN + al4k((size_t)DEPTH * UW * D * 2);
constexpr size_t WS_WUKV = WS_WUQ + al4k((size_t)DEPTH * 768 * 384 * 2);
constexpr size_t WS_WPOOL = WS_WUKV + al4k((size_t)DEPTH * 1024 * 256 * 2);
constexpr size_t WS_WOUT = WS_WPOOL + al4k((size_t)DEPTH * 256 * 256 * 2);
constexpr size_t WS_WGU = WS_WOUT + al4k((size_t)DEPTH * D * D * 2);
constexpr size_t WS_WD = WS_WGU + al4k((size_t)2 * 2 * FF * D * 2);
constexpr size_t WS_MGU = WS_WD + al4k((size_t)2 * D * FF * 2);
constexpr size_t WS_MD = WS_MGU + al4k((size_t)2 * NEXP * 2 * FF * D * 2);
constexpr size_t WS_HF = WS_MD + al4k((size_t)2 * NEXP * D * FF * 2);
constexpr size_t WS_HFC = WS_HF + al4k((size_t)512 * SEQ * 4);
constexpr size_t WS_HN = WS_HFC + al4k((size_t)512 * CTXL * 4);
constexpr size_t WS_U = WS_HN + al4k((size_t)MT * D * 2);
constexpr size_t WS_DP = WS_U + al4k((size_t)MT * UW * 2);
constexpr size_t WS_Q = WS_DP + al4k((size_t)MT * 256 * 2);
constexpr size_t WS_KV = WS_Q + al4k((size_t)MT * 768 * 2);
constexpr size_t WS_MIX = WS_KV + al4k((size_t)NB * NHEAD * NKEY * KVW * 2);
constexpr size_t WS_ZT = WS_MIX + al4k((size_t)MT * D * 2);
constexpr size_t WS_ZCT = WS_ZT + al4k((size_t)NB * 256 * SEQ * 4);
constexpr size_t WS_YT = WS_ZCT + al4k((size_t)NB * 256 * CTXL * 4);
constexpr size_t WS_END = WS_YT + al4k((size_t)NB * 256 * SEQ * 4);
constexpr size_t WS_H = WS_U;
constexpr size_t WS_XS = WS_U;
constexpr size_t WS_HS = WS_XS + al4k((size_t)XS_TILES * 256 * D * 2);
static_assert(WS_H + (size_t)MT * FF * 2 <= WS_KV + (size_t)NB * NHEAD * NKEY * KVW * 2, "dense hidden overlay");
static_assert(WS_HS + (size_t)HS_TILES * 256 * FF * 2 <= WS_END, "MoE overlay");
constexpr int CW_TMO = 0, CW_BAR = 4096, CW_GCNT = 16384;
constexpr int RING_BYTES = 131072, MISC_OFF = RING_BYTES + 320, LDS_BYTES = 147456;

struct Args { const float* in[34]; float* out; unsigned char* ws; int ph_lo, ph_hi; };
enum { I_X = 0, I_C, I_CTX, I_CCTX, I_N1G, I_N2G, I_WADA, I_BADA, I_WIN, I_HSW, I_HSB, I_FW1, I_FB1, I_FF1, I_FW2, I_FB2, I_FF2, I_FW3, I_HBIAS, I_POOLW, I_POOLS, I_QNG, I_WUQ, I_KVNG, I_WUKV,
       I_WOUT, I_FWG, I_FWU, I_FWD, I_ROUTER, I_MWG, I_MWU, I_MWD, I_FING };

struct Ctx {
    float* out; unsigned char* ws; LAS unsigned char* lds; volatile LAS unsigned* MISC;
    __device__ __forceinline__ const float* in(int k) const { const __attribute__((address_space(4))) Args* a = (const __attribute__((address_space(4))) Args*)__builtin_amdgcn_kernarg_segment_ptr();
        asm volatile("" : "+s"(a)); return (const float*)(const GAS float*)a->in[k]; }
    int tid, lane, wave, vcu, G;
    template <typename T> __device__ __forceinline__ T* p(size_t off) const { return (T*)(ws + off); }
};

__device__ __forceinline__ float wave_sum(float v) {
#pragma unroll
    for (int o = 1; o < 64; o <<= 1) v += __shfl_xor(v, o);
    return v;
}
__device__ __forceinline__ float sin_turns(float x) { return __builtin_amdgcn_sinf(x); }
__device__ __forceinline__ float cos_turns(float x) { return __builtin_amdgcn_cosf(x); }
constexpr float INV_2PI = 0.15915494309189535f;
__device__ __forceinline__ float bf2f(unsigned short h) { return __uint_as_float((unsigned)h << 16); }
__device__ __forceinline__ void unpack8(const v4u w, float (&f)[8]) {
    f[0] = __uint_as_float(w.x << 16); f[1] = __uint_as_float(w.x & 0xffff0000u); f[2] = __uint_as_float(w.y << 16); f[3] = __uint_as_float(w.y & 0xffff0000u);
    f[4] = __uint_as_float(w.z << 16); f[5] = __uint_as_float(w.z & 0xffff0000u); f[6] = __uint_as_float(w.w << 16); f[7] = __uint_as_float(w.w & 0xffff0000u);
}
__device__ __forceinline__ v4u pack8f(const float (&f)[8]) { v4u o; o.x = pk2(f[0], f[1]); o.y = pk2(f[2], f[3]); o.z = pk2(f[4], f[5]); o.w = pk2(f[6], f[7]); return o; }

__device__ __forceinline__ int maprow(int mode, int n) {
    if (mode == 1) return 256 * (n >> 7) + (n & 127);
    if (mode == 2) return 256 * (n >> 7) + 128 + (n & 127);
    if (mode == 3) { const int h = n / DQK, d = n % DQK; if (d < 64) return n; const int r = d - 64, j = r & 15, g = j >> 2, i = j & 3; return h * DQK + 64 + 8 * g + (r < 16 ? 0 : 4) + i; }
    return n;
}
__device__ __forceinline__ void transpose_item(const float* W, int K, int N, bf16* WT, int mode, const float* kscale, LAS float* scr, int item, int lane) {
    const int nblk = N / 32, kb = item / nblk, nb = item % nblk, k0 = 64 * kb, n0 = 32 * nb;
#pragma unroll 8
    for (int i = 0; i < 32; ++i) { const int kk = 2 * i + (lane >> 5); float v = W[(size_t)(k0 + kk) * N + n0 + (lane & 31)]; if (kscale) v *= kscale[k0 + kk]; scr[kk * 33 + (lane & 31)] = v; }
    LDS_WAIT(); asm volatile("" ::: "memory");
    const int c = lane & 7;
#pragma unroll
    for (int j = 0; j < 4; ++j) { const int n = (lane >> 3) + 8 * j; const LAS float* s = scr + (8 * c) * 33 + n;
        v4u o; o.x = pk2(s[0 * 33], s[1 * 33]); o.y = pk2(s[2 * 33], s[3 * 33]); o.z = pk2(s[4 * 33], s[5 * 33]); o.w = pk2(s[6 * 33], s[7 * 33]);
        *(GAS v4u*)(WT + (size_t)maprow(mode, n0 + n) * K + k0 + 8 * c) = o; }
    LDS_WAIT(); asm volatile("" ::: "memory");
}
struct Cat { int count, per; const float* src; size_t sstride; int K, N; bf16* dst; size_t dstride; int mode; const float* ks; int kstride; };
__device__ __forceinline__ void p0_prologue(const Ctx& F) {
    LAS float* scr = (LAS float*)(F.lds + F.wave * 16384);
    const int gw = F.vcu * 8 + F.wave, NGW = F.G * 8;
    const Cat cats[11] = {
        {DEPTH, 16 * 53, F.in(I_WIN), (size_t)D * 1696, D, 1696, F.p<bf16>(WS_WIN), (size_t)UW * D, 0, nullptr, 0},
        {DEPTH, 6 * 24, F.in(I_WUQ), (size_t)384 * 768, 384, 768, F.p<bf16>(WS_WUQ), (size_t)768 * 384, 3, F.in(I_QNG), 384},
        {DEPTH, 4 * 32, F.in(I_WUKV), (size_t)256 * 1024, 256, 1024, F.p<bf16>(WS_WUKV), (size_t)1024 * 256, 0, F.in(I_KVNG), 256},
        {DEPTH, 16 * 32, F.in(I_WOUT), (size_t)D * D, D, D, F.p<bf16>(WS_WOUT), (size_t)D * D, 0, nullptr, 0},
        {2, 16 * 88, F.in(I_FWG), (size_t)D * FF, D, FF, F.p<bf16>(WS_WGU), (size_t)2 * FF * D, 1, nullptr, 0},
        {2, 16 * 88, F.in(I_FWU), (size_t)D * FF, D, FF, F.p<bf16>(WS_WGU), (size_t)2 * FF * D, 2, nullptr, 0},
        {2, 44 * 32, F.in(I_FWD), (size_t)FF * D, FF, D, F.p<bf16>(WS_WD), (size_t)D * FF, 0, nullptr, 0},
        {2 * NEXP, 16 * 88, F.in(I_MWG), (size_t)D * FF, D, FF, F.p<bf16>(WS_MGU), (size_t)2 * FF * D, 1, nullptr, 0},
        {2 * NEXP, 16 * 88, F.in(I_MWU), (size_t)D * FF, D, FF, F.p<bf16>(WS_MGU), (size_t)2 * FF * D, 2, nullptr, 0},
        {2 * NEXP, 44 * 32, F.in(I_MWD), (size_t)FF * D, FF, D, F.p<bf16>(WS_MD), (size_t)D * FF, 0, nullptr, 0},
        {0, 1, nullptr, 0, 0, 0, nullptr, 0, 0, nullptr, 0}};
    int total = 0;
#pragma unroll
    for (int k = 0; k < 10; ++k) total += cats[k].count * cats[k].per;
    for (int it = gw; it < total; it += NGW) {
        int r = it;
#pragma unroll
        for (int k = 0; k < 10; ++k) {
            const int n = cats[k].count * cats[k].per;
            if (r >= 0 && r < n) { const int mi = r / cats[k].per, item = r % cats[k].per;
                transpose_item(cats[k].src + mi * cats[k].sstride, cats[k].K, cats[k].N, cats[k].dst + mi * cats[k].dstride, cats[k].mode, cats[k].ks ? cats[k].ks + mi * cats[k].kstride : nullptr, scr, item, F.lane); }
            r -= n;
        }
    }
    const int gt = F.vcu * 512 + F.tid, NGT = F.G * 512;
    for (int i = gt; i < DEPTH * 96 * (D / 8); i += NGT) { const int l = i / (96 * (D / 8)), r = i % (96 * (D / 8)); *(GAS v4u*)(F.p<bf16>(WS_WIN) + ((size_t)l * UW + 1696) * D + (size_t)r * 8) = (v4u){0u, 0u, 0u, 0u}; }
    { const float* poolw = F.in(I_POOLW);
    for (int i = gt; i < DEPTH * 256 * 256; i += NGT) { const int l = i >> 16, n = (i >> 8) & 255, k = i & 255, g = n >> 6;
        const float v = (k >> 6) == g ? poolw[(((size_t)l * 4 + g) * 64 + (k & 63)) * 64 + (n & 63)] : 0.f; F.p<bf16>(WS_WPOOL)[i] = (bf16)f2bf(v); } }
    for (int i = gt; i < SEQ * 16; i += NGT) { const int t = i >> 4, j = i & 15; const int pos = j < 8 ? (t >> 6) : (t & 63);
        const float invf[8] = {1.0f, 0.31622776601683794f, 0.1f, 0.031622776601683791f, 0.01f, 0.0031622776601683794f, 0.001f, 0.00031622776601683794f};
        const float ang = (float)pos * invf[j & 7];
        const double tr = (double)ang * 0.15915494309189535; const float fr = (float)(tr - __builtin_floor(tr));
        F.p<float>(WS_ROPEC)[i] = cos_turns(fr); F.p<float>(WS_ROPES)[i] = sin_turns(fr); }
    { const GAS f32x4* s = (const GAS f32x4*)F.in(I_X); GAS f32x4* d = (GAS f32x4*)F.out; for (int i = gt; i < LAT * D / 4; i += NGT) d[i] = s[i];
      const GAS f32x4* s2 = (const GAS f32x4*)F.in(I_CTX); GAS f32x4* d2 = (GAS f32x4*)F.p<float>(WS_XC); for (int i = gt; i < NCTX * D / 4; i += NGT) d2[i] = s2[i]; }
    __syncthreads();
    LAS float* red = (LAS float*)F.lds;
    const float* cvec = F.in(I_C); const float* cctx = F.in(I_CCTX); const float* wada = F.in(I_WADA); const float* bada = F.in(I_BADA);
    for (int it = F.vcu; it < DEPTH * 96; it += F.G) {
        const int l = it / 96, n = (it % 96) * 64 + F.lane; const float* W = wada + (size_t)l * D * 6 * D + n;
        float a0 = 0.f, a1 = 0.f, a2 = 0.f;
#pragma unroll 8
        for (int kk = 0; kk < 128; ++kk) { const int k = F.wave * 128 + kk; const float w = W[(size_t)k * 6 * D];
            const float c0 = cvec[k], c1 = cvec[D + k], c2 = cctx[k];
            a0 += w * (c0 * __builtin_amdgcn_rcpf(1.f + __expf(-c0))); a1 += w * (c1 * __builtin_amdgcn_rcpf(1.f + __expf(-c1))); a2 += w * (c2 * __builtin_amdgcn_rcpf(1.f + __expf(-c2))); }
        red[(F.wave * 3 + 0) * 64 + F.lane] = a0; red[(F.wave * 3 + 1) * 64 + F.lane] = a1; red[(F.wave * 3 + 2) * 64 + F.lane] = a2;
        __syncthreads();
        if (F.tid < 192) { const int v = F.tid >> 6, ln = F.tid & 63; float s = 0.f;
#pragma unroll
            for (int w = 0; w < 8; ++w) s += red[(w * 3 + v) * 64 + ln];
            const int nn = (it % 96) * 64 + ln; F.p<float>(WS_MODS)[((size_t)l * 3 + v) * 6 * D + nn] = s + bada[(size_t)l * 6 * D + nn]; }
        __syncthreads();
    }
}

__device__ __forceinline__ void filter_tile(const Ctx& F, int l, int tile) {
    LAS float* feat = (LAS float*)F.lds;
    LAS float* h1 = feat + 64 * 33;
    LAS float* h2 = h1 + 64 * 64;
    const bool lat = tile < 256; const int L = lat ? SEQ : CTXL; const int p0 = (lat ? tile : tile - 256) * 64;
    const float invLm1 = 1.0f / (float)(L - 1), invL = 1.0f / (float)L;
    for (int idx = F.tid; idx < 64 * 33; idx += 512) { const int p = idx / 33, k = idx % 33; const float pos = (float)(p0 + p);
        float v;
        if (k == 0) v = pos * invLm1;
        else { const int j = (k - 1) & 15; const float fj = 1e-4f + (float)j * ((15.0f - 1e-4f) / 15.0f); const float x = fj * pos * invL; const float fr = x - __builtin_floorf(x);
            v = k <= 16 ? cos_turns(fr) : -sin_turns(fr); }
        feat[idx] = v; }
    __syncthreads();
    { const int j = F.tid & 63, pg = F.tid >> 6; const float* w1 = F.in(I_FW1) + (size_t)l * 33 * 64 + j; float w[33];
#pragma unroll
      for (int k = 0; k < 33; ++k) w[k] = w1[k * 64];
      const float b = F.in(I_FB1)[l * 64 + j], fq = F.in(I_FF1)[l * 64 + j];
#pragma unroll 1
      for (int pp = 0; pp < 8; ++pp) { const int p = pg * 8 + pp; float a = b;
#pragma unroll
          for (int k = 0; k < 33; ++k) a += feat[p * 33 + k] * w[k];
          const float x = fq * a * INV_2PI; h1[p * 64 + j] = sin_turns(x - __builtin_floorf(x)); } }
    __syncthreads();
    { const int j = F.tid & 63, pg = F.tid >> 6; const float* w2 = F.in(I_FW2) + (size_t)l * 64 * 64 + j; float w[64];
#pragma unroll
      for (int k = 0; k < 64; ++k) w[k] = w2[k * 64];
      const float b = F.in(I_FB2)[l * 64 + j], fq = F.in(I_FF2)[l * 64 + j];
#pragma unroll 1
      for (int pp = 0; pp < 8; ++pp) { const int p = pg * 8 + pp; float a = b;
#pragma unroll
          for (int k = 0; k < 64; ++k) a += h1[p * 64 + k] * w[k];
          const float x = fq * a * INV_2PI; h2[p * 64 + j] = sin_turns(x - __builtin_floorf(x)); } }
    __syncthreads();
    { const int n = F.tid; const float* w3 = F.in(I_FW3) + (size_t)l * 64 * 512 + n; float w[64];
#pragma unroll
      for (int k = 0; k < 64; ++k) w[k] = w3[k * 512];
      const int c = n & 255; const float dl = 3.0701134573253946f + (float)c * ((15.350567286626973f - 3.0701134573253946f) / 255.0f);
      float* dst = lat ? F.p<float>(WS_HF) + (size_t)n * SEQ + p0 : F.p<float>(WS_HFC) + (size_t)n * CTXL + p0;
      float asum = 0.f;
#pragma unroll 1
      for (int p4 = 0; p4 < 16; ++p4) { f32x4 o;
#pragma unroll
          for (int pp = 0; pp < 4; ++pp) { const int p = p4 * 4 + pp; float a = 0.f;
#pragma unroll
              for (int k = 0; k < 64; k += 4) { const f32x4 hv = *(const LAS f32x4*)(h2 + p * 64 + k); a += hv.x * w[k] + hv.y * w[k + 1] + hv.z * w[k + 2] + hv.w * w[k + 3]; }
              const float tt = (float)(p0 + p) * invLm1; const float v = a * __expf(-tt * dl); o[pp] = v;
              if (!(n >= 256 && p0 + p == 0)) asum += __builtin_fabsf(v); asm volatile("" ::: "memory"); }
          *(GAS f32x4*)(dst + p4 * 4) = o; }
      F.p<float>(WS_FPART)[(size_t)tile * 512 + n] = asum; }
    __syncthreads();
}

template <int WHICH, bool COMBINE, bool ROUTE>
__device__ __forceinline__ void norm_phase(const Ctx& F, int l, int lprev  , int moe_idx  ) {
    const int gw = F.vcu * 8 + F.wave, NGW = F.G * 8;
    const float* gain = WHICH == 0 ? F.in(I_N1G) + l * D : WHICH == 1 ? F.in(I_N2G) + l * D : F.in(I_FING);
    const float* mods = F.p<float>(WS_MODS) + (size_t)l * 3 * 6 * D;
    const float* modp = F.p<float>(WS_MODS) + (size_t)lprev * 3 * 6 * D + 5 * D;
    const int rows = WHICH == 2 ? LAT : MT;
    LAS float* wr_l = (LAS float*)F.lds;
    LAS int* lcnt = (LAS int*)(F.lds + 32768);
    LAS int* rec = (LAS int*)(F.lds + 32768 + 64);
    if (ROUTE) {
        const float* wr = F.in(I_ROUTER) + (size_t)moe_idx * D * NEXP;
        for (int i = F.tid; i < D * NEXP / 4; i += 512) ((LAS f32x4*)wr_l)[i] = ((const f32x4*)wr)[i];
        if (F.tid < 16) lcnt[F.tid] = 0;
        __syncthreads();
    }
    int ri = 0;
    for (int row = gw; row < rows; row += NGW, ++ri) {
        const int vsel = row < SEQ ? 0 : (row < LAT ? 1 : 2);
        float* xr = row < LAT ? F.out + (size_t)row * D : F.p<float>(WS_XC) + (size_t)(row - LAT) * D;
        f32x4 v[4];
#pragma unroll
        for (int j = 0; j < 4; ++j) v[j] = ((const GAS f32x4*)xr)[F.lane + 64 * j];
        if (COMBINE) {
            const int d0 = F.p<int>(WS_TOKP)[2 * row], d1 = F.p<int>(WS_TOKP)[2 * row + 1]; const float g0 = F.p<float>(WS_TOKG)[2 * row], g1 = F.p<float>(WS_TOKG)[2 * row + 1];
            const bf16* y0 = F.p<bf16>(WS_XS) + (size_t)d0 * D, *y1 = F.p<bf16>(WS_XS) + (size_t)d1 * D;
#pragma unroll
            for (int j = 0; j < 4; ++j) { const int col = 4 * F.lane + 256 * j; const uint2 a = *(const uint2*)(y0 + col), b = *(const uint2*)(y1 + col); const f32x4 m5 = *(const f32x4*)(modp + vsel * 6 * D + col);
                f32x4 ya = {__uint_as_float(a.x << 16), __uint_as_float(a.x & 0xffff0000u), __uint_as_float(a.y << 16), __uint_as_float(a.y & 0xffff0000u)};
                f32x4 yb = {__uint_as_float(b.x << 16), __uint_as_float(b.x & 0xffff0000u), __uint_as_float(b.y << 16), __uint_as_float(b.y & 0xffff0000u)};
                v[j] = v[j] + m5 * (ya * g0 + yb * g1); if (WHICH != 2) ((GAS f32x4*)xr)[F.lane + 64 * j] = v[j]; }
        }
        float s = 0.f;
#pragma unroll
        for (int j = 0; j < 4; ++j) s += (v[j].x * v[j].x + v[j].y * v[j].y) + (v[j].z * v[j].z + v[j].w * v[j].w);
        const float rstd = 1.0f / sqrtf(wave_sum(s) * (1.0f / D) + 1e-6f);
        if (WHICH == 2) {
#pragma unroll
            for (int j = 0; j < 4; ++j) { const f32x4 g = *(const f32x4*)(gain + 4 * F.lane + 256 * j); ((GAS f32x4*)xr)[F.lane + 64 * j] = v[j] * rstd * g; }
        } else {
            const float* sh = mods + vsel * 6 * D + (WHICH == 0 ? 0 : 3) * D; const float* sc = sh + D;
            bf16* hn = F.p<bf16>(WS_HN) + (size_t)row * D;
            float lg[8] = {0.f, 0.f, 0.f, 0.f, 0.f, 0.f, 0.f, 0.f};
#pragma unroll
            for (int j = 0; j < 4; ++j) { const int col = 4 * F.lane + 256 * j; const f32x4 g = *(const f32x4*)(gain + col), a = *(const f32x4*)(sh + col), b = *(const f32x4*)(sc + col);
                const f32x4 h = v[j] * rstd * g * (b + 1.0f) + a;
                *(uint2*)(hn + col) = make_uint2(pk2(h.x, h.y), pk2(h.z, h.w));
                if (ROUTE) {
#pragma unroll
                    for (int q = 0; q < 4; ++q) { const f32x4 w0 = *(const LAS f32x4*)(wr_l + (col + q) * 8), w1 = *(const LAS f32x4*)(wr_l + (col + q) * 8 + 4);
                        lg[0] += h[q] * w0.x; lg[1] += h[q] * w0.y; lg[2] += h[q] * w0.z; lg[3] += h[q] * w0.w; lg[4] += h[q] * w1.x; lg[5] += h[q] * w1.y; lg[6] += h[q] * w1.z; lg[7] += h[q] * w1.w; } } }
            if (ROUTE) {
#pragma unroll
                for (int e = 0; e < 8; ++e) lg[e] = wave_sum(lg[e]);
                int e0 = 0; float v0 = lg[0];
#pragma unroll
                for (int e = 1; e < 8; ++e) if (lg[e] > v0) { v0 = lg[e]; e0 = e; }
                int e1 = -1; float v1 = -3.0e38f;
#pragma unroll
                for (int e = 0; e < 8; ++e) if (e != e0 && lg[e] > v1) { v1 = lg[e]; e1 = e; }
                const float g1 = 1.0f / (1.0f + __expf(v0 - v1)), g0 = 1.0f - g1;
                if (F.lane == 0) { const int p0 = __hip_atomic_fetch_add(lcnt + e0, 1, __ATOMIC_RELAXED, __HIP_MEMORY_SCOPE_WORKGROUP), p1 = __hip_atomic_fetch_add(lcnt + e1, 1, __ATOMIC_RELAXED, __HIP_MEMORY_SCOPE_WORKGROUP);
                    LAS int* rc = rec + (F.wave * 20 + ri) * 3; rc[0] = e0 | (e1 << 8); rc[1] = p0; rc[2] = p1;
                    F.p<float>(WS_TOKG)[2 * row] = g0; F.p<float>(WS_TOKG)[2 * row + 1] = g1; }
            }
        }
    }
    if (ROUTE) {
        __syncthreads();
        if (F.tid < 8) lcnt[8 + F.tid] = (int)__hip_atomic_fetch_add(F.p<unsigned>(WS_CTL) + CW_GCNT + 64 * (8 * moe_idx + F.tid), (unsigned)lcnt[F.tid], __ATOMIC_RELAXED, __HIP_MEMORY_SCOPE_AGENT);
        __syncthreads();
        if (F.lane == 0) { int k = 0; for (int row = gw; row < rows; row += NGW, ++k) { const LAS int* rc = rec + (F.wave * 20 + k) * 3; const int ee = rc[0], e0 = ee & 255, e1 = ee >> 8;
            F.p<int>(WS_TOKE)[row] = ee; F.p<int>(WS_TOKP)[2 * row] = lcnt[8 + e0] + rc[1]; F.p<int>(WS_TOKP)[2 * row + 1] = lcnt[8 + e1] + rc[2]; } }
        __syncthreads();
    }
}
__device__ __forceinline__ void moe_tile_starts(const Ctx& F, int moe_idx, int (&ts)[9]) {
    int acc = 0;
#pragma unroll
    for (int e = 0; e < 8; ++e) { ts[e] = acc; const unsigned c = (unsigned)__builtin_amdgcn_readfirstlane((int)__hip_atomic_load(F.p<unsigned>(WS_CTL) + CW_GCNT + 64 * (8 * moe_idx + e), __ATOMIC_RELAXED, __HIP_MEMORY_SCOPE_AGENT)); acc += (int)((c + 255u) >> 8); }
    ts[8] = acc;
}
__device__ __forceinline__ void moe_scatter(const Ctx& F, int moe_idx) {
    int ts[9]; moe_tile_starts(F, moe_idx, ts);
    const int gw = F.vcu * 8 + F.wave, NGW = F.G * 8;
    for (int row = gw; row < MT; row += NGW) {
        const int ee = F.p<int>(WS_TOKE)[row], e0 = ee & 255, e1 = ee >> 8;
        int s0 = 0, s1 = 0;
#pragma unroll
        for (int e = 0; e < 8; ++e) { s0 = e == e0 ? ts[e] : s0; s1 = e == e1 ? ts[e] : s1; }
        const int d0 = s0 * 256 + F.p<int>(WS_TOKP)[2 * row], d1 = s1 * 256 + F.p<int>(WS_TOKP)[2 * row + 1];
        const GAS v4u* src = (const GAS v4u*)(F.p<bf16>(WS_HN) + (size_t)row * D); const v4u a = src[F.lane], b = src[64 + F.lane];
        GAS v4u* o0 = (GAS v4u*)(F.p<bf16>(WS_XS) + (size_t)d0 * D); GAS v4u* o1 = (GAS v4u*)(F.p<bf16>(WS_XS) + (size_t)d1 * D);
        o0[F.lane] = a; o0[64 + F.lane] = b; o1[F.lane] = a; o1[64 + F.lane] = b;
        if (F.lane == 0) { F.p<int>(WS_TOKP)[2 * row] = d0; F.p<int>(WS_TOKP)[2 * row + 1] = d1; }
    }
}
struct TileInfo { int r0, b, t0, L; bool lat; };
__device__ __forceinline__ TileInfo tile_info(int T) {
    TileInfo ti; ti.lat = T < 512;
    if (ti.lat) { ti.r0 = T * 64; ti.b = T >> 8; ti.t0 = (T & 255) * 64; ti.L = SEQ; }
    else { const int rc = (T - 512) * 64; ti.r0 = LAT + rc; ti.b = rc >> 8; ti.t0 = rc & 255; ti.L = CTXL; }
    return ti;
}
__device__ __forceinline__ void sconv8(const bf16* Urow0  , int t, int L, int col, const float* sw, const float* sb, float (&o)[8]) {
    float a[8], b[8], c[8];
    const v4u z = {0u, 0u, 0u, 0u};
    const v4u um = t > 0 ? *(const GAS v4u*)(Urow0 + (size_t)(t - 1) * UW + col) : z;
    const v4u u0 = *(const GAS v4u*)(Urow0 + (size_t)t * UW + col);
    const v4u up = t + 1 < L ? *(const GAS v4u*)(Urow0 + (size_t)(t + 1) * UW + col) : z;
    unpack8(um, a); unpack8(u0, b); unpack8(up, c);
    const f32x4 w0a = *(const f32x4*)(sw + col), w0b = *(const f32x4*)(sw + col + 4), w1a = *(const f32x4*)(sw + 768 + col), w1b = *(const f32x4*)(sw + 768 + col + 4),
                w2a = *(const f32x4*)(sw + 1536 + col), w2b = *(const f32x4*)(sw + 1536 + col + 4), ba = *(const f32x4*)(sb + col), bb = *(const f32x4*)(sb + col + 4);
#pragma unroll
    for (int i = 0; i < 4; ++i) { o[i] = a[i] * w0a[i] + b[i] * w1a[i] + c[i] * w2a[i] + ba[i]; o[4 + i] = a[4 + i] * w0b[i] + b[4 + i] * w1b[i] + c[4 + i] * w2b[i] + bb[i]; }
}
__device__ __forceinline__ void prep_phase(const Ctx& F, int l) {
    LAS float* zs = (LAS float*)F.lds;
    const bf16* U = F.p<bf16>(WS_U);
    const float* sw = F.in(I_HSW) + (size_t)l * 3 * 768; const float* sb = F.in(I_HSB) + (size_t)l * 768;
    for (int T = F.vcu; T < MT / 64; T += F.G) {
        const TileInfo ti = tile_info(T); const bf16* Us = U + (size_t)(ti.r0 - ti.t0) * UW;
#pragma unroll
        for (int i = 0; i < 4; ++i) { const int item = F.tid + 512 * i, tl = item >> 5, j = item & 31, t = ti.t0 + tl;
            float x1[8], vv[8]; sconv8(Us, t, ti.L, C_HY + 256 + 8 * j, sw, sb, x1); sconv8(Us, t, ti.L, C_HY + 512 + 8 * j, sw, sb, vv);
#pragma unroll
            for (int q = 0; q < 8; ++q) zs[tl * 257 + 8 * j + q] = x1[q] * vv[q];
            const int g = j >> 3, half = 1 << g; const int lo = t - half < 0 ? 0 : t - half, hi = t + half > ti.L ? ti.L : t + half;
            float acc[8] = {0.f, 0.f, 0.f, 0.f, 0.f, 0.f, 0.f, 0.f}, pt[8];
            for (int s = lo; s < hi; ++s) { float f[8]; unpack8(*(const GAS v4u*)(Us + (size_t)s * UW + C_POOL + 8 * j), f);
#pragma unroll
                for (int q = 0; q < 8; ++q) acc[q] += f[q]; }
            unpack8(*(const GAS v4u*)(Us + (size_t)t * UW + C_POOL + 8 * j), pt);
            const float inv = 1.0f / (float)(hi - lo);
#pragma unroll
            for (int q = 0; q < 8; ++q) acc[q] = acc[q] * inv - pt[q];
            *(GAS v4u*)(F.p<bf16>(WS_DP) + (size_t)(ti.r0 + tl) * 256 + 8 * j) = pack8f(acc); }
#pragma unroll 1
        for (int rr = 0; rr < 8; ++rr) { const int tl = F.wave * 8 + rr, row = ti.r0 + tl, t = ti.t0 + tl; const bf16* ur = U + (size_t)row * UW;
            float sq = 0.f, skv = 0.f;
            if (F.lane < 48) { float f[8]; unpack8(*(const GAS v4u*)(ur + C_CQ + 8 * F.lane), f);
#pragma unroll
                for (int q = 0; q < 8; ++q) sq += f[q] * f[q]; }
            if (F.lane < 32) { float f[8]; unpack8(*(const GAS v4u*)(ur + C_CKV + 8 * F.lane), f);
#pragma unroll
                for (int q = 0; q < 8; ++q) skv += f[q] * f[q]; }
            sq = wave_sum(sq); skv = wave_sum(skv);
            if (F.lane == 0) { F.p<float>(WS_RSQ)[row] = 1.0f / sqrtf(sq * (1.0f / 384.0f) + 1e-6f); F.p<float>(WS_RSKV)[row] = 1.0f / sqrtf(skv * (1.0f / 256.0f) + 1e-6f); }
            if (F.lane < 16) { const int h = F.lane >> 1, i = F.lane & 1; float x1[8], x2[8];
                unpack8(*(const GAS v4u*)(ur + C_KPE + 8 * i), x1); unpack8(*(const GAS v4u*)(ur + C_KPE + 16 + 8 * i), x2);
                if (ti.lat) { const float* cp = F.p<float>(WS_ROPEC) + t * 16 + 8 * i; const float* sp = F.p<float>(WS_ROPES) + t * 16 + 8 * i;
#pragma unroll
                    for (int q = 0; q < 8; ++q) { const float c = cp[q], s = sp[q], a = x1[q] * c - x2[q] * s, bb = x1[q] * s + x2[q] * c; x1[q] = a; x2[q] = bb; } }
                const float o0[8] = {x1[0], x1[1], x1[2], x1[3], x2[0], x2[1], x2[2], x2[3]}, o1[8] = {x1[4], x1[5], x1[6], x1[7], x2[4], x2[5], x2[6], x2[7]};
                const int key = ti.lat ? CTXL + t : t;
                bf16* dst = F.p<bf16>(WS_KV) + ((size_t)(ti.b * NHEAD + h) * NKEY + key) * KVW + 64 + 16 * i;
                *(GAS v4u*)dst = pack8f(o0); *(GAS v4u*)(dst + 8) = pack8f(o1); } }
        __syncthreads();
        { float* zt = ti.lat ? F.p<float>(WS_ZT) + (size_t)ti.b * 256 * SEQ + ti.t0 : F.p<float>(WS_ZCT) + (size_t)ti.b * 256 * CTXL + ti.t0; const int pitch = ti.lat ? SEQ : CTXL;
#pragma unroll 8
          for (int cc = 0; cc < 32; ++cc) { const int c = F.wave * 32 + cc; zt[(size_t)c * pitch + F.lane] = zs[F.lane * 257 + c]; } }
        __syncthreads();
    }
}
__device__ __forceinline__ void hyena_finalize(const Ctx& F, int l) {
    LAS float* ys = (LAS float*)F.lds;
    const bf16* U = F.p<bf16>(WS_U);
    const float* sw = F.in(I_HSW) + (size_t)l * 3 * 768; const float* sb = F.in(I_HSB) + (size_t)l * 768;
    for (int T = F.vcu; T < MT / 64; T += F.G) {
        const TileInfo ti = tile_info(T); const bf16* Us = U + (size_t)(ti.r0 - ti.t0) * UW;
        { const float* zt = ti.lat ? F.p<float>(WS_YT) + (size_t)ti.b * 256 * SEQ + ti.t0 : F.p<float>(WS_ZCT) + (size_t)ti.b * 256 * CTXL + ti.t0; const int pitch = ti.lat ? SEQ : CTXL;
#pragma unroll 8
          for (int cc = 0; cc < 32; ++cc) { const int c = F.wave * 32 + cc; ys[F.lane * 257 + c] = zt[(size_t)c * pitch + F.lane]; } }
        __syncthreads();
#pragma unroll
        for (int i = 0; i < 4; ++i) { const int item = F.tid + 512 * i, tl = item >> 5, j = item & 31, t = ti.t0 + tl;
            float x0[8]; sconv8(Us, t, ti.L, C_HY + 8 * j, sw, sb, x0);
#pragma unroll
            for (int q = 0; q < 8; ++q) x0[q] *= ys[tl * 257 + 8 * j + q];
            *(GAS v4u*)(F.p<bf16>(WS_MIX) + (size_t)(ti.r0 + tl) * D + 8 * j) = pack8f(x0); }
        __syncthreads();
    }
}

typedef float c32 __attribute__((ext_vector_type(2)));
__device__ __forceinline__ c32 cmul(c32 a, c32 b) { return (c32){a.x * b.x - a.y * b.y, a.x * b.y + a.y * b.x}; }
__device__ __forceinline__ c32 cis_turns(float x) { return (c32){cos_turns(x), sin_turns(x)}; }
constexpr int FN = SEQ;
__device__ __forceinline__ void fft_fwd(LAS c32* X, int tid) {
#pragma unroll 1
    for (int s = 0; s < 7; ++s) { const int q = 4096 >> (2 * s); const float invLs = -1.0f / (float)(4 * q);
#pragma unroll 2
        for (int it = 0; it < 8; ++it) { const int i = tid + 512 * it, j = i & (q - 1), base = ((i - j) << 2) + j;
            const c32 a0 = X[base], a1 = X[base + q], a2 = X[base + 2 * q], a3 = X[base + 3 * q];
            const c32 t0 = a0 + a2, t1 = a0 - a2, t2 = a1 + a3, t3 = a1 - a3;
            const c32 b0 = t0 + t2, b2 = t0 - t2, b1 = (c32){t1.x + t3.y, t1.y - t3.x}, b3 = (c32){t1.x - t3.y, t1.y + t3.x};
            const c32 w1 = cis_turns((float)j * invLs), w2 = cmul(w1, w1), w3 = cmul(w2, w1);
            X[base] = b0; X[base + q] = cmul(b1, w1); X[base + 2 * q] = cmul(b2, w2); X[base + 3 * q] = cmul(b3, w3); }
        __syncthreads(); }
}
__device__ __forceinline__ void fft_inv(LAS c32* X, int tid) {
#pragma unroll 1
    for (int s = 6; s >= 0; --s) { const int q = 4096 >> (2 * s); const float invLs = 1.0f / (float)(4 * q);
#pragma unroll 2
        for (int it = 0; it < 8; ++it) { const int i = tid + 512 * it, j = i & (q - 1), base = ((i - j) << 2) + j;
            const c32 w1 = cis_turns((float)j * invLs), w2 = cmul(w1, w1), w3 = cmul(w2, w1);
            const c32 a0 = X[base], a1 = cmul(X[base + q], w1), a2 = cmul(X[base + 2 * q], w2), a3 = cmul(X[base + 3 * q], w3);
            const c32 t0 = a0 + a2, t1 = a0 - a2, t2 = a1 + a3, t3 = a1 - a3;
            X[base] = t0 + t2; X[base + 2 * q] = t0 - t2; X[base + q] = (c32){t1.x - t3.y, t1.y + t3.x}; X[base + 3 * q] = (c32){t1.x + t3.y, t1.y - t3.x}; }
        __syncthreads(); }
}
__device__ __forceinline__ void hyena_fft_channel(const Ctx& F, int l, int c) {
    LAS c32* X = (LAS c32*)F.lds; const int tid = F.tid;
    const float* hf = F.p<float>(WS_HF) + (size_t)c * SEQ + tid; const float* hb = F.p<float>(WS_HF) + (size_t)(256 + c) * SEQ + SEQ - tid;
    const float* z0 = F.p<float>(WS_ZT) + (size_t)c * SEQ + tid; const float* z1 = z0 + (size_t)256 * SEQ;
    float* y0 = F.p<float>(WS_YT) + (size_t)c * SEQ + tid; float* y1 = y0 + (size_t)256 * SEQ;
    float nrm = 0.f; { const float* fp = F.p<float>(WS_FPART);
#pragma unroll
        for (int k = 0; k < 4; ++k) { const int tile = F.lane + 64 * k; nrm += fp[(size_t)tile * 512 + c] + fp[(size_t)tile * 512 + 256 + c]; }
        nrm = wave_sum(nrm); }
    const float scale = 1.0f / (nrm * 2.0f * (float)FN); const float bias = F.in(I_HBIAS)[l * 256 + c];
    c32 G[32];
#pragma unroll 1
    for (int pass = 0; pass < 2; ++pass) {
        const float sgn = pass == 0 ? 1.0f : -1.0f; const float tw = pass == 0 ? 0.0f : -1.0f / 32768.0f;
#pragma unroll 2
        for (int k = 0; k < 32; ++k) { const int n = tid + 512 * k; const float g = hf[512 * k] + sgn * (n > 0 ? hb[-512 * k] : 0.f); X[n] = cis_turns((float)n * tw) * g; }
        __syncthreads(); fft_fwd(X, tid);
#pragma unroll
        for (int k = 0; k < 32; ++k) G[k] = X[tid + 512 * k];
        __syncthreads();
#pragma unroll 2
        for (int k = 0; k < 32; ++k) { const int n = tid + 512 * k; const c32 u = {z0[512 * k], z1[512 * k]}; X[n] = cmul(u, cis_turns((float)n * tw)); }
        __syncthreads(); fft_fwd(X, tid);
#pragma unroll
        for (int k = 0; k < 32; ++k) { const int n = tid + 512 * k; X[n] = cmul(X[n], G[k]); if ((k & 7) == 7) asm volatile("" ::: "memory"); }
        __syncthreads(); fft_inv(X, tid);
        if (pass == 0) {
#pragma unroll 2
            for (int k = 0; k < 32; ++k) { const c32 y = X[tid + 512 * k] * scale; y0[512 * k] = y.x + bias * z0[512 * k]; y1[512 * k] = y.y + bias * z1[512 * k]; }
        } else {
#pragma unroll 2
            for (int k = 0; k < 32; ++k) { const int n = tid + 512 * k; const c32 y = cmul(X[n], cis_turns((float)n * (1.0f / 32768.0f))) * scale; y0[512 * k] += y.x; y1[512 * k] += y.y; }
        }
        __syncthreads();
    }
}
__device__ __forceinline__ void hyena_ctx_item(const Ctx& F, int l, int item) {
    LAS float* zs = (LAS float*)F.lds;
    LAS float* fs = zs + 256 * 32;
    LAS float* nr = fs + 511 * 32;
    const int b = item >> 3, c0 = (item & 7) * 32; float* zc = F.p<float>(WS_ZCT) + ((size_t)b * 256 + c0) * CTXL;
    for (int i = F.tid; i < 32 * 256; i += 512) { const int c = i >> 8, s = i & 255; zs[s * 32 + c] = zc[(size_t)c * CTXL + s]; }
    for (int i = F.tid; i < 32 * 511; i += 512) { const int c = i / 511, lg = i % 511 - 255;
        fs[(lg + 255) * 32 + c] = lg >= 0 ? F.p<float>(WS_HFC)[(size_t)(c0 + c) * CTXL + lg] : F.p<float>(WS_HFC)[(size_t)(256 + c0 + c) * CTXL - lg]; }
    if (F.tid < 32) { float s = 0.f; for (int tl = 256; tl < 260; ++tl) s += F.p<float>(WS_FPART)[(size_t)tl * 512 + c0 + F.tid] + F.p<float>(WS_FPART)[(size_t)tl * 512 + 256 + c0 + F.tid]; nr[F.tid] = 1.0f / s; }
    __syncthreads();
    const int c = F.tid & 31, tg = F.tid >> 5; const float bias = F.in(I_HBIAS)[l * 256 + c0 + c];
    float acc[16];
#pragma unroll
    for (int i = 0; i < 16; ++i) acc[i] = 0.f;
#pragma unroll 1
    for (int sb = 0; sb < 16; ++sb) { float w[31];
        const int lag0 = 16 * tg - (16 * sb + 15);
#pragma unroll
        for (int k = 0; k < 31; ++k) w[k] = fs[(lag0 + k + 255) * 32 + c];
#pragma unroll
        for (int ss = 0; ss < 16; ++ss) { const float zv = zs[(16 * sb + ss) * 32 + c];
#pragma unroll
            for (int i = 0; i < 16; ++i) acc[i] += zv * w[i - ss + 15]; } }
    const float inv = nr[c];
    float outv[16];
#pragma unroll
    for (int i = 0; i < 16; ++i) outv[i] = acc[i] * inv + bias * zs[(16 * tg + i) * 32 + c];
    __syncthreads();
#pragma unroll
    for (int i = 0; i < 16; ++i) zc[(size_t)c * CTXL + 16 * tg + i] = outv[i];
    __syncthreads();
}
#ifndef MK_PER_PHASE
#define MK_PER_PHASE 1
#endif
#ifndef MK_EN
#define MK_EN 0xFFFFFFFFu
#endif
#define EN(k) (((MK_EN) >> (k)) & 1u)
constexpr int N_PHASES = 1 + 2 * 9 + 2 * 12 + 1;

__global__ void __launch_bounds__(512, 2) mk_fwd(Args args) {
    extern __shared__ __attribute__((aligned(16))) unsigned char lds[];
    Ctx F0;
    F0.out = args.out; F0.ws = args.ws; F0.lds = (LAS unsigned char*)lds; F0.MISC = (volatile LAS unsigned*)(F0.lds + MISC_OFF);
    F0.tid = threadIdx.x; F0.lane = F0.tid & 63; F0.wave = __builtin_amdgcn_readfirstlane(F0.tid >> 6);
    F0.G = gridDim.x; { const int bx = blockIdx.x; F0.vcu = (F0.G % 8 == 0) ? (bx % 8) * (F0.G / 8) + bx / 8 : bx; }
#define PHASE_CTX() Ctx F = F0; { int t_ = F0.tid, v_ = F0.vcu; long z_ = 0; asm volatile("" : "+v"(t_), "+s"(v_), "+s"(z_)); \
        F.tid = t_; F.vcu = v_; F.ws = F0.ws + z_; F.out = F0.out + z_; F.lane = t_ & 63; F.wave = __builtin_amdgcn_readfirstlane(t_ >> 6); }
    { Ctx& F = F0;
    for (int u = F.tid; u < (LDS_BYTES - RING_BYTES) / 4; u += 512) ((LAS unsigned*)(F.lds + RING_BYTES))[u] = 0u;
    __syncthreads(); }
    gu32* ctl = (gu32*)(args.ws + WS_CTL);
    XcdBarrier bar = xcd_barrier_post((unsigned*)(ctl + CW_BAR), F0.MISC + 8);
    const int lo = args.ph_lo, hi = args.ph_hi; int pid = 0;
#define RUN() (lo <= pid && pid < hi)
#define SEAM() do { if (pid + 1 < hi) xcd_barrier(bar); } while (0)
    LAS unsigned char* ring = F0.lds;
    LAS int* tsl = (LAS int*)(F0.lds + MISC_OFF + 64);
    const int bid = (int)blockIdx.x;

    if (RUN()) { PHASE_CTX(); if (EN(0)) p0_prologue(F); SEAM(); } ++pid;

#pragma unroll 1
    for (int l = 0; l < DEPTH; ++l) {
        const bool moe = (l & 1) != 0; const int mi = l >> 1;
        if (RUN()) { PHASE_CTX();
            if (EN(1)) for (int tile = F.vcu; tile < NFT; tile += F.G) filter_tile(F, l, tile);
            if (EN(19)) { if (l > 0 && ((l - 1) & 1)) norm_phase<0, true, false>(F, l, l - 1, 0); else norm_phase<0, false, false>(F, l, 0, 0); }
            SEAM(); } ++pid;
        if (RUN()) { PHASE_CTX(); if (EN(2)) {
            pg8::Gemm g{F.p<bf16>(WS_HN), F.p<bf16>(WS_WIN) + (size_t)l * UW * D, MT, UW, D, D}; pg8::StaticOrder S; S.init(MT, UW, F.G, bid);
            pg8::EpiBf16<0> E{F.p<bf16>(WS_U), UW, nullptr, 0, 0, 1.f};
            pg8::gemm_phase<pg8::EpiBf16<0>, pg8::StaticOrder, true, true>(ring, g, S, E); }
            SEAM(); } ++pid;
        if (RUN()) { PHASE_CTX(); if (EN(3)) prep_phase(F, l); SEAM(); } ++pid;
        if (RUN()) { PHASE_CTX();
            if (EN(4)) for (int c = F.vcu; c < 256; c += F.G) hyena_fft_channel(F, l, c);
            if (EN(5)) for (int it = F.G - 1 - F.vcu; it < 2 * 8; it += F.G) hyena_ctx_item(F, l, it);
            if (EN(6)) { pg8::Gemm g{F.p<bf16>(WS_U) + C_CQ, F.p<bf16>(WS_WUQ) + (size_t)l * 768 * 384, MT, 768, 384, UW}; pg8::StaticOrder S; S.init(MT, 768, F.G, bid);
              pg8::EpiQRope E{F.p<bf16>(WS_Q), F.p<float>(WS_RSQ), F.p<float>(WS_ROPEC), F.p<float>(WS_ROPES)};
              pg8::gemm_phase<pg8::EpiQRope, pg8::StaticOrder, true, true>(ring, g, S, E); }
            if (EN(7)) { pg8::Gemm g{F.p<bf16>(WS_U) + C_CKV, F.p<bf16>(WS_WUKV) + (size_t)l * 1024 * 256, MT, 1024, 256, UW}; pg8::StaticOrder S; S.init(MT, 1024, F.G, bid);
              pg8::EpiKV E{F.p<bf16>(WS_KV), F.p<float>(WS_RSKV)};
              pg8::gemm_phase<pg8::EpiKV, pg8::StaticOrder, true, true>(ring, g, S, E); }
            if (EN(8)) { pg8::Gemm g{F.p<bf16>(WS_DP), F.p<bf16>(WS_WPOOL) + (size_t)l * 256 * 256, MT, 256, 256, 256}; pg8::StaticOrder S; S.init(MT, 256, F.G, bid);
              pg8::EpiColScale E{F.p<bf16>(WS_MIX) + 256, D, F.in(I_POOLS) + l * 256};
              pg8::gemm_phase<pg8::EpiColScale, pg8::StaticOrder, true, true>(ring, g, S, E); }
            SEAM(); } ++pid;
        if (RUN()) { PHASE_CTX();
            if (EN(9)) hyena_finalize(F, l);
            if (EN(10)) for (int u = F.vcu; u < 1024 + 16; u += F.G) {
                int b, h, row0, seq;
                if (u < 1024) { const int pair = u >> 6, qb = u & 63; b = pair >> 3; h = pair & 7; row0 = b * SEQ + qb * 256; seq = NKEY; }
                else { const int pair = u - 1024; b = pair >> 3; h = pair & 7; row0 = LAT + b * CTXL; seq = CTXL; }
                att::attn_unit(F.p<bf16>(WS_Q) + (size_t)row0 * 768 + h * DQK, F.p<bf16>(WS_KV) + (size_t)(b * NHEAD + h) * KV_HEAD_STRIDE, F.p<bf16>(WS_MIX) + (size_t)row0 * D + 512 + h * DV, seq, (char*)lds, F.tid);
            }
            SEAM(); } ++pid;
        if (RUN()) { PHASE_CTX(); if (EN(11)) {
            pg8::Gemm g{F.p<bf16>(WS_MIX), F.p<bf16>(WS_WOUT) + (size_t)l * D * D, MT, D, D, D}; pg8::StaticOrder S; S.init(MT, D, F.G, bid);
            pg8::EpiResGate E{F.out, F.p<float>(WS_XC), F.p<float>(WS_MODS) + (size_t)l * 3 * 6 * D + 2 * D};
            pg8::gemm_phase<pg8::EpiResGate, pg8::StaticOrder, true, true>(ring, g, S, E); }
            SEAM(); } ++pid;
        if (RUN()) { PHASE_CTX(); if (EN(12)) { if (moe) norm_phase<1, false, true>(F, l, 0, mi); else norm_phase<1, false, false>(F, l, 0, 0); } SEAM(); } ++pid;
        if (!moe) {
            if (RUN()) { PHASE_CTX(); if (EN(13)) {
                pg8::Gemm g{F.p<bf16>(WS_HN), F.p<bf16>(WS_WGU) + (size_t)mi * 2 * FF * D, MT, 2 * FF, D, D}; pg8::StaticOrder S; S.init(MT, 2 * FF, F.G, bid);
                pg8::EpiSwiGLU E{F.p<bf16>(WS_H)};
                pg8::gemm_phase<pg8::EpiSwiGLU, pg8::StaticOrder, true, true>(ring, g, S, E); }
                SEAM(); } ++pid;
            if (RUN()) { PHASE_CTX(); if (EN(14)) {
                pg8::Gemm g{F.p<bf16>(WS_H), F.p<bf16>(WS_WD) + (size_t)mi * D * FF, MT, D, FF, FF}; pg8::StaticOrder S; S.init(MT, D, F.G, bid);
                pg8::EpiResGate E{F.out, F.p<float>(WS_XC), F.p<float>(WS_MODS) + (size_t)l * 3 * 6 * D + 5 * D};
                pg8::gemm_phase<pg8::EpiResGate, pg8::StaticOrder, true, true>(ring, g, S, E); }
                SEAM(); } ++pid;
        } else {
            if (RUN()) { PHASE_CTX(); if (EN(15)) moe_scatter(F, mi); SEAM(); } ++pid;
#pragma unroll 1
            for (int ch = 0; ch < 2; ++ch) {
                int ts[9]; { PHASE_CTX(); moe_tile_starts(F, mi, ts); }
                const int Tn = ts[8] < XS_TILES ? ts[8] : XS_TILES, Th = Tn < HS_TILES ? Tn : HS_TILES; const int t0 = ch == 0 ? 0 : Th, nt = ch == 0 ? Th : Tn - Th;
                bf16* hs = F0.p<bf16>(WS_HS) - (size_t)t0 * 256 * FF;
                if (RUN()) { PHASE_CTX(); if (EN(16)) {
                    if (F.tid == 0) {
#pragma unroll
                        for (int e = 0; e < 9; ++e) tsl[e] = ts[e]; }
                    __syncthreads();
                    pg8::Gemm g{F.p<bf16>(WS_XS), F.p<bf16>(WS_MGU) + (size_t)mi * NEXP * 2 * FF * D, 0, 0, D, D}; pg8::MoeOrder<NJ_GU> S{t0, nt, F.G, bid, tsl};
                    pg8::EpiSwiGLU E{hs};
                    pg8::gemm_phase<pg8::EpiSwiGLU, pg8::MoeOrder<NJ_GU>, true, true>(ring, g, S, E); }
                    SEAM(); } ++pid;
                if (RUN()) { PHASE_CTX(); if (EN(17)) {
                    if (F.tid == 0) {
#pragma unroll
                        for (int e = 0; e < 9; ++e) tsl[e] = ts[e]; }
                    __syncthreads();
                    pg8::Gemm g{hs, F.p<bf16>(WS_MD) + (size_t)mi * NEXP * D * FF, 0, 0, FF, FF}; pg8::MoeOrder<4> S{t0, nt, F.G, bid, tsl};
                    pg8::EpiBf16<0> E{F.p<bf16>(WS_XS), D, nullptr, D, 0, 1.f};
                    pg8::gemm_phase<pg8::EpiBf16<0>, pg8::MoeOrder<4>, true, true>(ring, g, S, E); }
                    SEAM(); } ++pid;
            }
        }
    }
    if (RUN()) { PHASE_CTX(); if (EN(18)) norm_phase<2, true, false>(F, 0, DEPTH - 1, 0); } ++pid;
#undef RUN
#undef SEAM
}

extern "C" void kernel_launch(void* const* d_in, const int* in_sizes, int n_in, void* d_out, int out_size, void* d_ws, size_t ws_size, hipStream_t stream) {
    static int grid = 0;
    if (grid == 0) {
        if (n_in != 34 || in_sizes[0] != LAT * D || out_size != LAT * D || ws_size < WS_END) {
            fprintf(stderr, "kernel_launch: shape mismatch: n_in %d in0 %d out %d ws %zu (need %zu); nothing launched\n", n_in, n_in > 0 ? in_sizes[0] : -1, out_size, ws_size, (size_t)WS_END); grid = -1; return; }
        if (hipFuncSetAttribute((const void*)mk_fwd, hipFuncAttributeMaxDynamicSharedMemorySize, LDS_BYTES) != hipSuccess) { fprintf(stderr, "kernel_launch: hipFuncSetAttribute failed\n"); grid = -1; return; }
        int dev = 0, cus = 0; (void)hipGetDevice(&dev); (void)hipDeviceGetAttribute(&cus, hipDeviceAttributeMultiprocessorCount, dev);
        int per_cu = 0; (void)hipOccupancyMaxActiveBlocksPerMultiprocessor(&per_cu, (const void*)mk_fwd, 512, LDS_BYTES); (void)hipGetLastError();
        grid = (cus >= 256 && per_cu >= 1) ? 256 : (cus > 8 ? (cus / 8) * 8 : 8);
    }
    if (grid < 0) return;
    (void)hipMemsetAsync((char*)d_ws + WS_CTL, 0, CTL_BYTES, stream);
    Args a{};
    for (int i = 0; i < 34; ++i) a.in[i] = (const float*)d_in[i];
    a.out = (float*)d_out; a.ws = (unsigned char*)d_ws;
#if MK_PER_PHASE
    for (int p = 0; p < N_PHASES; ++p) { a.ph_lo = p; a.ph_hi = p + 1; hipLaunchKernelGGL(mk_fwd, dim3(grid), dim3(512), LDS_BYTES, stream, a); }
#else
    a.ph_lo = 0; a.ph_hi = N_PHASES; hipLaunchKernelGGL(mk_fwd, dim3(grid), dim3(512), LDS_BYTES, stream, a);
#endif
    const hipError_t le = hipPeekAtLastError();
    if (le != hipSuccess) fprintf(stderr, "kernel_launch: launch failed: %s\n", hipGetErrorName(le));
}
```

```cpp
#include <hip/hip_runtime.h>
#include <cstdio>
#include <cstdint>
namespace pg8 {
#define PG8_LAS __attribute__((address_space(3)))
typedef unsigned short bf16_t;
typedef short bf16x8 __attribute__((ext_vector_type(8)));
typedef float f32x4 __attribute__((ext_vector_type(4)));
typedef unsigned u32x4 __attribute__((ext_vector_type(4)));
constexpr int BM = 256, BK = 64, HALF = 128, HTB = HALF * BK * 2  , STAGE_BYTES = 8 * HTB, NXCD = 8, WGM = 8;

__host__ __device__ __forceinline__ int lds_byte(int r, int c) { const int st = (r >> 4) * 2 + (c >> 5), rr = r & 15, cc = c & 31, ob = rr * 64 + cc * 2; return st * 1024 + (ob ^ (((ob >> 9) & 1) << 5)); }
__host__ __device__ __forceinline__ void stage_rc(int b, int& R, int& C) { const int st = b / 1024, sb = b % 1024, swz = sb ^ (((sb >> 9) & 1) << 5); R = (st >> 1) * 16 + swz / 64; C = (st & 1) * 32 + (swz % 64) / 2; }
__host__ __device__ __forceinline__ int perm32(int rho) { const int n = rho >> 4, i = rho & 15; return 8 * (i >> 2) + 4 * n + (i & 3); }

struct Unit { int pm, pn, ko; };
struct Gemm { const bf16_t* A; const bf16_t* Bt; int M, N, K, lda, ldb; };

struct StaticOrder {
    int nM, nN, nwg, G, c;
    __host__ __device__ void init(int M, int N, int G_, int c_) { nM = M / BM; nN = N / BM; nwg = nM * nN; G = G_; c = c_; }
    __host__ __device__ bool next(int i, Unit& u) const {
        const long L = (long)i * G + c; if (L >= nwg) return false;
        int wgid = (int)L; { const int q = nwg / NXCD, r = nwg % NXCD, xcd = wgid % NXCD, off = wgid / NXCD; wgid = (xcd < r ? xcd * (q + 1) : r * (q + 1) + (xcd - r) * q) + off; }
        const int nig = WGM * nN, gid = wgid / nig, fm = gid * WGM, gsz = (nM - fm) < WGM ? (nM - fm) : WGM;
        u.pm = fm + ((wgid % nig) % gsz); u.pn = (wgid % nig) / gsz; u.ko = 0; return true;
    }
    __device__ __forceinline__ void a_ready(const Unit&) const {}
    __device__ __forceinline__ void done(const Unit&) const {}
};

__device__ __forceinline__ unsigned cvt_pk_bf16(float lo, float hi) { unsigned r; asm volatile("v_cvt_pk_bf16_f32 %0, %1, %2" : "=v"(r) : "v"(lo), "v"(hi)); return r; }
typedef float f32x2 __attribute__((ext_vector_type(2)));
__device__ __forceinline__ f32x2 gelu_pk(f32x2 v) {
    const f32x2 av = __builtin_elementwise_abs(v), d = av * 0.2316418882f + 1.0f;
    f32x2 t; t.x = __builtin_amdgcn_rcpf(d.x); t.y = __builtin_amdgcn_rcpf(d.y);
    f32x2 q = t * 0.5307027145f + (-0.7265760135f); q = q * t + 0.7107068705f; q = q * t + (-0.142248368f); q = q * t + 0.127414796f; q = q * t;
    const f32x2 s = (v * v) * (-0.72134752044f);
    f32x2 e; e.x = __builtin_amdgcn_exp2f(s.x); e.y = __builtin_amdgcn_exp2f(s.y);
    const f32x2 m = v * (q * e), r = v - m;
    f32x2 o; o.x = v.x < 0.f ? m.x : r.x; o.y = v.y < 0.f ? m.y : r.y; return o;
}

template <int ACT  > struct EpiBf16 {
    static constexpr bool PERM = true, AFTER_DRAIN = false; static_assert(ACT == 0 || ACT == 1, "EpiBf16: ACT is 0 (none) or 1 (gelu_pk)");
    bf16_t* O; int ldc; const float* bias; int split_cols; size_t split_stride; float scale0;
    __device__ __forceinline__ void operator()(const f32x4 (&acc)[2][2][4][2], const Unit& u, int wr, int wc, int fr, int fq) const {
        const int row0 = u.pm * BM + wr * 64 + fr; int colt = u.pn * BM; bf16_t* base = O;
        float sc = 1.f; if (split_cols) { const int t = colt / split_cols; base += (size_t)t * split_stride; colt -= t * split_cols; if (t == 0) sc = scale0; }
        const int col0 = colt + wc * 32 + 8 * fq, bcol0 = u.pn * BM + wc * 32 + 8 * fq;
        f32x4 bv[2][2];
#pragma unroll
        for (int bj = 0; bj < 2; ++bj)
#pragma unroll
            for (int n = 0; n < 2; ++n) bv[bj][n] = bias ? *(const f32x4*)(bias + bcol0 + bj * HALF + 4 * n) : (f32x4){0.f, 0.f, 0.f, 0.f};
#pragma unroll
        for (int ai = 0; ai < 2; ++ai)
#pragma unroll
            for (int m = 0; m < 4; ++m) { bf16_t* rowp = base + (size_t)(row0 + ai * HALF + m * 16) * ldc + col0;
#pragma unroll
                for (int bj = 0; bj < 2; ++bj) { f32x4 v0 = acc[ai][bj][m][0] + bv[bj][0], v1 = acc[ai][bj][m][1] + bv[bj][1];
                    if (ACT == 1) { f32x2 a = gelu_pk((f32x2){v0[0], v0[1]}), b = gelu_pk((f32x2){v0[2], v0[3]}), c = gelu_pk((f32x2){v1[0], v1[1]}), d = gelu_pk((f32x2){v1[2], v1[3]});
                        v0 = (f32x4){a.x, a.y, b.x, b.y}; v1 = (f32x4){c.x, c.y, d.x, d.y}; }
                    v0 = v0 * sc; v1 = v1 * sc; u32x4 w; w.x = cvt_pk_bf16(v0[0], v0[1]); w.y = cvt_pk_bf16(v0[2], v0[3]); w.z = cvt_pk_bf16(v1[0], v1[1]); w.w = cvt_pk_bf16(v1[2], v1[3]);
                    *(u32x4*)(rowp + bj * HALF) = w; } }
    }
};

struct PanelStats {
    unsigned* xbuf;
    unsigned* cnt;
    unsigned* tmo;
    int ntn; float eps;
    unsigned code;
    __device__ __forceinline__ bool run(const f32x4 (&v)[2][2][4][2], const Unit& u, int wr, int wc, int fr, int fq, PG8_LAS unsigned char* lds, int wid, int lane) const {
        typedef float f32x2v __attribute__((ext_vector_type(2)));
        PG8_LAS f32x2v* P = (PG8_LAS f32x2v*)lds;
        PG8_LAS f32x2v* S = (PG8_LAS f32x2v*)(lds + 8192);
        PG8_LAS unsigned* flag = (PG8_LAS unsigned*)(lds + 8192 + 2048);
#pragma unroll
        for (int ai = 0; ai < 2; ++ai)
#pragma unroll
            for (int m = 0; m < 4; ++m) {
                float s = 0.f;
#pragma unroll
                for (int bj = 0; bj < 2; ++bj)
#pragma unroll
                    for (int n = 0; n < 2; ++n) { const f32x4 x = v[ai][bj][m][n]; s += (x[0] + x[1]) + (x[2] + x[3]); }
                s += __shfl_xor(s, 16); s += __shfl_xor(s, 32);
                const float mw = s * (1.0f / 64.0f); float q = 0.f;
#pragma unroll
                for (int bj = 0; bj < 2; ++bj)
#pragma unroll
                    for (int n = 0; n < 2; ++n) { const f32x4 d = v[ai][bj][m][n] - mw; q += (d[0] * d[0] + d[1] * d[1]) + (d[2] * d[2] + d[3] * d[3]); }
                q += __shfl_xor(q, 16); q += __shfl_xor(q, 32);
                if (fq == 0) P[(ai * HALF + wr * 64 + m * 16 + fr) * 4 + wc] = (f32x2v){mw, q};
            }
        asm volatile("s_waitcnt lgkmcnt(0)" ::: "memory"); __builtin_amdgcn_s_barrier(); asm volatile("" ::: "memory");
#if defined(BROKEN_EXCHANGE_NO_WAIT)
#warning BROKEN CONTROL BUILD: the row-statistics exchange does not wait; results are wrong by design
        if (blockIdx.x >= 64) { const long long t0_ = clock64(); while (clock64() - t0_ < 60000) __builtin_amdgcn_s_sleep(8); }
#endif
        const int row = wid * 32 + (lane & 31);
        if (lane < 32) {
            const f32x2v a = P[row * 4 + 0], b = P[row * 4 + 1], c = P[row * 4 + 2], d = P[row * 4 + 3];
            const float mt = (a.x + b.x + c.x + d.x) * 0.25f;
            const float da = a.x - mt, db = b.x - mt, dc = c.x - mt, dd = d.x - mt;
            const float m2 = (a.y + b.y) + (c.y + d.y) + 64.0f * ((da * da + db * db) + (dc * dc + dd * dd));
            unsigned long long* slot = (unsigned long long*)xbuf + ((size_t)(u.pm * BM + row) * 4 + u.pn);
            __hip_atomic_store(slot, ((unsigned long long)__float_as_uint(m2) << 32) | __float_as_uint(mt), __ATOMIC_RELAXED, __HIP_MEMORY_SCOPE_AGENT);
        }
        asm volatile("s_waitcnt vmcnt(0)" ::: "memory");
        if (lane == 0) __hip_atomic_fetch_add(cnt + 64 * u.pm, 1u, __ATOMIC_RELAXED, __HIP_MEMORY_SCOPE_AGENT);
        if (wid == 0) {
            bool dead = false; const unsigned long long t0 = __builtin_amdgcn_s_memrealtime(); const unsigned want = 8u * (unsigned)ntn;
            for (;;) {
#if defined(BROKEN_EXCHANGE_NO_WAIT)
                break;
#endif
                if ((unsigned)__builtin_amdgcn_readfirstlane(__hip_atomic_load(cnt + 64 * u.pm, __ATOMIC_RELAXED, __HIP_MEMORY_SCOPE_AGENT)) >= want) break;
                if (__builtin_amdgcn_s_memrealtime() - t0 > 2000000ull) {
                    if (lane == 0) { unsigned expect = 0u; __hip_atomic_compare_exchange_strong(tmo + 1, &expect, code | (unsigned)(u.pm & 0xff), __ATOMIC_RELAXED, __ATOMIC_RELAXED, __HIP_MEMORY_SCOPE_AGENT);
                                     __hip_atomic_store(tmo, 1u, __ATOMIC_RELAXED, __HIP_MEMORY_SCOPE_AGENT); }
                    dead = true; break; }
                __builtin_amdgcn_s_sleep(2);
            }
            __builtin_amdgcn_fence(__ATOMIC_ACQUIRE, "agent");
            if (lane == 0) flag[0] = dead ? 1u : 0u;
        }
        asm volatile("s_waitcnt vmcnt(0) lgkmcnt(0)" ::: "memory"); __builtin_amdgcn_s_barrier(); asm volatile("" ::: "memory");
        const bool bad = flag[0] != 0u;
        if (lane < 32) {
            const unsigned long long* slot = (const unsigned long long*)xbuf + (size_t)(u.pm * BM + row) * 4; float mt[4], m2[4]; float ms = 0.f;
#pragma unroll
            for (int t = 0; t < 4; ++t) { if (t < ntn) { const unsigned long long w = __hip_atomic_load(slot + t, __ATOMIC_RELAXED, __HIP_MEMORY_SCOPE_AGENT); mt[t] = __uint_as_float((unsigned)w); m2[t] = __uint_as_float((unsigned)(w >> 32)); } else { mt[t] = 0.f; m2[t] = 0.f; } ms += mt[t]; }
            const float mean = ms / (float)ntn; float q = 0.f;
#pragma unroll
            for (int t = 0; t < 4; ++t) if (t < ntn) { const float dm = mt[t] - mean; q += m2[t] + 256.0f * dm * dm; }
            S[row] = (f32x2v){mean, 1.0f / sqrtf(q / (256.0f * (float)ntn) + eps)};
        }
        asm volatile("s_waitcnt lgkmcnt(0)" ::: "memory"); __builtin_amdgcn_s_barrier(); asm volatile("" ::: "memory");
        return bad;
    }
};
struct EpiLnRes {
    static constexpr bool PERM = false, AFTER_DRAIN = true;
    const float* base; float* out; int ldc; const float* bias; PanelStats st; unsigned poison;
    __device__ __forceinline__ void fused(f32x4 (&acc)[2][2][4][2], const Unit& u, int wr, int wc, int fr, int fq, PG8_LAS unsigned char* lds, int wid, int lane) const {
        typedef float f32x2v __attribute__((ext_vector_type(2)));
        const PG8_LAS f32x2v* S = (const PG8_LAS f32x2v*)(lds + 8192);
        const int col0 = u.pn * BM + wc * 32 + 4 * fq;
#pragma unroll
        for (int bj = 0; bj < 2; ++bj)
#pragma unroll
            for (int n = 0; n < 2; ++n) { const f32x4 bv = bias ? *(const f32x4*)(bias + col0 + bj * HALF + n * 16) : (f32x4){0.f, 0.f, 0.f, 0.f};
#pragma unroll
                for (int ai = 0; ai < 2; ++ai)
#pragma unroll
                    for (int m = 0; m < 4; ++m) acc[ai][bj][m][n] += bv; }
        f32x4 pre[4][2][2];
#pragma unroll
        for (int m = 0; m < 4; ++m) { const size_t off = (size_t)(u.pm * BM + wr * 64 + m * 16 + fr) * ldc + col0;
#pragma unroll
            for (int bj = 0; bj < 2; ++bj)
#pragma unroll
                for (int n = 0; n < 2; ++n) pre[m][bj][n] = *(const f32x4*)(base + off + bj * HALF + n * 16); }
        const bool bad = st.run(acc, u, wr, wc, fr, fq, lds, wid, lane) || poison != 0u;
        const float qnan = __builtin_nanf("");
#pragma unroll
        for (int ai = 0; ai < 2; ++ai)
#pragma unroll
            for (int m = 0; m < 4; ++m) { const int r = ai * HALF + wr * 64 + m * 16 + fr; const f32x2v sr = S[r]; const size_t off = (size_t)(u.pm * BM + r) * ldc + col0;
#pragma unroll
                for (int bj = 0; bj < 2; ++bj)
#pragma unroll
                    for (int n = 0; n < 2; ++n) { const f32x4 bs = ai == 0 ? pre[m][bj][n] : *(const f32x4*)(base + off + bj * HALF + n * 16); f32x4 o = bs + (acc[ai][bj][m][n] - sr.x) * sr.y;
                        if (bad) o = (f32x4){qnan, qnan, qnan, qnan}; *(f32x4*)(out + off + bj * HALF + n * 16) = o; }
                if (m & 1) asm volatile("" ::: "memory"); }
    }
};
struct EpiLnResLn {
    static constexpr bool PERM = false, AFTER_DRAIN = true;
    const float* base; float* out; bf16_t* xn; int ldc; const float* bias; PanelStats st1, st2; unsigned poison;
    __device__ __forceinline__ void fused(f32x4 (&acc)[2][2][4][2], const Unit& u, int wr, int wc, int fr, int fq, PG8_LAS unsigned char* lds, int wid, int lane) const {
        typedef float f32x2v __attribute__((ext_vector_type(2))); typedef unsigned u32x2v __attribute__((ext_vector_type(2)));
        const PG8_LAS f32x2v* S = (const PG8_LAS f32x2v*)(lds + 8192);
        const int col0 = u.pn * BM + wc * 32 + 4 * fq;
#pragma unroll
        for (int bj = 0; bj < 2; ++bj)
#pragma unroll
            for (int n = 0; n < 2; ++n) { const f32x4 bv = bias ? *(const f32x4*)(bias + col0 + bj * HALF + n * 16) : (f32x4){0.f, 0.f, 0.f, 0.f};
#pragma unroll
                for (int ai = 0; ai < 2; ++ai)
#pragma unroll
                    for (int m = 0; m < 4; ++m) acc[ai][bj][m][n] += bv; }
        bool bad = st1.run(acc, u, wr, wc, fr, fq, lds, wid, lane) || poison != 0u;
        const float qnan = __builtin_nanf("");
#pragma unroll
        for (int ai = 0; ai < 2; ++ai)
#pragma unroll
            for (int m = 0; m < 4; ++m) { const int r = ai * HALF + wr * 64 + m * 16 + fr; const f32x2v sr = S[r]; const size_t off = (size_t)(u.pm * BM + r) * ldc + col0;
#pragma unroll
                for (int bj = 0; bj < 2; ++bj)
#pragma unroll
                    for (int n = 0; n < 2; ++n) { const f32x4 bs = *(const f32x4*)(base + off + bj * HALF + n * 16); acc[ai][bj][m][n] = bs + (acc[ai][bj][m][n] - sr.x) * sr.y; }
                asm volatile("" : "+v"(acc[ai][0][m][0]), "+v"(acc[ai][0][m][1]), "+v"(acc[ai][1][m][0]), "+v"(acc[ai][1][m][1]));
                if (m & 1) asm volatile("" ::: "memory"); }
        const bool bad1 = bad;
        bad = st2.run(acc, u, wr, wc, fr, fq, lds, wid, lane) || bad;
#pragma unroll
        for (int ai = 0; ai < 2; ++ai)
#pragma unroll
            for (int m = 0; m < 4; ++m) { const int r = ai * HALF + wr * 64 + m * 16 + fr; const f32x2v sr = S[r]; const size_t off = (size_t)(u.pm * BM + r) * ldc + col0;
#pragma unroll
                for (int bj = 0; bj < 2; ++bj)
#pragma unroll
                    for (int n = 0; n < 2; ++n) { const f32x4 x1 = acc[ai][bj][m][n]; *(f32x4*)(out + off + bj * HALF + n * 16) = bad1 ? (f32x4){qnan, qnan, qnan, qnan} : x1;
                        const f32x4 o = (x1 - sr.x) * sr.y; u32x2v w; w.x = cvt_pk_bf16(o[0], o[1]); w.y = cvt_pk_bf16(o[2], o[3]);
                        if (bad) { w.x = 0x7fc07fc0u; w.y = 0x7fc07fc0u; } *(u32x2v*)(xn + off + bj * HALF + n * 16) = w; }
                asm volatile("" ::: "memory"); }
    }
};

template <class Epi, class Sched, bool ALIGN_EPI = false, bool SP2 = false>
__device__ __forceinline__ void gemm_phase(PG8_LAS unsigned char* lds, const Gemm g, const Sched& S, const Epi& E, int tid_in) {
    int tid_ = tid_in; asm volatile("" : "+v"(tid_));
    const int tid = tid_, wid = __builtin_amdgcn_readfirstlane(tid >> 6), lane = tid & 63, wr = wid >> 2, wc = wid & 3, fr = lane & 15, fq = lane >> 4;
    int K_ = g.K; asm volatile("" : "+s"(K_)); const int K = K_, nt = K / BK;
    unsigned voffA[2], voffB[2];
#pragma unroll
    for (int i = 0; i < 2; ++i) { int R, C; stage_rc(tid * 16 + i * 8192, R, C); const int Rb = Epi::PERM ? ((R & ~31) + perm32(R & 31)) : R;
        voffA[i] = (unsigned)(R * g.lda + C) * 2u; voffB[i] = (unsigned)(Rb * g.ldb + C) * 2u; }
    const size_t kstep = (size_t)(BK * 2);
    const size_t hstepA = (size_t)HALF * g.lda * 2, hstepB = (size_t)HALF * g.ldb * 2;
    const size_t tstepA = 2 * hstepA, tstepB = 2 * hstepB;
    const unsigned ldsw = (unsigned)wid * 1024u;
    const int aoff = lds_byte(wr * 64 + fr, fq * 8), boff = lds_byte(wc * 32 + fr, fq * 8);
#define PG8_SA(b, h) (((b) * 2 + (h)) * HTB)
#define PG8_SB(b, h) ((4 + (b) * 2 + (h)) * HTB)
#define PG8_STAGE(bufoff, gbase, voff) do { _Pragma("unroll") for (int _i = 0; _i < 2; ++_i) \
        __builtin_amdgcn_global_load_lds((const unsigned*)((const char*)(gbase) + (voff)[_i]), (PG8_LAS unsigned*)(lds + (bufoff) + ldsw + _i * 8192), 16, 0, 0); } while (0)
#define PG8_LDA(dst, b, h) do { _Pragma("unroll") for (int m = 0; m < 4; ++m) _Pragma("unroll") for (int k = 0; k < 2; ++k) dst[m][k] = *(const PG8_LAS bf16x8*)(lds + PG8_SA(b, h) + aoff + m * 2048 + k * 1024); } while (0)
#define PG8_LDB(dst, b, h) do { _Pragma("unroll") for (int n = 0; n < 2; ++n) _Pragma("unroll") for (int k = 0; k < 2; ++k) dst[n][k] = *(const PG8_LAS bf16x8*)(lds + PG8_SB(b, h) + boff + n * 2048 + k * 1024); } while (0)
#define PG8_MMA(ai, bj, At, Bt) do { __builtin_amdgcn_s_setprio(1); _Pragma("unroll") for (int m = 0; m < 4; ++m) _Pragma("unroll") for (int n = 0; n < 2; ++n) _Pragma("unroll") for (int k = 0; k < 2; ++k) \
        acc[ai][bj][m][n] = __builtin_amdgcn_mfma_f32_16x16x32_bf16(Bt[n][k], At[m][k], acc[ai][bj][m][n], 0, 0, 0); __builtin_amdgcn_s_setprio(0); } while (0)
#define PG8_WAIT_V(n) asm volatile("s_waitcnt vmcnt(" #n ")" ::: "memory")
#define PG8_WAIT_L(n) asm volatile("s_waitcnt lgkmcnt(" #n ")" ::: "memory")
#define PG8_BAR __builtin_amdgcn_s_barrier()
#define PG8_SCHED __builtin_amdgcn_sched_barrier(0)
    Unit cur, nxt; int ui = 0;
    if (!S.next(0, cur)) return;
    f32x4 acc[2][2][4][2];
#pragma unroll
    for (int a = 0; a < 2; ++a)
#pragma unroll
        for (int b = 0; b < 2; ++b)
#pragma unroll
            for (int m = 0; m < 4; ++m)
#pragma unroll
                for (int n = 0; n < 2; ++n) acc[a][b][m][n] = (f32x4){0.f, 0.f, 0.f, 0.f};
    bf16x8 At[4][2], B0[2][2], B1[2][2];
    const char* cA = (const char*)g.A + (size_t)cur.pm * tstepA + (size_t)cur.ko * 2; const char* cB = (const char*)g.Bt + (size_t)cur.pn * tstepB + (size_t)cur.ko * 2;
    S.a_ready(cur);
    if constexpr (SP2) {
        PG8_STAGE(PG8_SB(0, 0), cB, voffB); PG8_STAGE(PG8_SB(0, 1), cB + hstepB, voffB); PG8_STAGE(PG8_SA(0, 0), cA, voffA); PG8_STAGE(PG8_SA(0, 1), cA + hstepA, voffA);
        if (wr == 1) PG8_BAR;
        PG8_WAIT_V(2); PG8_BAR;
        PG8_STAGE(PG8_SB(1, 0), cB + kstep, voffB); PG8_STAGE(PG8_SA(1, 0), cA + kstep, voffA); PG8_STAGE(PG8_SB(1, 1), cB + hstepB + kstep, voffB);
        PG8_WAIT_V(6); PG8_BAR;
    } else {
        PG8_STAGE(PG8_SB(0, 0), cB, voffB); PG8_STAGE(PG8_SA(0, 0), cA, voffA); PG8_STAGE(PG8_SB(0, 1), cB + hstepB, voffB); PG8_STAGE(PG8_SA(0, 1), cA + hstepA, voffA);
        if (wr == 1) PG8_BAR;
        PG8_WAIT_V(4); PG8_BAR;
        PG8_STAGE(PG8_SB(1, 0), cB + kstep, voffB); PG8_STAGE(PG8_SA(1, 0), cA + kstep, voffA); PG8_STAGE(PG8_SB(1, 1), cB + hstepB + kstep, voffB);
        PG8_WAIT_V(6); PG8_BAR;
    }
    for (;;) {
        const bool has_next = S.next(ui + 1, nxt);
        const char* nA = has_next ? (const char*)g.A + (size_t)nxt.pm * tstepA + (size_t)nxt.ko * 2 : cA; const char* nB = has_next ? (const char*)g.Bt + (size_t)nxt.pn * tstepB + (size_t)nxt.ko * 2 : cB;
#pragma unroll 1
        for (int t = 0; t < nt; t += 2) {
            const bool last = (t == nt - 2);
            const char* a1 = cA + (size_t)(t + 1) * kstep;
            const char* a2 = last ? nA : cA + (size_t)(t + 2) * kstep; const char* b2 = last ? nB : cB + (size_t)(t + 2) * kstep;
            const char* a3 = a2 + kstep; const char* b3 = b2 + kstep;
            if (last && has_next) S.a_ready(nxt);
            if constexpr (SP2) {
            PG8_LDB(B0, 0, 0); PG8_LDB(B1, 0, 1); PG8_SCHED; PG8_LDA(At, 0, 0); PG8_STAGE(PG8_SA(1, 1), a1 + hstepA, voffA);
            PG8_WAIT_V(8); PG8_WAIT_L(0); PG8_BAR; PG8_MMA(0, 0, At, B0); PG8_MMA(0, 1, At, B1); PG8_BAR; PG8_SCHED;
            PG8_LDA(At, 0, 1); PG8_STAGE(PG8_SB(0, 0), b2, voffB); PG8_STAGE(PG8_SB(0, 1), b2 + hstepB, voffB); PG8_STAGE(PG8_SA(0, 0), a2, voffA);
            PG8_WAIT_V(8); PG8_WAIT_L(0); PG8_BAR; PG8_MMA(1, 0, At, B0); PG8_MMA(1, 1, At, B1); PG8_BAR; PG8_SCHED;
            PG8_LDB(B0, 1, 0); PG8_LDB(B1, 1, 1); PG8_SCHED; PG8_LDA(At, 1, 0); PG8_STAGE(PG8_SA(0, 1), a2 + hstepA, voffA);
            PG8_WAIT_V(8); PG8_WAIT_L(0); PG8_BAR; PG8_MMA(0, 0, At, B0); PG8_MMA(0, 1, At, B1); PG8_BAR; PG8_SCHED;
            PG8_LDA(At, 1, 1); PG8_STAGE(PG8_SB(1, 0), b3, voffB); PG8_STAGE(PG8_SB(1, 1), b3 + hstepB, voffB); PG8_STAGE(PG8_SA(1, 0), a3, voffA);
            PG8_WAIT_V(8); PG8_WAIT_L(0); PG8_BAR; PG8_MMA(1, 0, At, B0); PG8_MMA(1, 1, At, B1); PG8_BAR; PG8_SCHED;
            } else {
            PG8_LDB(B0, 0, 0); PG8_SCHED; PG8_LDA(At, 0, 0); PG8_STAGE(PG8_SA(1, 1), a1 + hstepA, voffA);
            PG8_WAIT_L(8); PG8_BAR; PG8_WAIT_L(0); PG8_MMA(0, 0, At, B0); PG8_BAR; PG8_SCHED;
            PG8_LDB(B1, 0, 1); PG8_STAGE(PG8_SB(0, 0), b2, voffB);
            PG8_BAR; PG8_WAIT_L(0); PG8_MMA(0, 1, At, B1); PG8_BAR;
            PG8_LDA(At, 0, 1); PG8_STAGE(PG8_SA(0, 0), a2, voffA);
            PG8_BAR; PG8_WAIT_L(0); PG8_MMA(1, 0, At, B0); PG8_BAR; PG8_SCHED;
            PG8_STAGE(PG8_SB(0, 1), b2 + hstepB, voffB);
            PG8_WAIT_V(6); PG8_BAR; PG8_MMA(1, 1, At, B1); PG8_BAR;
            PG8_LDB(B0, 1, 0); PG8_SCHED; PG8_LDA(At, 1, 0); PG8_STAGE(PG8_SA(0, 1), a2 + hstepA, voffA);
            PG8_WAIT_L(8); PG8_BAR; PG8_WAIT_L(0); PG8_MMA(0, 0, At, B0); PG8_BAR; PG8_SCHED;
            PG8_LDB(B1, 1, 1); PG8_STAGE(PG8_SB(1, 0), b3, voffB);
            PG8_BAR; PG8_WAIT_L(0); PG8_MMA(0, 1, At, B1); PG8_BAR;
            PG8_LDA(At, 1, 1); PG8_STAGE(PG8_SA(1, 0), a3, voffA);
            PG8_BAR; PG8_WAIT_L(0); PG8_MMA(1, 0, At, B0); PG8_BAR; PG8_SCHED;
            PG8_STAGE(PG8_SB(1, 1), b3 + hstepB, voffB);
            PG8_WAIT_V(6); PG8_BAR; PG8_MMA(1, 1, At, B1); PG8_BAR;
            }
        }
        if constexpr (ALIGN_EPI) { if (wr == 0) PG8_BAR; }
        if constexpr (!Epi::AFTER_DRAIN) { E(acc, cur, wr, wc, fr, fq); S.done(cur); }
        if (!has_next) break;
#pragma unroll
        for (int a = 0; a < 2; ++a)
#pragma unroll
            for (int b = 0; b < 2; ++b)
#pragma unroll
                for (int m = 0; m < 4; ++m)
#pragma unroll
                    for (int n = 0; n < 2; ++n) acc[a][b][m][n] = (f32x4){0.f, 0.f, 0.f, 0.f};
        cur = nxt; cA = nA; cB = nB; ++ui;
        if constexpr (ALIGN_EPI) { if (wr == 1) PG8_BAR; }
    }
    PG8_WAIT_V(0);
    if constexpr (!ALIGN_EPI) { if (wr == 0) PG8_BAR; }
    PG8_BAR;
    if constexpr (Epi::AFTER_DRAIN) { E.fused(acc, cur, wr, wc, fr, fq, lds, wid, lane); S.done(cur); }
#undef PG8_SA
#undef PG8_SB
#undef PG8_STAGE
#undef PG8_LDA
#undef PG8_LDB
#undef PG8_MMA
#undef PG8_WAIT_V
#undef PG8_WAIT_L
#undef PG8_BAR
#undef PG8_SCHED
}
}
constexpr int D = 1024, NB = 2, SEQ = 16384, LAT = NB * SEQ, CTXL = 256, NCTX = NB * CTXL, MT = LAT + NCTX;
constexpr int DEPTH = 4, NHEAD = 8, DQK = 96, DV = 64, NKEY = CTXL + SEQ;
constexpr int UW = 1792, KVW = 160;
constexpr int C_HY = 0, C_POOL = 768, C_CQ = 1024, C_CKV = 1408, C_KPE = 1664;
constexpr int FF = 2816, NJ_GU = FF / 128, NEXP = 8;
constexpr size_t KV_HEAD_STRIDE = (size_t)NKEY * KVW;
constexpr float QSCALE = 0.10206207261596577f * 1.4426950408889634f;

namespace pg8 {
__device__ __forceinline__ u32x4 pack8(f32x4 v0, f32x4 v1) { u32x4 w; w.x = cvt_pk_bf16(v0[0], v0[1]); w.y = cvt_pk_bf16(v0[2], v0[3]); w.z = cvt_pk_bf16(v1[0], v1[1]); w.w = cvt_pk_bf16(v1[2], v1[3]); return w; }

struct EpiQRope {
    static constexpr bool PERM = true, AFTER_DRAIN = false;
    bf16_t* Q; const float* rstd; const float* ropec; const float* ropes;
    __device__ __forceinline__ void operator()(const f32x4 (&acc)[2][2][4][2], const Unit& u, int wr, int wc, int fr, int fq) const {
        asm volatile("" : "+v"(fr), "+v"(fq));
        const int row0 = u.pm * BM + wr * 64 + fr; const bool lat = u.pm < (LAT / BM);
        int c0[2], j0[2]; bool rp[2];
#pragma unroll
        for (int bj = 0; bj < 2; ++bj) { c0[bj] = u.pn * BM + bj * HALF + wc * 32 + 8 * fq; const int dl = c0[bj] % DQK; rp[bj] = lat && dl >= 64; j0[bj] = rp[bj] ? ((dl - 64) >> 1) : 0; }
#pragma unroll
        for (int ai = 0; ai < 2; ++ai)
#pragma unroll
            for (int m = 0; m < 4; ++m) { const int row = row0 + ai * HALF + m * 16; const float rs = rstd[row] * QSCALE; const int t = row & (SEQ - 1);
#pragma unroll
                for (int bj = 0; bj < 2; ++bj) { f32x4 v0 = acc[ai][bj][m][0] * rs, v1 = acc[ai][bj][m][1] * rs;
                    if (rp[bj]) { const f32x4 c = *(const f32x4*)(ropec + t * 16 + j0[bj]), s = *(const f32x4*)(ropes + t * 16 + j0[bj]);
                        const f32x4 a = v0 * c - v1 * s, b = v0 * s + v1 * c; v0 = a; v1 = b; }
                    *(u32x4*)(Q + (unsigned)(row * 768 + c0[bj])) = pack8(v0, v1); }
                asm volatile("" ::: "memory"); }
    }
};
struct EpiKV {
    static constexpr bool PERM = true, AFTER_DRAIN = false;
    bf16_t* KV; const float* rstd;
    __device__ __forceinline__ void operator()(const f32x4 (&acc)[2][2][4][2], const Unit& u, int wr, int wc, int fr, int fq) const {
        asm volatile("" : "+v"(fr), "+v"(fq));
        const int row0 = u.pm * BM + wr * 64 + fr; const bool lat = u.pm < (LAT / BM);
        const int d = wc * 32 + 8 * fq, off = d < 64 ? d : d + 32;
#pragma unroll
        for (int ai = 0; ai < 2; ++ai)
#pragma unroll
            for (int m = 0; m < 4; ++m) { const int row = row0 + ai * HALF + m * 16; const float rs = rstd[row];
                int b, key; if (lat) { b = row >> 14; key = CTXL + (row & (SEQ - 1)); } else { const int rc = row - LAT; b = rc >> 8; key = rc & (CTXL - 1); }
                const unsigned ro = (unsigned)((b * NHEAD + 2 * u.pn) * NKEY + key) * KVW + off;
#pragma unroll
                for (int bj = 0; bj < 2; ++bj) *(u32x4*)(KV + ro + bj * (unsigned)KV_HEAD_STRIDE) = pack8(acc[ai][bj][m][0] * rs, acc[ai][bj][m][1] * rs);
                asm volatile("" ::: "memory"); }
    }
};
struct EpiColScale {
    static constexpr bool PERM = true, AFTER_DRAIN = false;
    bf16_t* O; int ldc; const float* cs;
    __device__ __forceinline__ void operator()(const f32x4 (&acc)[2][2][4][2], const Unit& u, int wr, int wc, int fr, int fq) const {
        asm volatile("" : "+v"(fr), "+v"(fq));
        const int row0 = u.pm * BM + wr * 64 + fr;
#pragma unroll
        for (int bj = 0; bj < 2; ++bj) { const int c = u.pn * BM + bj * HALF + wc * 32 + 8 * fq; const f32x4 s0 = *(const f32x4*)(cs + c), s1 = *(const f32x4*)(cs + c + 4);
#pragma unroll
            for (int ai = 0; ai < 2; ++ai)
#pragma unroll
                for (int m = 0; m < 4; ++m) { *(u32x4*)(O + (unsigned)((row0 + ai * HALF + m * 16) * ldc + c)) = pack8(acc[ai][bj][m][0] * s0, acc[ai][bj][m][1] * s1); if (m & 1) asm volatile("" ::: "memory"); } }
    }
};
struct EpiSwiGLU {
    static constexpr bool PERM = true, AFTER_DRAIN = false;
    bf16_t* H;
    __device__ __forceinline__ void operator()(const f32x4 (&acc)[2][2][4][2], const Unit& u, int wr, int wc, int fr, int fq) const {
        asm volatile("" : "+v"(fr), "+v"(fq));
        const int row0 = u.pm * BM + wr * 64 + fr; const int hc = (u.pn % NJ_GU) * HALF + wc * 32 + 8 * fq;
#pragma unroll
        for (int ai = 0; ai < 2; ++ai)
#pragma unroll
            for (int m = 0; m < 4; ++m) { f32x4 h[2];
#pragma unroll
                for (int n = 0; n < 2; ++n) { const f32x4 g = acc[ai][0][m][n], up = acc[ai][1][m][n];
#pragma unroll
                    for (int j = 0; j < 4; ++j) { const float e = __builtin_amdgcn_exp2f(g[j] * -1.4426950408889634f); h[n][j] = g[j] * __builtin_amdgcn_rcpf(1.0f + e) * up[j]; } }
                *(u32x4*)(H + (size_t)(row0 + ai * HALF + m * 16) * FF + hc) = pack8(h[0], h[1]); if (m & 1) asm volatile("" ::: "memory"); }
    }
};
typedef unsigned u32x2g __attribute__((ext_vector_type(2)));
constexpr int XBP = 2 * D;
struct EpiResGate {
    static constexpr bool PERM = false, AFTER_DRAIN = false;
    const float* src_f32; unsigned short* xb; const float* gate;
    __device__ __forceinline__ void operator()(const f32x4 (&acc)[2][2][4][2], const Unit& u, int wr, int wc, int fr, int fq) const {
        asm volatile("" : "+v"(fr), "+v"(fq));
        const int vsel = u.pm < (SEQ / BM) ? 0 : 1;
        unsigned short* base = xb + (size_t)u.pm * BM * XBP; const float* sbase = src_f32 ? src_f32 + (size_t)u.pm * BM * D : nullptr;
        const int col0 = u.pn * BM + wc * 32 + 4 * fq; const float* gp = gate + vsel * 6 * D + col0;
        f32x4 gv[2][2];
#pragma unroll
        for (int bj = 0; bj < 2; ++bj)
#pragma unroll
            for (int n = 0; n < 2; ++n) gv[bj][n] = *(const f32x4*)(gp + bj * HALF + n * 16);
#pragma unroll
        for (int ai = 0; ai < 2; ++ai)
#pragma unroll
            for (int m = 0; m < 4; ++m) { const unsigned rr = (unsigned)(ai * HALF + wr * 64 + m * 16 + fr);
#pragma unroll
                for (int bj = 0; bj < 2; ++bj)
#pragma unroll
                    for (int n = 0; n < 2; ++n) { const unsigned c = (unsigned)(col0 + bj * HALF + n * 16); f32x4 xi;
                        if (sbase) xi = *(const f32x4*)(sbase + rr * D + c);
                        else { const u32x2g w = *(const u32x2g*)(base + rr * XBP + c); xi = (f32x4){__uint_as_float(w.x << 16), __uint_as_float(w.x & 0xffff0000u), __uint_as_float(w.y << 16), __uint_as_float(w.y & 0xffff0000u)}; }
                        const f32x4 o = xi + gv[bj][n] * acc[ai][bj][m][n]; u32x2g ow; ow.x = cvt_pk_bf16(o[0], o[1]); ow.y = cvt_pk_bf16(o[2], o[3]);
                        *(u32x2g*)(base + rr * XBP + c) = ow; }
                if (m & 1) asm volatile("" ::: "memory"); }
    }
};
template <int NJ> struct MoeOrder {
    int t0, nt, G, c; const PG8_LAS int* tstart;
    __device__ __forceinline__ bool next(int i, Unit& u) const {
        int tile, j;
        if (G == 256) { constexpr int NJH = NJ / 2; const int x = c & 7, r = x & 3, ch = x >> 2, w = c >> 3; const int ntr = (nt - r + 3) >> 2; const int Lx = i * 32 + w;
            if (Lx >= ntr * NJH) return false; tile = t0 + 4 * (Lx / NJH) + r; j = ch * NJH + Lx % NJH; }
        else { const int L = i * G + c; if (L >= nt * NJ) return false; tile = t0 + L / NJ; j = L % NJ; }
        int e = 0;
#pragma unroll
        for (int k = 1; k < NEXP; ++k) e += (tile >= tstart[k]) ? 1 : 0;
        u.pm = __builtin_amdgcn_readfirstlane(tile); u.pn = __builtin_amdgcn_readfirstlane(e * NJ + j); u.ko = 0; return true;
    }
    __device__ __forceinline__ void a_ready(const Unit&) const {}
    __device__ __forceinline__ void done(const Unit&) const {}
};
template <int S> struct CtxSplitOrder {
    int G, c, Kp;
    __device__ __forceinline__ bool next(int i, Unit& u) const {
        const int L = i * G + c; if (L >= 8 * S) return false;
        const int ks = L % S, t = L / S; u.pm = LAT / BM + (t >> 2); u.pn = t & 3; u.ko = ks * Kp; return true;
    }
    __device__ __forceinline__ void a_ready(const Unit&) const {}
    __device__ __forceinline__ void done(const Unit&) const {}
};
struct EpiCtxSlab {
    static constexpr bool PERM = false, AFTER_DRAIN = false;
    float* slab; const float* gate; int Kp;
    __device__ __forceinline__ void operator()(const f32x4 (&acc)[2][2][4][2], const Unit& u, int wr, int wc, int fr, int fq) const {
        asm volatile("" : "+v"(fr), "+v"(fq));
        float* base = slab + ((size_t)(u.ko / Kp) * NCTX + (size_t)(u.pm - LAT / BM) * BM) * D;
        const int col0 = u.pn * BM + wc * 32 + 4 * fq; const float* gp = gate + 2 * 6 * D + col0;
        f32x4 gv[2][2];
#pragma unroll
        for (int bj = 0; bj < 2; ++bj)
#pragma unroll
            for (int n = 0; n < 2; ++n) gv[bj][n] = *(const f32x4*)(gp + bj * HALF + n * 16);
#pragma unroll
        for (int ai = 0; ai < 2; ++ai)
#pragma unroll
            for (int m = 0; m < 4; ++m) { const unsigned ro = (unsigned)((ai * HALF + wr * 64 + m * 16 + fr) * D + col0);
#pragma unroll
                for (int bj = 0; bj < 2; ++bj)
#pragma unroll
                    for (int n = 0; n < 2; ++n) *(f32x4*)(base + ro + bj * HALF + n * 16) = gv[bj][n] * acc[ai][bj][m][n];
                if (m & 1) asm volatile("" ::: "memory"); }
    }
};
}
#ifndef ATT_W64
#define ATT_W64 1
#endif
namespace att {
using bf16x8 = __attribute__((ext_vector_type(8))) short;
using s16x4  = __attribute__((ext_vector_type(4))) short;
using f32x16 = __attribute__((ext_vector_type(16))) float;
using u32x4  = __attribute__((ext_vector_type(4))) unsigned;
constexpr int NW = 8, QBLK = 32, KVBLK = 64;
constexpr float SCALE = 0.10206207261596577f;
constexpr float THR = 8.f;
constexpr int SHM_K = KVBLK * 256, SHM_V = KVBLK * DV * 2, BUF = SHM_K + SHM_V, SHM_ATTN = 2 * BUF + NW * 64 * 4 + 16;
#define ATT_KSWZ(row, colB) ((row) * 256 + ((colB) ^ (((row) & 7) << 4)))
#define ATT_SBAR() __builtin_amdgcn_sched_barrier(0)
__device__ __forceinline__ int crow(int r, int hi) { return (r & 3) + 8 * (r >> 2) + 4 * hi; }
__device__ __forceinline__ unsigned cvtpk(float lo, float hi) { unsigned r; asm volatile("v_cvt_pk_bf16_f32 %0, %1, %2" : "=v"(r) : "v"(lo), "v"(hi)); return r; }
constexpr float THRL = THR * 1.4426950408889634f;
template <bool FIRST> __device__ __forceinline__ void partialSM_a(f32x16& p0, f32x16& p1, float& m_ref, f32x16& negm, float& alpha) {
  float pmax = p0[0];
#pragma unroll
  for (int r = 1; r < 16; ++r) pmax = fmaxf(pmax, p0[r]);
#pragma unroll
  for (int r = 0; r < 16; ++r) pmax = fmaxf(pmax, p1[r]);
  { auto rr = __builtin_amdgcn_permlane32_swap(__float_as_uint(pmax), __float_as_uint(pmax), false, false);
    pmax = fmaxf(__uint_as_float(rr[0]), __uint_as_float(rr[1])); }
  if (!FIRST && __builtin_expect(__all(pmax <= THRL), 1)) { alpha = 1.f; }
  else { const float dl = FIRST ? pmax : fmaxf(pmax, 0.f); m_ref += dl; alpha = FIRST ? 1.f : __builtin_amdgcn_exp2f(-dl);
#pragma unroll
    for (int r = 0; r < 16; ++r) { p0[r] -= dl; p1[r] -= dl; }
#pragma unroll
    for (int r = 0; r < 16; ++r) negm[r] = -m_ref;
    asm volatile("" : "+v"(negm)); }
}
__device__ __forceinline__ void partialSM_b(f32x16& p0) {
#pragma unroll
  for (int r = 0; r < 16; ++r) p0[r] = __builtin_amdgcn_exp2f(p0[r]);
}
template <bool DO_EXP = true> __device__ __forceinline__ void finishSM(f32x16& p0, f32x16& p1, float alpha, float& l_reg, bf16x8& pa0, bf16x8& pa1, bf16x8& pa2, bf16x8& pa3) {
  if (DO_EXP) {
#pragma unroll
  for (int r = 0; r < 16; ++r) p1[r] = __builtin_amdgcn_exp2f(p1[r]); }
  float ps = 0;
#pragma unroll
  for (int r = 0; r < 16; ++r) ps += p0[r];
#pragma unroll
  for (int r = 0; r < 16; ++r) ps += p1[r];
  { auto rr = __builtin_amdgcn_permlane32_swap(__float_as_uint(ps), __float_as_uint(ps), false, false);
    ps = __uint_as_float(rr[0]) + __uint_as_float(rr[1]); }
  l_reg = l_reg * alpha + ps;
#define ATT_PK4(P, BASE, OUT) do { unsigned a0 = cvtpk(P[BASE + 0], P[BASE + 1]), a1 = cvtpk(P[BASE + 2], P[BASE + 3]);   \
    unsigned b0 = cvtpk(P[BASE + 4], P[BASE + 5]), b1 = cvtpk(P[BASE + 6], P[BASE + 7]);                              \
    auto r0 = __builtin_amdgcn_permlane32_swap(a0, b0, false, false); auto r1 = __builtin_amdgcn_permlane32_swap(a1, b1, false, false); \
    u32x4 w = {r0[0], r1[0], r0[1], r1[1]}; OUT = *reinterpret_cast<bf16x8*>(&w); } while (0)
  ATT_PK4(p0, 0, pa0); ATT_PK4(p0, 8, pa1); ATT_PK4(p1, 0, pa2); ATT_PK4(p1, 8, pa3);
#undef ATT_PK4
}
__device__ __forceinline__ void kload(bf16x8 (&kf)[12], const char* Ks, int r32, int hi) {
#pragma unroll
  for (int d0 = 0; d0 < DQK / 16; ++d0) { const int cb = (d0 * 16 + hi * 8) * 2;
    kf[2 * d0] = *reinterpret_cast<const bf16x8*>(Ks + ATT_KSWZ(r32, cb)); kf[2 * d0 + 1] = *reinterpret_cast<const bf16x8*>(Ks + ATT_KSWZ(32 + r32, cb)); }
}
__device__ __forceinline__ void qk_mma(f32x16& p0, f32x16& p1, const bf16x8 (&kf)[12], const bf16x8* qr, const f32x16& negm) {
  p0 = negm; p1 = negm;
#pragma unroll
  for (int d0 = 0; d0 < DQK / 16; ++d0) { p0 = __builtin_amdgcn_mfma_f32_32x32x16_bf16(kf[2 * d0], qr[d0], p0, 0, 0, 0); p1 = __builtin_amdgcn_mfma_f32_32x32x16_bf16(kf[2 * d0 + 1], qr[d0], p1, 0, 0, 0); }
}
__device__ __forceinline__ void qkt(f32x16& p0, f32x16& p1, const char* Ks, const bf16x8* qr, int r32, int hi, const f32x16& negm) { bf16x8 kf[12]; kload(kf, Ks, r32, hi); qk_mma(p0, p1, kf, qr, negm); }
__device__ __forceinline__ int v_st(int k, int c) { const int kk = (k & ~0xC) | ((k & 4) << 1) | ((k & 8) >> 1); return ((kk >> 3) * 2 + (c >> 5)) * 512 + ((kk & 7) * 32 + (c & 31)) * 2; }
__device__ __forceinline__ int v_rd_base(int lane) { return ((lane & 3) << 3) | (((lane >> 2) & 3) << 6) | (((lane >> 4) & 1) << 5) | (((lane >> 5) & 1) << 8); }
constexpr int v_rd_off(int d0, int ks, int half) { return d0 * 512 + ks * 2048 + half * 1024; }
template <int OFF> __device__ __forceinline__ s16x4 tr_read(int vb) {
  s16x4 r; asm volatile("ds_read_b64_tr_b16 %0, %1 offset:%2" : "=&v"(r) : "v"(vb), "i"(OFF) : "memory"); return r;
}
struct VFrag { s16x4 l[2][4], h[2][4]; };
__device__ __forceinline__ void vload(VFrag& v, int vb) {
#define ATT_VR(D0, KS) v.l[D0][KS] = tr_read<v_rd_off(D0, KS, 0)>(vb); v.h[D0][KS] = tr_read<v_rd_off(D0, KS, 1)>(vb);
  ATT_VR(0, 0) ATT_VR(1, 0) ATT_VR(0, 1) ATT_VR(1, 1) ATT_VR(0, 2) ATT_VR(1, 2) ATT_VR(0, 3) ATT_VR(1, 3)
#undef ATT_VR
}
__device__ __forceinline__ void pv_mma(f32x16* o, const VFrag& v, bf16x8 pa0, bf16x8 pa1, bf16x8 pa2, bf16x8 pa3) {
#define ATT_PK(L, H) (bf16x8){L[0], L[1], L[2], L[3], H[0], H[1], H[2], H[3]}
  o[0] = __builtin_amdgcn_mfma_f32_32x32x16_bf16(pa0, ATT_PK(v.l[0][0], v.h[0][0]), o[0], 0, 0, 0); o[1] = __builtin_amdgcn_mfma_f32_32x32x16_bf16(pa0, ATT_PK(v.l[1][0], v.h[1][0]), o[1], 0, 0, 0);
  o[0] = __builtin_amdgcn_mfma_f32_32x32x16_bf16(pa1, ATT_PK(v.l[0][1], v.h[0][1]), o[0], 0, 0, 0); o[1] = __builtin_amdgcn_mfma_f32_32x32x16_bf16(pa1, ATT_PK(v.l[1][1], v.h[1][1]), o[1], 0, 0, 0);
  o[0] = __builtin_amdgcn_mfma_f32_32x32x16_bf16(pa2, ATT_PK(v.l[0][2], v.h[0][2]), o[0], 0, 0, 0); o[1] = __builtin_amdgcn_mfma_f32_32x32x16_bf16(pa2, ATT_PK(v.l[1][2], v.h[1][2]), o[1], 0, 0, 0);
  o[0] = __builtin_amdgcn_mfma_f32_32x32x16_bf16(pa3, ATT_PK(v.l[0][3], v.h[0][3]), o[0], 0, 0, 0); o[1] = __builtin_amdgcn_mfma_f32_32x32x16_bf16(pa3, ATT_PK(v.l[1][3], v.h[1][3]), o[1], 0, 0, 0);
#undef ATT_PK
}
__device__ __forceinline__ void pv_d0(f32x16* o, int vb, bf16x8 pa0, bf16x8 pa1, bf16x8 pa2, bf16x8 pa3) {
  VFrag v; vload(v, vb); asm volatile("s_waitcnt lgkmcnt(0)" ::: "memory"); ATT_SBAR(); pv_mma(o, v, pa0, pa1, pa2, pa3);
}
#define ATT_SEGB(P0, P1, AL, VB) do { VFrag v_; if (!(STRIP & 4)) vload(v_, (VB)); else { _Pragma("unroll") for (int a_ = 0; a_ < 2; ++a_) _Pragma("unroll") for (int b_ = 0; b_ < 4; ++b_) { v_.l[a_][b_] = (s16x4){pa0[0], pa1[1], pa2[2], pa3[3]}; v_.h[a_][b_] = (s16x4){pa0[4], pa1[5], pa2[6], pa3[7]}; } } \
    if (!FAST) partialSM_a<false>(P0, P1, m_ref, negm, AL); asm volatile("s_waitcnt lgkmcnt(0)" ::: "memory"); ATT_SBAR(); \
    pv_mma(o, v_, pa0, pa1, pa2, pa3); if (!(STRIP & 1)) partialSM_b(P0); } while (0)
template <bool FAST, int STRIP = 0> __device__ __forceinline__ bool attn_unit(const unsigned short* __restrict__ Qb, const unsigned short* __restrict__ KVh, unsigned short* __restrict__ Ob, int seq, char* lds, int tid) {
  const int wid = __builtin_amdgcn_readfirstlane(tid >> 6), lane = tid & 63, r32 = lane & 31, hi = lane >> 5;
  float* ws = (float*)(lds + 2 * BUF) + wid * 64; float* li_l = ws; float* al_l = ws + 32; unsigned* okflag = (unsigned*)(lds + 2 * BUF + NW * 64 * 4);
  if (FAST && tid == 0) *okflag = 0u;
  float m_ref = 0.f, l_reg = 0; f32x16 o[2] = {}; f32x16 negm = {}; bf16x8 qr[DQK / 16];
  { const unsigned qoff = (unsigned)((wid * QBLK + r32) * 768 + hi * 8);
#pragma unroll
    for (int d0 = 0; d0 < DQK / 16; ++d0) qr[d0] = *reinterpret_cast<const bf16x8*>(Qb + qoff + d0 * 16); }
  int dst[3];
#pragma unroll
  for (int i = 0; i < 3; ++i) { const int c = tid + 512 * i, row = c / 20, part = c % 20; dst[i] = part < 12 ? ATT_KSWZ(row, part * 16) : SHM_K + v_st(row, (part - 12) * 8); }
  const bool third = wid < 4;
  const char* kvb = (const char*)KVh; const unsigned voff = (unsigned)tid * 16u; const unsigned off2 = third ? 16384u : 0u;
  const int vb0 = (int)(uintptr_t)(lds + SHM_K) + v_rd_base(lane);
  bf16x8 sA0, sA1, sA2, sB0, sB1, sB2;
#define ATT_SLOAD(S, k0) do { const char* p_ = kvb + (long)(k0) * (KVW * 2);     \
    S##0 = *reinterpret_cast<const bf16x8*>(p_ + voff); S##1 = *reinterpret_cast<const bf16x8*>(p_ + 8192 + voff); S##2 = *reinterpret_cast<const bf16x8*>(p_ + off2 + voff); } while (0)
#define ATT_SWRITE(b, S) do { char* q_ = lds + (b) * BUF; *reinterpret_cast<bf16x8*>(q_ + dst[0]) = S##0; *reinterpret_cast<bf16x8*>(q_ + dst[1]) = S##1; \
    if (third) *reinterpret_cast<bf16x8*>(q_ + dst[2]) = S##2; } while (0)
#define ATT_RESC(a) do { if (!FAST && __any((a) < 1.f)) { if (hi == 0) al_l[r32] = (a); asm volatile("s_waitcnt lgkmcnt(0)" ::: "memory"); \
    _Pragma("unroll") for (int d = 0; d < 2; ++d) _Pragma("unroll") for (int r = 0; r < 16; ++r) o[d][r] *= al_l[crow(r, hi)]; } } while (0)
#define ATT_FIN(P0, P1, AL) do { if (!(STRIP & 1)) finishSM(P0, P1, AL, l_reg, pa0, pa1, pa2, pa3); else { u32x4 w0_ = {__float_as_uint(P0[0]), __float_as_uint(P0[1]), __float_as_uint(P0[2]), __float_as_uint(P0[3])}, w1_ = {__float_as_uint(P0[4]), __float_as_uint(P0[5]), __float_as_uint(P0[6]), __float_as_uint(P0[7])}, \
           w2_ = {__float_as_uint(P1[0]), __float_as_uint(P1[1]), __float_as_uint(P1[2]), __float_as_uint(P1[3])}, w3_ = {__float_as_uint(P1[4]), __float_as_uint(P1[5]), __float_as_uint(P1[6]), __float_as_uint(P1[7])}; \
           pa0 = *reinterpret_cast<bf16x8*>(&w0_); pa1 = *reinterpret_cast<bf16x8*>(&w1_); pa2 = *reinterpret_cast<bf16x8*>(&w2_); pa3 = *reinterpret_cast<bf16x8*>(&w3_); l_reg += P1[8]; } } while (0)
#define ATT_QKT(P0, P1, KS) do { bf16x8 kf_[12]; if (!(STRIP & 16)) kload(kf_, (KS), r32, hi); else { _Pragma("unroll") for (int i_ = 0; i_ < 12; ++i_) kf_[i_] = qr[i_ % 6]; } qk_mma(P0, P1, kf_, qr, negm); } while (0)
  f32x16 pA0, pA1, pB0, pB1; float alA = 1.f, alB = 1.f; bf16x8 pa0, pa1, pa2, pa3; const int NT = seq / KVBLK;
  ATT_SLOAD(sA, 0); ATT_SWRITE(0, sA); __syncthreads();
  ATT_QKT(pA0, pA1, lds); partialSM_a<true>(pA0, pA1, m_ref, negm, alA); partialSM_b(pA0);
  ATT_SLOAD(sB, KVBLK); if (2 < NT) ATT_SLOAD(sA, 2 * KVBLK);
  ATT_SWRITE(1, sB); __syncthreads();
#define ATT_LBAR() do { if (!(STRIP & 8)) __syncthreads(); } while (0)
  for (int j = 1; j + 1 < NT; j += 2) {
    ATT_SBAR(); if (!(STRIP & 2)) ATT_SLOAD(sB, (STRIP & 32) ? 0 : (j + 2) * KVBLK); ATT_SBAR();
    ATT_QKT(pB0, pB1, lds + BUF);
    ATT_FIN(pA0, pA1, alA); ATT_SBAR();
    ATT_SEGB(pB0, pB1, alB, vb0);
    ATT_LBAR(); if (!(STRIP & 2)) ATT_SWRITE(0, sA);
    ATT_RESC(alB); ATT_LBAR();
    ATT_SBAR(); if (!(STRIP & 2) && j + 3 < NT) ATT_SLOAD(sA, (STRIP & 32) ? 0 : (j + 3) * KVBLK); ATT_SBAR();
    ATT_QKT(pA0, pA1, lds);
    ATT_FIN(pB0, pB1, alB); ATT_SBAR();
    ATT_SEGB(pA0, pA1, alA, vb0 + BUF);
    ATT_LBAR(); if (!(STRIP & 2)) ATT_SWRITE(1, sB);
    ATT_RESC(alA); ATT_LBAR();
  }
#undef ATT_LBAR
  ATT_SBAR(); ATT_QKT(pB0, pB1, lds + BUF);
  ATT_FIN(pA0, pA1, alA); ATT_SBAR();
  ATT_SEGB(pB0, pB1, alB, vb0);
  __syncthreads(); ATT_RESC(alB);
  ATT_FIN(pB0, pB1, alB); ATT_SBAR();
  pv_d0(o, vb0 + BUF, pa0, pa1, pa2, pa3);
  if (FAST) { const bool bad = !(l_reg < 1.3e36f);
    if (__any(bad) && lane == 0) *okflag = 1u;
    __syncthreads(); if (*okflag != 0u) { __syncthreads(); return false; } }
  if (hi == 0) li_l[r32] = l_reg; asm volatile("s_waitcnt lgkmcnt(0)" ::: "memory");
  float rli[16];
#pragma unroll
  for (int r = 0; r < 16; ++r) rli[r] = __builtin_amdgcn_rcpf(li_l[crow(r, hi)]);
  unsigned short* Ow = Ob + (long)(wid * QBLK) * D;
#pragma unroll
  for (int r = 0; r < 16; ++r) { const int orow = crow(r, hi);
    *reinterpret_cast<unsigned*>(Ow + (long)orow * D + 2 * r32) = cvtpk(o[0][r] * rli[r], o[1][r] * rli[r]); }
  __syncthreads();
  return true;
#undef ATT_QKT
#undef ATT_FIN
#undef ATT_SLOAD
#undef ATT_SWRITE
#undef ATT_RESC
}
constexpr int PKP = 192, PSHK = KVBLK * PKP, PBUF = PSHK + SHM_V;
#ifndef ATT_PNB
#define ATT_PNB 5
#endif
constexpr int PNB = ATT_PNB;
#ifdef ATT_PP_SETPRIO
#define PP_PRIO(x) __builtin_amdgcn_s_setprio(x)
#else
#define PP_PRIO(x) do {} while (0)
#endif
typedef __attribute__((address_space(3))) unsigned lds_u32;
typedef __attribute__((address_space(3))) unsigned char lds_u8;
__device__ __forceinline__ void kload_pp(bf16x8 (&kf)[12], const char* Ks, int kbe, int kbo) {
#pragma unroll
  for (int d0 = 0; d0 < DQK / 16; ++d0) { const int a = ((d0 & 1) ? kbo : kbe) + (d0 >> 1) * 64;
    kf[2 * d0] = *reinterpret_cast<const bf16x8*>(Ks + a); kf[2 * d0 + 1] = *reinterpret_cast<const bf16x8*>(Ks + a + 32 * PKP); }
}
template <int STRIP = 0> __device__ __forceinline__ bool attn_unit_pp(const unsigned short* __restrict__ Qb, const unsigned short* __restrict__ KVh, unsigned short* __restrict__ Ob, int seq, lds_u8* ldsl, int tid) {
  char* lds = (char*)ldsl;
  const int wid = __builtin_amdgcn_readfirstlane(tid >> 6), lane = tid & 63, r32 = lane & 31, hi = lane >> 5;
  float* ws = (float*)(lds + PNB * PBUF) + wid * 64; float* li_l = ws; unsigned* okflag = (unsigned*)(lds + PNB * PBUF + NW * 64 * 4);
  if (tid == 0) *okflag = 0u;
  float m_ref = 0.f, l_reg = 0.f, alpha = 1.f; f32x16 o[2] = {}; f32x16 negm = {}; bf16x8 qr[DQK / 16];
  { const unsigned qoff = (unsigned)((wid * QBLK + r32) * 768 + hi * 8);
#pragma unroll
    for (int d0 = 0; d0 < DQK / 16; ++d0) qr[d0] = *reinterpret_cast<const bf16x8*>(Qb + qoff + d0 * 16); }
  const bool third = wid < 4;
  unsigned g0, g1, g2;
  { const int q0 = wid * 64 + lane, r0 = q0 / 12, s0 = q0 % 12; g0 = (unsigned)(r0 * (KVW * 2) + ((s0 ^ ((r0 >> 2) & 3)) << 4));
    const int q1 = (wid + 8) * 64 + lane, r1 = q1 / 12, s1 = q1 % 12; const unsigned g1k = (unsigned)(r1 * (KVW * 2) + ((s1 ^ ((r1 >> 2) & 3)) << 4));
    const int v1 = (wid - 4) * 64 + lane, v2 = (wid + 4) * 64 + lane;
    auto vsrc = [](int v) { const int sub = v >> 5, w = v & 31, kk = (sub >> 1) * 8 + (w >> 2), k = (kk & ~0xC) | ((kk & 4) << 1) | ((kk & 8) >> 1), c = (sub & 1) * 32 + (w & 3) * 8; return (unsigned)(k * (KVW * 2) + 192 + c * 2); };
    g1 = third ? g1k : vsrc(v1); g2 = vsrc(v2 & 511); }
  const int fsw = (r32 >> 2) & 3; const int kbe = r32 * PKP + ((hi ^ fsw) << 4), kbo = r32 * PKP + (((2 + hi) ^ fsw) << 4);
  const int vb0 = (int)(uintptr_t)(lds + PSHK) + v_rd_base(lane);
  const char* kvb = (const char*)KVh; const int NT = seq / KVBLK;
#define PP_DMA(T, OFF) do { const char* tb_ = kvb + (long)(T) * (KVBLK * KVW * 2); lds_u8* sb_ = ldsl + (OFF) + wid * 1024; \
    __builtin_amdgcn_global_load_lds((const unsigned*)(tb_ + g0), (lds_u32*)sb_, 16, 0, 0); \
    __builtin_amdgcn_global_load_lds((const unsigned*)(tb_ + g1), (lds_u32*)(sb_ + 8192), 16, 0, 0); \
    if (third) __builtin_amdgcn_global_load_lds((const unsigned*)(tb_ + g2), (lds_u32*)(sb_ + 16384), 16, 0, 0); } while (0)
#define PP_WAITV() do { if (third) asm volatile("s_waitcnt vmcnt(%0)" :: "n"(3 * (PNB - 3)) : "memory"); else asm volatile("s_waitcnt vmcnt(%0)" :: "n"(2 * (PNB - 3)) : "memory"); } while (0)
  f32x16 p0, p1; bf16x8 pa0, pa1, pa2, pa3; bf16x8 kf[12]; VFrag vf;
#pragma unroll
  for (int T = 0; T < PNB - 1; ++T) { const int Tc = T < NT ? T : NT - 1; PP_DMA(Tc, T * PBUF); }
  PP_WAITV();
  __builtin_amdgcn_s_barrier();
  kload_pp(kf, lds, kbe, kbo); if (STRIP & 4) vload(vf, vb0); asm volatile("s_waitcnt lgkmcnt(0)" ::: "memory");
  if (wid >= 4) __builtin_amdgcn_s_barrier();
  int oK = PBUF, oV = 0, oD = (PNB - 1) * PBUF;
#define PP_ADV(x) do { x += PBUF; if (x == PNB * PBUF) x = 0; } while (0)
#define PP_LSEG(FIRST_, t_) do { ATT_SBAR(); if (!(STRIP & 4)) { kload_pp(kf, lds + oK, kbe, kbo); vload(vf, vb0 + oV); } ATT_SBAR(); \
    if (!(STRIP & 2) && (t_) + PNB - 1 < NT) { PP_DMA((t_) + PNB - 1, oD); } ATT_SBAR(); \
    if (FIRST_) partialSM_a<true>(p0, p1, m_ref, negm, alpha); \
    if (!(STRIP & 1)) { partialSM_b(p0); finishSM(p0, p1, 1.f, l_reg, pa0, pa1, pa2, pa3); } \
    else { u32x4 w0_ = {__float_as_uint(p0[0]), __float_as_uint(p0[1]), __float_as_uint(p0[2]), __float_as_uint(p0[3])}, w1_ = {__float_as_uint(p0[4]), __float_as_uint(p0[5]), __float_as_uint(p0[6]), __float_as_uint(p0[7])}, \
           w2_ = {__float_as_uint(p1[0]), __float_as_uint(p1[1]), __float_as_uint(p1[2]), __float_as_uint(p1[3])}, w3_ = {__float_as_uint(p1[4]), __float_as_uint(p1[5]), __float_as_uint(p1[6]), __float_as_uint(p1[7])}; \
           pa0 = *reinterpret_cast<bf16x8*>(&w0_); pa1 = *reinterpret_cast<bf16x8*>(&w1_); pa2 = *reinterpret_cast<bf16x8*>(&w2_); pa3 = *reinterpret_cast<bf16x8*>(&w3_); l_reg += p1[8]; } ATT_SBAR(); \
    if ((t_) + PNB - 1 < NT) PP_WAITV(); else asm volatile("s_waitcnt vmcnt(0)" ::: "memory"); \
    asm volatile("s_waitcnt lgkmcnt(0)" ::: "memory"); ATT_SBAR(); __builtin_amdgcn_s_barrier(); ATT_SBAR(); PP_ADV(oK); PP_ADV(oV); PP_ADV(oD); } while (0)
  PP_PRIO(1); qk_mma(p0, p1, kf, qr, negm); PP_PRIO(0); ATT_SBAR(); __builtin_amdgcn_s_barrier(); ATT_SBAR();
  PP_LSEG(true, 0);
#pragma unroll 1
  for (int t = 1; t < NT; ++t) {
    if (!(STRIP & 8)) { PP_PRIO(1); qk_mma(p0, p1, kf, qr, negm); pv_mma(o, vf, pa0, pa1, pa2, pa3); PP_PRIO(0); }
    else { _Pragma("unroll") for (int i_ = 0; i_ < 12; ++i_) asm volatile("" :: "v"(kf[i_])); asm volatile("" :: "v"(vf.l[0][0]), "v"(vf.h[1][3]), "v"(pa0), "v"(pa1), "v"(pa2), "v"(pa3)); asm volatile("" : "+v"(p0), "+v"(p1)); }
    ATT_SBAR(); __builtin_amdgcn_s_barrier(); ATT_SBAR();
    PP_LSEG(false, t);
  }
  PP_PRIO(1); pv_mma(o, vf, pa0, pa1, pa2, pa3); PP_PRIO(0); ATT_SBAR();
  if (wid < 4) __builtin_amdgcn_s_barrier();
  { const bool bad = !(l_reg < 1.3e36f);
    if (__any(bad) && lane == 0) *okflag = 1u;
    __syncthreads(); if (*okflag != 0u) { __syncthreads(); return false; } }
  if (hi == 0) li_l[r32] = l_reg; asm volatile("s_waitcnt lgkmcnt(0)" ::: "memory");
  float rli[16];
#pragma unroll
  for (int r = 0; r < 16; ++r) rli[r] = __builtin_amdgcn_rcpf(li_l[crow(r, hi)]);
  unsigned short* Ow = Ob + (long)(wid * QBLK) * D;
#pragma unroll
  for (int r = 0; r < 16; ++r) { const int orow = crow(r, hi);
    *reinterpret_cast<unsigned*>(Ow + (long)orow * D + 2 * r32) = cvtpk(o[0][r] * rli[r], o[1][r] * rli[r]); }
  __syncthreads();
  return true;
#undef PP_DMA
#undef PP_WAITV
#undef PP_ADV
#undef PP_LSEG
}
#ifndef ATT_WNB
#define ATT_WNB 4
#endif
constexpr int WNB = ATT_WNB;
__device__ __forceinline__ bool attn_unit_w64(const unsigned short* __restrict__ Qb, const unsigned short* __restrict__ KVh, unsigned short* __restrict__ Ob, int seq, lds_u8* ldsl, int tid) {
  char* lds = (char*)ldsl;
  const int wid = __builtin_amdgcn_readfirstlane(tid >> 6), lane = tid & 63, r32 = lane & 31, hi = lane >> 5;
  float* ws = (float*)(lds + WNB * PBUF) + wid * 64; unsigned* okflag = (unsigned*)(lds + WNB * PBUF + NW * 64 * 4);
  if (tid == 0) *okflag = 0u;
  float lA = 0.f, lB = 0.f; f32x16 oA[2] = {}, oB[2] = {}; const f32x16 zero = {}; bf16x8 qA[DQK / 16], qB[DQK / 16];
  { const unsigned qoff = (unsigned)((wid * 64 + r32) * 768 + hi * 8);
#pragma unroll
    for (int d0 = 0; d0 < DQK / 16; ++d0) { qA[d0] = *reinterpret_cast<const bf16x8*>(Qb + qoff + d0 * 16); qB[d0] = *reinterpret_cast<const bf16x8*>(Qb + qoff + 32 * 768 + d0 * 16); } }
  const bool third = wid < 4;
  unsigned g0, g1, g2;
  { const int q0 = wid * 64 + lane, r0 = q0 / 12, s0 = q0 % 12; g0 = (unsigned)(r0 * (KVW * 2) + ((s0 ^ ((r0 >> 2) & 3)) << 4));
    const int q1 = (wid + 8) * 64 + lane, r1 = q1 / 12, s1 = q1 % 12; const unsigned g1k = (unsigned)(r1 * (KVW * 2) + ((s1 ^ ((r1 >> 2) & 3)) << 4));
    const int v1 = (wid - 4) * 64 + lane, v2 = (wid + 4) * 64 + lane;
    auto vsrc = [](int v) { const int sub = v >> 5, w = v & 31, kk = (sub >> 1) * 8 + (w >> 2), k = (kk & ~0xC) | ((kk & 4) << 1) | ((kk & 8) >> 1), c = (sub & 1) * 32 + (w & 3) * 8; return (unsigned)(k * (KVW * 2) + 192 + c * 2); };
    g1 = third ? g1k : vsrc(v1 & 511); g2 = vsrc(v2 & 511); }
  const int fsw = (r32 >> 2) & 3; const int kbe = r32 * PKP + ((hi ^ fsw) << 4), kbo = r32 * PKP + (((2 + hi) ^ fsw) << 4);
  const int vb0 = (int)(uintptr_t)(lds + PSHK) + v_rd_base(lane);
  const char* kvb = (const char*)KVh; const int NT = seq / KVBLK;
#define W64_DMA(T, OFF) do { const char* tb_ = kvb + (long)(T) * (KVBLK * KVW * 2); lds_u8* sb_ = ldsl + (OFF) + wid * 1024; \
    __builtin_amdgcn_global_load_lds((const unsigned*)(tb_ + g0), (lds_u32*)sb_, 16, 0, 0); \
    __builtin_amdgcn_global_load_lds((const unsigned*)(tb_ + g1), (lds_u32*)(sb_ + 8192), 16, 0, 0); \
    if (third) __builtin_amdgcn_global_load_lds((const unsigned*)(tb_ + g2), (lds_u32*)(sb_ + 16384), 16, 0, 0); } while (0)
#define W64_WAITV() do { if (third) asm volatile("s_waitcnt vmcnt(%0)" :: "n"(3 * (WNB - 2)) : "memory"); else asm volatile("s_waitcnt vmcnt(%0)" :: "n"(2 * (WNB - 2)) : "memory"); } while (0)
#pragma unroll
  for (int T = 0; T < WNB; ++T) { const int Tc = T < NT ? T : NT - 1; W64_DMA(Tc, T * PBUF); }
  f32x16 pA0, pA1, pB0, pB1; bf16x8 pa0, pa1, pa2, pa3, pb0, pb1, pb2, pb3; bf16x8 kf[12];
  if (third) asm volatile("s_waitcnt vmcnt(%0)" :: "n"(3 * (WNB - 1)) : "memory"); else asm volatile("s_waitcnt vmcnt(%0)" :: "n"(2 * (WNB - 1)) : "memory");
  __builtin_amdgcn_s_barrier(); ATT_SBAR();
  kload_pp(kf, lds, kbe, kbo);
  int oT = 0;
#pragma unroll 1
  for (int t = 0; t < NT; ++t) {
    ATT_SBAR(); qk_mma(pA0, pA1, kf, qA, zero); ATT_SBAR();
    qk_mma(pB0, pB1, kf, qB, zero); partialSM_b(pA0); partialSM_b(pA1); ATT_SBAR();
    VFrag vf; vload(vf, vb0 + oT); ATT_SBAR();
    finishSM<false>(pA0, pA1, 1.f, lA, pa0, pa1, pa2, pa3); asm volatile("s_waitcnt lgkmcnt(0)" ::: "memory"); ATT_SBAR();
    pv_mma(oA, vf, pa0, pa1, pa2, pa3); partialSM_b(pB0); finishSM(pB0, pB1, 1.f, lB, pb0, pb1, pb2, pb3); ATT_SBAR();
    if (t + WNB - 1 < NT) W64_WAITV(); else asm volatile("s_waitcnt vmcnt(0)" ::: "memory");
    __builtin_amdgcn_s_barrier(); ATT_SBAR();
    if (t + WNB < NT) W64_DMA(t + WNB, oT);
    oT += PBUF; if (oT == WNB * PBUF) oT = 0;
    ATT_SBAR(); kload_pp(kf, lds + oT, kbe, kbo); ATT_SBAR();
    pv_mma(oB, vf, pb0, pb1, pb2, pb3); ATT_SBAR();
  }
#ifdef ATT_W64_CHECK_FALLBACK
  lA = -1.f;
#endif
  { const bool bad = !(lA < 1.3e36f) || !(lA > 1e-30f) || !(lB < 1.3e36f) || !(lB > 1e-30f);
    if (__any(bad) && lane == 0) *okflag = 1u;
    __syncthreads(); if (*okflag != 0u) { __syncthreads(); return false; } }
  if (hi == 0) { ws[r32] = lA; ws[32 + r32] = lB; } asm volatile("s_waitcnt lgkmcnt(0)" ::: "memory");
  unsigned short* Ow = Ob + (long)(wid * 64) * D;
#pragma unroll
  for (int r = 0; r < 16; ++r) { const int orow = crow(r, hi); const float ra = __builtin_amdgcn_rcpf(ws[orow]), rb = __builtin_amdgcn_rcpf(ws[32 + orow]);
    *reinterpret_cast<unsigned*>(Ow + (long)orow * D + 2 * r32) = cvtpk(oA[0][r] * ra, oA[1][r] * ra);
    *reinterpret_cast<unsigned*>(Ow + (long)(32 + orow) * D + 2 * r32) = cvtpk(oB[0][r] * rb, oB[1][r] * rb); }
  __syncthreads();
  return true;
#undef W64_DMA
#undef W64_WAITV
}
#undef ATT_SEGB
#undef ATT_KSWZ
#undef ATT_SBAR
}
#define GAS __attribute__((address_space(1)))
#define LAS __attribute__((address_space(3)))
typedef unsigned short bf16;
typedef unsigned v4u __attribute__((ext_vector_type(4)));
typedef unsigned v2u __attribute__((ext_vector_type(2)));
typedef float f32x4 __attribute__((ext_vector_type(4)));
typedef short bf16x8 __attribute__((ext_vector_type(8)));
typedef GAS unsigned gu32;
typedef GAS unsigned long long gu64;
#define RLX_AGENT __ATOMIC_RELAXED, __HIP_MEMORY_SCOPE_AGENT
#define LDS_WAIT() asm volatile("s_waitcnt lgkmcnt(0)" ::: "memory")
#define VM_WAIT() asm volatile("s_waitcnt vmcnt(0)" ::: "memory")
__device__ __forceinline__ unsigned long long rt() { return __builtin_amdgcn_s_memrealtime(); }
__device__ __forceinline__ unsigned f2bf(float f) { unsigned u = __builtin_bit_cast(unsigned, f); return (u + 0x7fffu + ((u >> 16) & 1u)) >> 16; }
__device__ __forceinline__ unsigned pk2(float lo, float hi) { return f2bf(lo) | (f2bf(hi) << 16); }

#define XB_TMO      128
#define XB_XCNT(j)  (256  + 64 * (j))
#define XB_XSUB(j)  (1280 + 64 * (j))
#define XB_XGEN(j)  (2304 + 64 * (j))
#define XB_TOP      3328
#define XB_TOPGEN   3392
#define XCD_BAR_WORDS 3456
#define XB_SPIN_CAP (1u << 18)

__device__ __forceinline__ unsigned xb_ld(unsigned* p)              { return __hip_atomic_load(p, __ATOMIC_RELAXED, __HIP_MEMORY_SCOPE_AGENT); }
__device__ __forceinline__ unsigned xb_add(unsigned* p, unsigned v) { return __hip_atomic_fetch_add(p, v, __ATOMIC_RELAXED, __HIP_MEMORY_SCOPE_AGENT); }
__device__ __forceinline__ unsigned xb_xcc_id() { return (unsigned)__builtin_amdgcn_s_getreg((3 << 11) | 20) & 0xFu; }
#define XB_SPIN(cond, bar) do { unsigned _sp = 0; while (cond) { __builtin_amdgcn_s_sleep(1); \
    if ((++_sp & 255u) == 0u) { if (xb_ld(&(bar)[XB_TMO])) break; if (_sp > XB_SPIN_CAP) { atomicAdd(&(bar)[XB_TMO], 1u); break; } } } } while (0)

struct XcdBarrier {
    unsigned* bar; unsigned x;
    volatile LAS unsigned* st;
};

__device__ __forceinline__ XcdBarrier xcd_barrier_post(unsigned* bar, volatile LAS unsigned* st) {
    XcdBarrier b; b.bar = bar; b.x = xb_xcc_id(); b.st = st;
    if (threadIdx.x == 0) (void)xb_add(&bar[XB_XCNT(b.x)], 1u);
    return b;
}
__device__ __forceinline__ void xcd_barrier_complete(unsigned* bar, unsigned x, unsigned& nloc, unsigned& nx) {
    const unsigned G = gridDim.x * gridDim.y * gridDim.z;
    unsigned sum, cnt, mine, sp = 0u;
    for (;;) {
        sum = 0u; cnt = 0u; mine = 0u;
#pragma unroll
        for (unsigned j = 0; j < 16; ++j) { const unsigned c = xb_ld(&bar[XB_XCNT(j)]); sum += c; cnt += (c > 0u) ? 1u : 0u; mine = (j == x) ? c : mine; }
        if (sum == G) break;
        __builtin_amdgcn_s_sleep(1);
        if ((++sp & 255u) == 0u) { if (xb_ld(&bar[XB_TMO])) break; if (sp > XB_SPIN_CAP) { atomicAdd(&bar[XB_TMO], 1u); break; } }
    }
    nloc = mine > 0u ? mine : 1u; nx = cnt > 0u ? cnt : 1u;
}

__device__ __forceinline__ void xcd_barrier(const XcdBarrier& b, const bool leader_thread  ) {
    asm volatile("s_waitcnt vmcnt(0)" ::: "memory");
    __syncthreads();
    if (leader_thread) {
        unsigned* bar = b.bar;
        __builtin_amdgcn_s_waitcnt(0);
        unsigned nloc = b.st[0], nx = b.st[1];
        if (nloc == 0u) { xcd_barrier_complete(bar, b.x, nloc, nx); b.st[0] = nloc; b.st[1] = nx; }
        const unsigned old = xb_add(&bar[XB_XSUB(b.x)], 1u);
        const unsigned gen = old / nloc;
        if (old + 1u == (gen + 1u) * nloc) {
            __builtin_amdgcn_fence(__ATOMIC_RELEASE, "agent");
            asm volatile("s_waitcnt vmcnt(0)" ::: "memory");
            const unsigned og = xb_add(&bar[XB_TOP], 1u);
            const unsigned tg = og / nx;
            if (og + 1u == (tg + 1u) * nx) xb_add(&bar[XB_TOPGEN], 1u);
            else XB_SPIN(xb_ld(&bar[XB_TOPGEN]) == tg, bar);
            __builtin_amdgcn_fence(__ATOMIC_ACQUIRE, "agent");
            xb_add(&bar[XB_XGEN(b.x)], 1u);
            asm volatile("s_waitcnt vmcnt(0)" ::: "memory");
        } else {
            XB_SPIN(xb_ld(&bar[XB_XGEN(b.x)]) == gen, bar);
            __builtin_amdgcn_fence(__ATOMIC_ACQUIRE, "agent");
            asm volatile("s_waitcnt vmcnt(0)" ::: "memory");
        }
    }
    __syncthreads();
}
constexpr size_t MiB = 1u << 20;
constexpr size_t al4k(size_t x) { return (x + 4095) & ~(size_t)4095; }
constexpr int NFT = 260;
constexpr int XS_TILES = 268, HS_TILES = 140, MOE_CHUNK0 = 128;
constexpr size_t WS_CTL = 0, CTL_BYTES = 1 * MiB;
constexpr size_t WS_MODS = WS_CTL + CTL_BYTES;
constexpr size_t WS_ROPEC = WS_MODS + al4k((size_t)DEPTH * 3 * 6 * D * 4);
constexpr size_t WS_ROPES = WS_ROPEC + al4k((size_t)SEQ * 16 * 4);
constexpr size_t WS_RSQ = WS_ROPES + al4k((size_t)SEQ * 16 * 4);
constexpr size_t WS_RSKV = WS_RSQ + al4k((size_t)MT * 4);
constexpr size_t WS_FPART = WS_RSKV + al4k((size_t)MT * 4);
constexpr size_t WS_TOKE = WS_FPART + al4k((size_t)NFT * 512 * 4);
constexpr size_t WS_TOKP = WS_TOKE + al4k((size_t)MT * 4);
constexpr size_t WS_TOKG = WS_TOKP + al4k((size_t)MT * 8);
constexpr size_t WS_XC = WS_TOKG + al4k((size_t)MT * 8);
constexpr size_t WS_WIN = WS_XC + al4k((size_t)NCTX * D * 4);
constexpr size_t WS_WUQ = WS_WIN + al4k((size_t)DEPTH * UW * D * 2);
constexpr size_t WS_WUKV = WS_WUQ + al4k((size_t)DEPTH * 768 * 384 * 2);
constexpr size_t WS_WPOOL = WS_WUKV + al4k((size_t)DEPTH * 1024 * 256 * 2);
constexpr size_t WS_WOUT = WS_WPOOL + al4k((size_t)DEPTH * 256 * 256 * 2);
constexpr size_t WS_WGU = WS_WOUT + al4k((size_t)DEPTH * D * D * 2);
constexpr size_t WS_WD = WS_WGU + al4k((size_t)2 * 2 * FF * D * 2);
constexpr size_t WS_MGU = WS_WD + al4k((size_t)2 * D * FF * 2);
constexpr size_t WS_MD = WS_MGU + al4k((size_t)2 * NEXP * 2 * FF * D * 2);
constexpr size_t WS_HF = WS_MD + al4k((size_t)2 * NEXP * D * FF * 2);
constexpr size_t WS_HFC = WS_HF + al4k((size_t)512 * SEQ * 4);
constexpr size_t WS_HN = WS_HFC + al4k((size_t)512 * CTXL * 4);
constexpr size_t WS_U = WS_HN + al4k((size_t)MT * D * 2);
constexpr size_t WS_DP = WS_U + al4k((size_t)MT * UW * 2);
constexpr size_t WS_Q = WS_DP + al4k((size_t)MT * 256 * 2);
constexpr size_t WS_KV = WS_Q + al4k((size_t)MT * 768 * 2);
constexpr size_t WS_MIX = WS_KV + al4k((size_t)NB * NHEAD * NKEY * KVW * 2);
constexpr size_t WS_ZT = WS_MIX + al4k((size_t)MT * D * 2);
constexpr size_t WS_ZCT = WS_ZT + al4k((size_t)NB * 256 * SEQ * 4);
constexpr size_t WS_YT = WS_ZCT + al4k((size_t)NB * 256 * CTXL * 4);
constexpr size_t WS_SLAB = WS_YT + al4k((size_t)NB * 256 * SEQ * 4);
constexpr size_t WS_END = WS_SLAB + al4k((size_t)4 * NCTX * D * 4);
constexpr size_t WS_H = WS_U;
constexpr size_t WS_XS = WS_U;
constexpr size_t WS_HS = WS_XS + al4k((size_t)XS_TILES * 256 * D * 2);
static_assert(WS_H + (size_t)MT * FF * 2 <= WS_KV + (size_t)NB * NHEAD * NKEY * KVW * 2, "dense hidden overlay");
static_assert(WS_HS + (size_t)HS_TILES * 256 * FF * 2 <= WS_END, "MoE overlay");
constexpr int CW_TMO = 0, CW_BAR = 4096, CW_GCNT = 16384;
constexpr int RING_BYTES = 131072, MISC_OFF = RING_BYTES + 320, LDS_BYTES = 147456;

struct Args { const float* in[34]; float* out; unsigned char* ws; int ph_lo, ph_hi; };
enum { I_X = 0, I_C, I_CTX, I_CCTX, I_N1G, I_N2G, I_WADA, I_BADA, I_WIN, I_HSW, I_HSB, I_FW1, I_FB1, I_FF1, I_FW2, I_FB2, I_FF2, I_FW3, I_HBIAS, I_POOLW, I_POOLS, I_QNG, I_WUQ, I_KVNG, I_WUKV,
       I_WOUT, I_FWG, I_FWU, I_FWD, I_ROUTER, I_MWG, I_MWU, I_MWD, I_FING };

struct Ctx {
    float* out; unsigned char* ws; LAS unsigned char* lds; volatile LAS unsigned* MISC;
    __device__ __forceinline__ const float* in(int k) const { const __attribute__((address_space(4))) Args* a = (const __attribute__((address_space(4))) Args*)__builtin_amdgcn_kernarg_segment_ptr();
        asm volatile("" : "+s"(a)); return (const float*)(const GAS float*)a->in[k]; }
    int tid, lane, wave, vcu, G;
    template <typename T> __device__ __forceinline__ T* p(size_t off) const { return (T*)(ws + off); }
};

template <int XM> __device__ __forceinline__ float swz_xor(float v) { return __builtin_bit_cast(float, __builtin_amdgcn_ds_swizzle(__builtin_bit_cast(int, v), (XM << 10) | 0x1f)); }
__device__ __forceinline__ float wave_sum(float v) {
    v += swz_xor<1>(v); v += swz_xor<2>(v); v += swz_xor<4>(v); v += swz_xor<8>(v); v += swz_xor<16>(v);
    { auto rr = __builtin_amdgcn_permlane32_swap(__float_as_uint(v), __float_as_uint(v), false, false); v = __uint_as_float(rr[0]) + __uint_as_float(rr[1]); }
    return v;
}
__device__ __forceinline__ float sin_turns(float x) { return __builtin_amdgcn_sinf(x); }
__device__ __forceinline__ float cos_turns(float x) { return __builtin_amdgcn_cosf(x); }
constexpr float INV_2PI = 0.15915494309189535f;
__device__ __forceinline__ float bf2f(unsigned short h) { return __uint_as_float((unsigned)h << 16); }
__device__ __forceinline__ void unpack8(const v4u w, float (&f)[8]) {
    f[0] = __uint_as_float(w.x << 16); f[1] = __uint_as_float(w.x & 0xffff0000u); f[2] = __uint_as_float(w.y << 16); f[3] = __uint_as_float(w.y & 0xffff0000u);
    f[4] = __uint_as_float(w.z << 16); f[5] = __uint_as_float(w.z & 0xffff0000u); f[6] = __uint_as_float(w.w << 16); f[7] = __uint_as_float(w.w & 0xffff0000u);
}
__device__ __forceinline__ v4u pack8f(const float (&f)[8]) { v4u o; o.x = pk2(f[0], f[1]); o.y = pk2(f[2], f[3]); o.z = pk2(f[4], f[5]); o.w = pk2(f[6], f[7]); return o; }

__device__ __forceinline__ int maprow(int mode, int n) {
    if (mode == 1) return 256 * (n >> 7) + (n & 127);
    if (mode == 2) return 256 * (n >> 7) + 128 + (n & 127);
    if (mode == 3) { const int h = n / DQK, d = n % DQK; if (d < 64) return n; const int r = d - 64, j = r & 15, g = j >> 2, i = j & 3; return h * DQK + 64 + 8 * g + (r < 16 ? 0 : 4) + i; }
    if (mode == 4) { const int d = n & 127; if (d < 64) return n; const int c = d - 64; return (n & ~127) + 64 + (c & 1) * 32 + (c >> 1); }
    return n;
}
__device__ __forceinline__ void transpose_item(const float* W, int K, int N, bf16* WT, int mode, const float* kscale, LAS float* scr, int item, int lane) {
    const int nblk = N / 32, kb = item / nblk, nb = item % nblk, k0 = 64 * kb, n0 = 32 * nb;
    float wv[32];
#pragma unroll
    for (int i = 0; i < 32; ++i) { const int kk = 2 * i + (lane >> 5); wv[i] = __builtin_nontemporal_load(W + (size_t)(k0 + kk) * N + n0 + (lane & 31)); }
#pragma unroll
    for (int i = 0; i < 32; ++i) { const int kk = 2 * i + (lane >> 5); float v = wv[i]; if (kscale) v *= kscale[k0 + kk]; scr[kk * 33 + (lane & 31)] = v; }
    LDS_WAIT(); asm volatile("" ::: "memory");
    const int c = lane & 7;
#pragma unroll
    for (int j = 0; j < 4; ++j) { const int n = (lane >> 3) + 8 * j; const LAS float* s = scr + (8 * c) * 33 + n;
        v4u o; o.x = pk2(s[0 * 33], s[1 * 33]); o.y = pk2(s[2 * 33], s[3 * 33]); o.z = pk2(s[4 * 33], s[5 * 33]); o.w = pk2(s[6 * 33], s[7 * 33]);
        *(GAS v4u*)(WT + (size_t)maprow(mode, n0 + n) * K + k0 + 8 * c) = o; }
    LDS_WAIT(); asm volatile("" ::: "memory");
}
struct Cat { int count, per; const float* src; size_t sstride; int K, N; bf16* dst; size_t dstride; int mode; const float* ks; int kstride; };
struct ItemD { const float* W; bf16* WT; const float* ks; int K, N, mode, k0, n0; };
__device__ __forceinline__ void ti_load(const ItemD& d, float (&wv)[32], int lane) {
#pragma unroll
    for (int i = 0; i < 32; ++i) { const int kk = 2 * i + (lane >> 5); wv[i] = __builtin_nontemporal_load(d.W + (size_t)(d.k0 + kk) * d.N + d.n0 + (lane & 31)); }
}
__device__ __forceinline__ void ti_store(const ItemD& d, const float (&wv)[32], LAS float* scr, int lane) {
#pragma unroll
    for (int i = 0; i < 32; ++i) { const int kk = 2 * i + (lane >> 5); float v = wv[i]; if (d.ks) v *= d.ks[d.k0 + kk]; scr[kk * 33 + (lane & 31)] = v; }
    LDS_WAIT(); asm volatile("" ::: "memory");
    const int c = lane & 7;
#pragma unroll
    for (int j = 0; j < 4; ++j) { const int n = (lane >> 3) + 8 * j; const LAS float* s = scr + (8 * c) * 33 + n;
        v4u o; o.x = pk2(s[0 * 33], s[1 * 33]); o.y = pk2(s[2 * 33], s[3 * 33]); o.z = pk2(s[4 * 33], s[5 * 33]); o.w = pk2(s[6 * 33], s[7 * 33]);
        *(GAS v4u*)(d.WT + (size_t)maprow(d.mode, d.n0 + n) * d.K + d.k0 + 8 * c) = o; }
    LDS_WAIT(); asm volatile("" ::: "memory");
}
template <int CLO, int CHI> __device__ __forceinline__ void item_resolve(const Cat (&cats)[11], int it, ItemD& d) {
    int r = it;
#pragma unroll
    for (int k = CLO; k < CHI; ++k) { const int n = cats[k].count * cats[k].per;
        if (r >= 0 && r < n) { const int mi = r / cats[k].per, item = r % cats[k].per; const int nblk = cats[k].N / 32;
            d.W = cats[k].src + mi * cats[k].sstride; d.WT = cats[k].dst + mi * cats[k].dstride; d.ks = cats[k].ks ? cats[k].ks + mi * cats[k].kstride : nullptr;
            d.K = cats[k].K; d.N = cats[k].N; d.mode = cats[k].mode; d.k0 = 64 * (item / nblk); d.n0 = 32 * (item % nblk); }
        r -= n; }
}
template <int CLO, int CHI> __device__ __forceinline__ void convert_cats(const Ctx& F, int gw, int NGW, int lane) {
    LAS float* scr = (LAS float*)(F.lds + F.wave * 16384);
    const Cat cats[11] = {
        {DEPTH, 16 * 53, F.in(I_WIN), (size_t)D * 1696, D, 1696, F.p<bf16>(WS_WIN), (size_t)UW * D, 0, nullptr, 0},
        {DEPTH, 6 * 24, F.in(I_WUQ), (size_t)384 * 768, 384, 768, F.p<bf16>(WS_WUQ), (size_t)768 * 384, 3, F.in(I_QNG), 384},
        {DEPTH, 4 * 32, F.in(I_WUKV), (size_t)256 * 1024, 256, 1024, F.p<bf16>(WS_WUKV), (size_t)1024 * 256, 4, F.in(I_KVNG), 256},
        {DEPTH, 16 * 32, F.in(I_WOUT), (size_t)D * D, D, D, F.p<bf16>(WS_WOUT), (size_t)D * D, 0, nullptr, 0},
        {2, 16 * 88, F.in(I_FWG), (size_t)D * FF, D, FF, F.p<bf16>(WS_WGU), (size_t)2 * FF * D, 1, nullptr, 0},
        {2, 16 * 88, F.in(I_FWU), (size_t)D * FF, D, FF, F.p<bf16>(WS_WGU), (size_t)2 * FF * D, 2, nullptr, 0},
        {2, 44 * 32, F.in(I_FWD), (size_t)FF * D, FF, D, F.p<bf16>(WS_WD), (size_t)D * FF, 0, nullptr, 0},
        {2 * NEXP, 16 * 88, F.in(I_MWG), (size_t)D * FF, D, FF, F.p<bf16>(WS_MGU), (size_t)2 * FF * D, 1, nullptr, 0},
        {2 * NEXP, 16 * 88, F.in(I_MWU), (size_t)D * FF, D, FF, F.p<bf16>(WS_MGU), (size_t)2 * FF * D, 2, nullptr, 0},
        {2 * NEXP, 44 * 32, F.in(I_MWD), (size_t)FF * D, FF, D, F.p<bf16>(WS_MD), (size_t)D * FF, 0, nullptr, 0},
        {0, 1, nullptr, 0, 0, 0, nullptr, 0, 0, nullptr, 0}};
    int total = 0;
#pragma unroll
    for (int k = CLO; k < CHI; ++k) total += cats[k].count * cats[k].per;
    int it = 2 * gw; ItemD dA, dB, dC, dD; float wA[32], wB[32], wC[32], wD[32]; bool hA, hC;
#define CV_LD(X, Y) do { h##X = it < total; if (h##X) { item_resolve<CLO, CHI>(cats, it, d##X); ti_load(d##X, w##X, lane); item_resolve<CLO, CHI>(cats, it + 1, d##Y); ti_load(d##Y, w##Y, lane); } it += 2 * NGW; } while (0)
    CV_LD(A, B); CV_LD(C, D);
    while (hA) {
        ti_store(dA, wA, scr, lane); ti_store(dB, wB, scr, lane); CV_LD(A, B); if (!hC) break;
        ti_store(dC, wC, scr, lane); ti_store(dD, wD, scr, lane); CV_LD(C, D);
    }
#undef CV_LD
}
__device__ __forceinline__ void p0_prologue(const Ctx& F) {
    convert_cats<0, 3>(F, F.vcu * 8 + F.wave, F.G * 8, F.lane);
    const int gt = F.vcu * 512 + F.tid, NGT = F.G * 512;
    for (int i = gt; i < DEPTH * 96 * (D / 8); i += NGT) { const int l = i / (96 * (D / 8)), r = i % (96 * (D / 8)); *(GAS v4u*)(F.p<bf16>(WS_WIN) + ((size_t)l * UW + 1696) * D + (size_t)r * 8) = (v4u){0u, 0u, 0u, 0u}; }
    { const float* poolw = F.in(I_POOLW);
    for (int i = gt; i < DEPTH * 256 * 256; i += NGT) { const int l = i >> 16, n = (i >> 8) & 255, k = i & 255, g = n >> 6;
        const float v = (k >> 6) == g ? poolw[(((size_t)l * 4 + g) * 64 + (k & 63)) * 64 + (n & 63)] : 0.f; F.p<bf16>(WS_WPOOL)[i] = (bf16)f2bf(v); } }
    for (int i = gt; i < SEQ * 16; i += NGT) { const int t = i >> 4, j = i & 15; const int pos = j < 8 ? (t >> 6) : (t & 63);
        const float invf[8] = {1.0f, 0.31622776601683794f, 0.1f, 0.031622776601683791f, 0.01f, 0.0031622776601683794f, 0.001f, 0.00031622776601683794f};
        const float ang = (float)pos * invf[j & 7];
        const double tr = (double)ang * 0.15915494309189535; const float fr = (float)(tr - __builtin_floor(tr));
        F.p<float>(WS_ROPEC)[i] = cos_turns(fr); F.p<float>(WS_ROPES)[i] = sin_turns(fr); }
    { const GAS f32x4* s2 = (const GAS f32x4*)F.in(I_CTX); GAS f32x4* d2 = (GAS f32x4*)F.p<float>(WS_XC); for (int i = gt; i < NCTX * D / 4; i += NGT) d2[i] = s2[i]; }
    __syncthreads();
    LAS float* red = (LAS float*)F.lds;
    const float* cvec = F.in(I_C); const float* cctx = F.in(I_CCTX); const float* wada = F.in(I_WADA); const float* bada = F.in(I_BADA);
    LAS float* sl = (LAS float*)(F.lds + 8192);
    for (int i = F.tid; i < 3 * D; i += 512) { const float c0 = i < 2 * D ? cvec[i] : cctx[i - 2 * D]; sl[i] = c0 * __builtin_amdgcn_rcpf(1.f + __expf(-c0)); }
    __syncthreads();
    for (int it = F.vcu; it < DEPTH * 96; it += F.G) {
        const int l = it / 96, n = (it % 96) * 64 + F.lane; const float* W = wada + (size_t)l * D * 6 * D + n;
        float a0 = 0.f, a1 = 0.f, a2 = 0.f;
#pragma unroll 1
        for (int kb = 0; kb < 128; kb += 32) {
            float wv[32];
#pragma unroll
            for (int j = 0; j < 32; ++j) wv[j] = __builtin_nontemporal_load(W + (size_t)(F.wave * 128 + kb + j) * 6 * D);
#pragma unroll
            for (int j = 0; j < 32; ++j) { const int k = F.wave * 128 + kb + j; a0 += wv[j] * sl[k]; a1 += wv[j] * sl[D + k]; a2 += wv[j] * sl[2 * D + k]; }
        }
        red[(F.wave * 3 + 0) * 64 + F.lane] = a0; red[(F.wave * 3 + 1) * 64 + F.lane] = a1; red[(F.wave * 3 + 2) * 64 + F.lane] = a2;
        __syncthreads();
        if (F.tid < 192) { const int v = F.tid >> 6, ln = F.tid & 63; float s = 0.f;
#pragma unroll
            for (int w = 0; w < 8; ++w) s += red[(w * 3 + v) * 64 + ln];
            const int nn = (it % 96) * 64 + ln; F.p<float>(WS_MODS)[((size_t)l * 3 + v) * 6 * D + nn] = s + bada[(size_t)l * 6 * D + nn]; }
        __syncthreads();
    }
}

__device__ __forceinline__ void filter_tile(const Ctx& F, int l, int tile) {
    LAS float* feat = (LAS float*)F.lds;
    LAS float* h1 = feat + 64 * 33;
    constexpr int H2P = 65;
    LAS float* h2 = h1 + 64 * 64;
    const bool lat = tile < 256; const int L = lat ? SEQ : CTXL; const int p0 = (lat ? tile : tile - 256) * 64;
    const float invLm1 = 1.0f / (float)(L - 1), invL = 1.0f / (float)L;
    for (int idx = F.tid; idx < 64 * 33; idx += 512) { const int p = idx / 33, k = idx % 33; const float pos = (float)(p0 + p);
        float v;
        if (k == 0) v = pos * invLm1;
        else { const int j = (k - 1) & 15; const float fj = 1e-4f + (float)j * ((15.0f - 1e-4f) / 15.0f); const float x = fj * pos * invL; const float fr = x - __builtin_floorf(x);
            v = k <= 16 ? cos_turns(fr) : -sin_turns(fr); }
        feat[idx] = v; }
    __syncthreads();
    { const int j = F.tid & 63, pg = F.tid >> 6; const float* w1 = F.in(I_FW1) + (size_t)l * 33 * 64 + j; float w[33];
#pragma unroll
      for (int k = 0; k < 33; ++k) w[k] = w1[k * 64];
      const float b = F.in(I_FB1)[l * 64 + j], fq = F.in(I_FF1)[l * 64 + j];
#pragma unroll 1
      for (int pp = 0; pp < 8; ++pp) { const int p = pg * 8 + pp; float a = b;
#pragma unroll
          for (int k = 0; k < 33; ++k) a += feat[p * 33 + k] * w[k];
          const float x = fq * a * INV_2PI; h1[p * 64 + j] = sin_turns(x - __builtin_floorf(x)); } }
    __syncthreads();
    { const int j = F.tid & 63, pg = F.tid >> 6; const float* w2 = F.in(I_FW2) + (size_t)l * 64 * 64 + j; float w[64];
#pragma unroll
      for (int k = 0; k < 64; ++k) w[k] = w2[k * 64];
      const float b = F.in(I_FB2)[l * 64 + j], fq = F.in(I_FF2)[l * 64 + j];
#pragma unroll 1
      for (int pp = 0; pp < 8; ++pp) { const int p = pg * 8 + pp; float a = b;
#pragma unroll
          for (int k = 0; k < 64; ++k) a += h1[p * 64 + k] * w[k];
          const float x = fq * a * INV_2PI; h2[p * H2P + j] = sin_turns(x - __builtin_floorf(x)); } }
    __syncthreads();
    {
      typedef float f32x16v __attribute__((ext_vector_type(16)));
      const int r32 = F.lane & 31, hi = F.lane >> 5;
      const float* w3 = F.in(I_FW3) + (size_t)l * 64 * 512 + F.wave * 64 + r32 + hi * 512;
      const LAS float* ha = h2 + r32 * H2P + hi;
      f32x16v acc[2][2] = {};
      float wb0[32], wb1[32];
#pragma unroll
      for (int s2 = 0; s2 < 32; ++s2) { wb0[s2] = w3[(size_t)(2 * s2) * 512]; wb1[s2] = w3[(size_t)(2 * s2) * 512 + 32]; }
#pragma unroll
      for (int s2 = 0; s2 < 32; ++s2) {
          const float a0 = ha[2 * s2], a1 = ha[32 * H2P + 2 * s2], b0 = wb0[s2], b1 = wb1[s2];
          acc[0][0] = __builtin_amdgcn_mfma_f32_32x32x2f32(a0, b0, acc[0][0], 0, 0, 0); acc[0][1] = __builtin_amdgcn_mfma_f32_32x32x2f32(a0, b1, acc[0][1], 0, 0, 0);
          acc[1][0] = __builtin_amdgcn_mfma_f32_32x32x2f32(a1, b0, acc[1][0], 0, 0, 0); acc[1][1] = __builtin_amdgcn_mfma_f32_32x32x2f32(a1, b1, acc[1][1], 0, 0, 0); }
      LAS float* T = h2 + 64 * H2P;
      float* dst = lat ? F.p<float>(WS_HF) + p0 : F.p<float>(WS_HFC) + p0; const int pitch = lat ? SEQ : CTXL;
      float asum[2] = {0.f, 0.f};
#pragma unroll
      for (int pb = 0; pb < 2; ++pb) {
#pragma unroll
          for (int cb = 0; cb < 2; ++cb) { const int n = F.wave * 64 + 32 * cb + r32, c = n & 255; const float dl = 3.0701134573253946f + (float)c * ((15.350567286626973f - 3.0701134573253946f) / 255.0f);
#pragma unroll
              for (int r = 0; r < 16; ++r) { const int pq = (r & 3) + 8 * (r >> 2) + 4 * hi, p = 32 * pb + pq; const float tt = (float)(p0 + p) * invLm1; const float v = acc[pb][cb][r] * __expf(-tt * dl);
                  T[n * 33 + pq] = v; if (!(n >= 256 && p0 + p == 0)) asum[cb] += __builtin_fabsf(v); } }
          __syncthreads();
#pragma unroll 4
          for (int i = 0; i < 32; ++i) { const int row = F.wave * 64 + 2 * i + (F.lane >> 5), pl = F.lane & 31; dst[(size_t)row * pitch + pb * 32 + pl] = T[row * 33 + pl]; }
          __syncthreads(); }
#pragma unroll
      for (int cb = 0; cb < 2; ++cb) { auto rr = __builtin_amdgcn_permlane32_swap(__float_as_uint(asum[cb]), __float_as_uint(asum[cb]), false, false); const float tot = __uint_as_float(rr[0]) + __uint_as_float(rr[1]);
          if (hi == 0) F.p<float>(WS_FPART)[(size_t)tile * 512 + F.wave * 64 + 32 * cb + r32] = tot; } }
    __syncthreads();
}

template <int WHICH, bool COMBINE, bool ROUTE, bool FROM_INPUT = false, int NSLAB = 0  >
__device__ __forceinline__ void norm_phase(const Ctx& F, int l, int lprev  , int moe_idx  ) {
    const float* xin = FROM_INPUT ? F.in(I_X) : nullptr;
    const int gw = F.vcu * 8 + F.wave, NGW = F.G * 8;
    const float* gain = WHICH == 0 ? F.in(I_N1G) + l * D : WHICH == 1 ? F.in(I_N2G) + l * D : F.in(I_FING);
    const float* mods = F.p<float>(WS_MODS) + (size_t)l * 3 * 6 * D;
    const float* modp = F.p<float>(WS_MODS) + (size_t)lprev * 3 * 6 * D + 5 * D;
    const int rows = WHICH == 2 ? LAT : MT;
    LAS float* wr_l = (LAS float*)F.lds;
    LAS int* lcnt = (LAS int*)(F.lds + 32768);
    LAS int* rec = (LAS int*)(F.lds + 32768 + 64);
    if (ROUTE) {
        const float* wr = F.in(I_ROUTER) + (size_t)moe_idx * D * NEXP;
        for (int i = F.tid; i < D * NEXP / 4; i += 512) ((LAS f32x4*)wr_l)[i] = ((const f32x4*)wr)[i];
        if (F.tid < 16) lcnt[F.tid] = 0;
        __syncthreads();
    }
    int ri = 0;
    int nd0 = 0, nd1 = 0; float ng0 = 0.f, ng1 = 0.f;
    if (COMBINE && gw < rows) { nd0 = F.p<int>(WS_TOKP)[2 * gw]; nd1 = F.p<int>(WS_TOKP)[2 * gw + 1]; ng0 = F.p<float>(WS_TOKG)[2 * gw]; ng1 = F.p<float>(WS_TOKG)[2 * gw + 1]; }
    f32x4 vn[4];
    const bf16* xbf = (const bf16*)F.out;
#define NRM_LOAD(r) do { const int r_ = (r); if ((FROM_INPUT && r_ < LAT) || r_ >= LAT) { const float* xs_ = (FROM_INPUT && r_ < LAT) ? xin + (size_t)r_ * D : F.p<float>(WS_XC) + (size_t)(r_ - LAT) * D; \
        _Pragma("unroll") for (int j = 0; j < 4; ++j) vn[j] = ((const GAS f32x4*)xs_)[F.lane + 64 * j]; } \
      else { const bf16* xs_ = xbf + (size_t)r_ * (2 * D); \
        _Pragma("unroll") for (int j = 0; j < 4; ++j) { const v2u w_ = ((const GAS v2u*)xs_)[F.lane + 64 * j]; vn[j] = (f32x4){__uint_as_float(w_.x), __uint_as_float(w_.y), 0.f, 0.f}; } } } while (0)
#define NRM_UNPACK(r, V) do { const int r_ = (r); if (!((FROM_INPUT && r_ < LAT) || r_ >= LAT)) { _Pragma("unroll") for (int j = 0; j < 4; ++j) { const unsigned a_ = __float_as_uint(V[j].x), b_ = __float_as_uint(V[j].y); \
        V[j] = (f32x4){__uint_as_float(a_ << 16), __uint_as_float(a_ & 0xffff0000u), __uint_as_float(b_ << 16), __uint_as_float(b_ & 0xffff0000u)}; } } } while (0)
    if (gw < rows) NRM_LOAD(gw);
    for (int row = gw; row < rows; row += NGW, ++ri) {
        const int vsel = row < SEQ ? 0 : (row < LAT ? 1 : 2);
        float* xr = row < LAT ? F.out + (size_t)row * D : F.p<float>(WS_XC) + (size_t)(row - LAT) * D;
        bf16* xrb = (bf16*)F.out + (size_t)row * (2 * D);
        f32x4 v[4];
#pragma unroll
        for (int j = 0; j < 4; ++j) v[j] = vn[j];
        NRM_UNPACK(row, v);
        if (NSLAB > 0 && row >= LAT) { const float* sl = F.p<float>(WS_SLAB) + (size_t)(row - LAT) * D;
#pragma unroll
            for (int k = 0; k < NSLAB; ++k)
#pragma unroll
                for (int j = 0; j < 4; ++j) v[j] = v[j] + ((const GAS f32x4*)(sl + (size_t)k * NCTX * D))[F.lane + 64 * j];
#pragma unroll
            for (int j = 0; j < 4; ++j) ((GAS f32x4*)xr)[F.lane + 64 * j] = v[j]; }
        if (COMBINE) {
            const int d0 = nd0, d1 = nd1; const float g0 = ng0, g1 = ng1;
            if (row + NGW < rows) { const int rn = row + NGW; nd0 = F.p<int>(WS_TOKP)[2 * rn]; nd1 = F.p<int>(WS_TOKP)[2 * rn + 1]; ng0 = F.p<float>(WS_TOKG)[2 * rn]; ng1 = F.p<float>(WS_TOKG)[2 * rn + 1]; }
            const bf16* y0 = F.p<bf16>(WS_XS) + (size_t)d0 * D, *y1 = F.p<bf16>(WS_XS) + (size_t)d1 * D;
#pragma unroll
            for (int j = 0; j < 4; ++j) { const int col = 4 * F.lane + 256 * j; const uint2 a = *(const uint2*)(y0 + col), b = *(const uint2*)(y1 + col); const f32x4 m5 = *(const f32x4*)(modp + vsel * 6 * D + col);
                f32x4 ya = {__uint_as_float(a.x << 16), __uint_as_float(a.x & 0xffff0000u), __uint_as_float(a.y << 16), __uint_as_float(a.y & 0xffff0000u)};
                f32x4 yb = {__uint_as_float(b.x << 16), __uint_as_float(b.x & 0xffff0000u), __uint_as_float(b.y << 16), __uint_as_float(b.y & 0xffff0000u)};
                v[j] = v[j] + m5 * (ya * g0 + yb * g1);
                if (WHICH != 2) { if (row < LAT) ((GAS v2u*)xrb)[F.lane + 64 * j] = (v2u){pk2(v[j].x, v[j].y), pk2(v[j].z, v[j].w)}; else ((GAS f32x4*)xr)[F.lane + 64 * j] = v[j]; } }
        }
        float s = 0.f;
#pragma unroll
        for (int j = 0; j < 4; ++j) s += (v[j].x * v[j].x + v[j].y * v[j].y) + (v[j].z * v[j].z + v[j].w * v[j].w);
        const float* sh = mods + vsel * 6 * D + (WHICH == 0 ? 0 : 3) * D; const float* sc = sh + D;
        f32x4 gv[4], av[4], bv[4];
#pragma unroll
        for (int j = 0; j < 4; ++j) { const int col = 4 * F.lane + 256 * j; gv[j] = *(const f32x4*)(gain + col); if (WHICH != 2) { av[j] = *(const f32x4*)(sh + col); bv[j] = *(const f32x4*)(sc + col); } }
        asm volatile("" ::: "memory");
        if (row + NGW < rows) NRM_LOAD(row + NGW);
        asm volatile("" ::: "memory");
        const float rstd = 1.0f / sqrtf(wave_sum(s) * (1.0f / D) + 1e-6f);
        if (WHICH == 2) {
#pragma unroll
            for (int j = 0; j < 4; ++j) { const f32x4 g = gv[j]; ((GAS f32x4*)xr)[F.lane + 64 * j] = v[j] * rstd * g; }
        } else {
            bf16* hn = F.p<bf16>(WS_HN) + (size_t)row * D;
            float lg[8] = {0.f, 0.f, 0.f, 0.f, 0.f, 0.f, 0.f, 0.f};
#pragma unroll
            for (int j = 0; j < 4; ++j) { const int col = 4 * F.lane + 256 * j; const f32x4 g = gv[j], a = av[j], b = bv[j];
                const f32x4 h = v[j] * rstd * g * (b + 1.0f) + a;
                *(uint2*)(hn + col) = make_uint2(pk2(h.x, h.y), pk2(h.z, h.w));
                if (ROUTE) {
#pragma unroll
                    for (int q = 0; q < 4; ++q) { const f32x4 w0 = *(const LAS f32x4*)(wr_l + (col + q) * 8), w1 = *(const LAS f32x4*)(wr_l + (col + q) * 8 + 4);
                        lg[0] += h[q] * w0.x; lg[1] += h[q] * w0.y; lg[2] += h[q] * w0.z; lg[3] += h[q] * w0.w; lg[4] += h[q] * w1.x; lg[5] += h[q] * w1.y; lg[6] += h[q] * w1.z; lg[7] += h[q] * w1.w; } } }
            if (ROUTE) {
#pragma unroll
                for (int e = 0; e < 8; ++e) lg[e] = wave_sum(lg[e]);
                int e0 = 0; float v0 = lg[0];
#pragma unroll
                for (int e = 1; e < 8; ++e) if (lg[e] > v0) { v0 = lg[e]; e0 = e; }
                int e1 = -1; float v1 = -3.0e38f;
#pragma unroll
                for (int e = 0; e < 8; ++e) if (e != e0 && lg[e] > v1) { v1 = lg[e]; e1 = e; }
                const float g1 = 1.0f / (1.0f + __expf(v0 - v1)), g0 = 1.0f - g1;
                if (F.lane == 0) { const int p0 = __hip_atomic_fetch_add(lcnt + e0, 1, __ATOMIC_RELAXED, __HIP_MEMORY_SCOPE_WORKGROUP), p1 = __hip_atomic_fetch_add(lcnt + e1, 1, __ATOMIC_RELAXED, __HIP_MEMORY_SCOPE_WORKGROUP);
                    LAS int* rc = rec + (F.wave * 20 + ri) * 3; rc[0] = e0 | (e1 << 8); rc[1] = p0; rc[2] = p1;
                    F.p<float>(WS_TOKG)[2 * row] = g0; F.p<float>(WS_TOKG)[2 * row + 1] = g1; }
            }
        }
    }
    if (ROUTE) {
        __syncthreads();
        if (F.tid < 8) lcnt[8 + F.tid] = (int)__hip_atomic_fetch_add(F.p<unsigned>(WS_CTL) + CW_GCNT + 64 * (8 * moe_idx + F.tid), (unsigned)lcnt[F.tid], __ATOMIC_RELAXED, __HIP_MEMORY_SCOPE_AGENT);
        __syncthreads();
        if (F.lane == 0) { int k = 0; for (int row = gw; row < rows; row += NGW, ++k) { const LAS int* rc = rec + (F.wave * 20 + k) * 3; const int ee = rc[0], e0 = ee & 255, e1 = ee >> 8;
            F.p<int>(WS_TOKE)[row] = ee; F.p<int>(WS_TOKP)[2 * row] = lcnt[8 + e0] + rc[1]; F.p<int>(WS_TOKP)[2 * row + 1] = lcnt[8 + e1] + rc[2]; } }
        __syncthreads();
    }
}
__device__ __forceinline__ void moe_tile_starts(const Ctx& F, int moe_idx, int (&ts)[9]) {
    int acc = 0;
#pragma unroll
    for (int e = 0; e < 8; ++e) { ts[e] = acc; const unsigned c = (unsigned)__builtin_amdgcn_readfirstlane((int)__hip_atomic_load(F.p<unsigned>(WS_CTL) + CW_GCNT + 64 * (8 * moe_idx + e), __ATOMIC_RELAXED, __HIP_MEMORY_SCOPE_AGENT)); acc += (int)((c + 255u) >> 8); }
    ts[8] = acc;
}
__device__ __forceinline__ void moe_scatter(const Ctx& F, int moe_idx) {
    int ts[9]; moe_tile_starts(F, moe_idx, ts);
    const int gw = F.vcu * 8 + F.wave, NGW = F.G * 8;
    for (int row0 = gw; row0 < MT; row0 += 4 * NGW) {
        int ee[4], p0[4], p1[4]; bool ok[4];
#pragma unroll
        for (int q = 0; q < 4; ++q) { const int row = row0 + q * NGW; ok[q] = row < MT; const int r = ok[q] ? row : row0; ee[q] = F.p<int>(WS_TOKE)[r]; p0[q] = F.p<int>(WS_TOKP)[2 * r]; p1[q] = F.p<int>(WS_TOKP)[2 * r + 1]; }
        v4u a[4], b[4]; int d0[4], d1[4];
#pragma unroll
        for (int q = 0; q < 4; ++q) { const int row = ok[q] ? row0 + q * NGW : row0; const GAS v4u* src = (const GAS v4u*)(F.p<bf16>(WS_HN) + (size_t)row * D); a[q] = src[F.lane]; b[q] = src[64 + F.lane];
            const int e0 = ee[q] & 255, e1 = ee[q] >> 8; int s0 = 0, s1 = 0;
#pragma unroll
            for (int e = 0; e < 8; ++e) { s0 = e == e0 ? ts[e] : s0; s1 = e == e1 ? ts[e] : s1; }
            d0[q] = s0 * 256 + p0[q]; d1[q] = s1 * 256 + p1[q]; }
#pragma unroll
        for (int q = 0; q < 4; ++q) if (ok[q]) { const int row = row0 + q * NGW;
            GAS v4u* o0 = (GAS v4u*)(F.p<bf16>(WS_XS) + (size_t)d0[q] * D); GAS v4u* o1 = (GAS v4u*)(F.p<bf16>(WS_XS) + (size_t)d1[q] * D);
            o0[F.lane] = a[q]; o0[64 + F.lane] = b[q]; o1[F.lane] = a[q]; o1[64 + F.lane] = b[q];
            if (F.lane == 0) { F.p<int>(WS_TOKP)[2 * row] = d0[q]; F.p<int>(WS_TOKP)[2 * row + 1] = d1[q]; } }
    }
}
struct TileInfo { int r0, b, t0, L; bool lat; };
__device__ __forceinline__ TileInfo tile_info(int T) {
    TileInfo ti; ti.lat = T < 512;
    if (ti.lat) { ti.r0 = T * 64; ti.b = T >> 8; ti.t0 = (T & 255) * 64; ti.L = SEQ; }
    else { const int rc = (T - 512) * 64; ti.r0 = LAT + rc; ti.b = rc >> 8; ti.t0 = rc & 255; ti.L = CTXL; }
    return ti;
}
__device__ __forceinline__ void sconv8(const bf16* Urow0  , int t, int L, int col, const float* sw, const float* sb, float (&o)[8]) {
    float a[8], b[8], c[8];
    const v4u z = {0u, 0u, 0u, 0u};
    const v4u um = t > 0 ? *(const GAS v4u*)(Urow0 + (size_t)(t - 1) * UW + col) : z;
    const v4u u0 = *(const GAS v4u*)(Urow0 + (size_t)t * UW + col);
    const v4u up = t + 1 < L ? *(const GAS v4u*)(Urow0 + (size_t)(t + 1) * UW + col) : z;
    unpack8(um, a); unpack8(u0, b); unpack8(up, c);
    const f32x4 w0a = *(const f32x4*)(sw + col), w0b = *(const f32x4*)(sw + col + 4), w1a = *(const f32x4*)(sw + 768 + col), w1b = *(const f32x4*)(sw + 768 + col + 4),
                w2a = *(const f32x4*)(sw + 1536 + col), w2b = *(const f32x4*)(sw + 1536 + col + 4), ba = *(const f32x4*)(sb + col), bb = *(const f32x4*)(sb + col + 4);
#pragma unroll
    for (int i = 0; i < 4; ++i) { o[i] = a[i] * w0a[i] + b[i] * w1a[i] + c[i] * w2a[i] + ba[i]; o[4 + i] = a[4 + i] * w0b[i] + b[4 + i] * w1b[i] + c[4 + i] * w2b[i] + bb[i]; }
}
__device__ __forceinline__ void prep_item(const Ctx& F, const bf16* Us, int t, int L, int row, int j, const float* sw, const float* sb, float (&z)[8]) {
    float x1[8], vv[8]; sconv8(Us, t, L, C_HY + 256 + 8 * j, sw, sb, x1); sconv8(Us, t, L, C_HY + 512 + 8 * j, sw, sb, vv);
#pragma unroll
    for (int q = 0; q < 8; ++q) z[q] = x1[q] * vv[q];
}
template <int HALF> __device__ __forceinline__ void pool_item(const Ctx& F, const bf16* Us, int t, int L, int row, int col  , int dcol) {
    v4u w[2 * HALF];
#pragma unroll
    for (int k = 0; k < 2 * HALF; ++k) { int s = t - HALF + k; s = s < 0 ? 0 : (s >= L ? L - 1 : s); w[k] = *(const GAS v4u*)(Us + (size_t)s * UW + col); }
    float acc[8] = {0.f, 0.f, 0.f, 0.f, 0.f, 0.f, 0.f, 0.f}, pt[8];
#pragma unroll
    for (int k = 0; k < 2 * HALF; ++k) { const int s = t - HALF + k; const float m = (s >= 0 && s < L) ? 1.0f : 0.0f; float f[8]; unpack8(w[k], f);
#pragma unroll
        for (int q = 0; q < 8; ++q) acc[q] += m * f[q]; }
    unpack8(w[HALF], pt);
    const int lo = t - HALF < 0 ? 0 : t - HALF, hi = t + HALF > L ? L : t + HALF; const float inv = 1.0f / (float)(hi - lo);
#pragma unroll
    for (int q = 0; q < 8; ++q) acc[q] = acc[q] * inv - pt[q];
    *(GAS v4u*)(F.p<bf16>(WS_DP) + (size_t)row * 256 + dcol) = pack8f(acc);
}
__device__ __forceinline__ void pool_item_g(const Ctx& F, int g, const bf16* Us, int t, int L, int row, int chunk  ) {
    const int dcol = 64 * g + 8 * chunk, col = C_POOL + dcol;
    if (g == 0) pool_item<1>(F, Us, t, L, row, col, dcol); else if (g == 1) pool_item<2>(F, Us, t, L, row, col, dcol); else if (g == 2) pool_item<4>(F, Us, t, L, row, col, dcol); else pool_item<8>(F, Us, t, L, row, col, dcol);
}
__device__ __forceinline__ void prep_row(const Ctx& F, int row, int t, int b, bool lat) {
    const bf16* ur = F.p<bf16>(WS_U) + (size_t)row * UW;
    float sq = 0.f, skv = 0.f;
    if (F.lane < 48) { float f[8]; unpack8(*(const GAS v4u*)(ur + C_CQ + 8 * F.lane), f);
#pragma unroll
        for (int q = 0; q < 8; ++q) sq += f[q] * f[q]; }
    if (F.lane < 32) { float f[8]; unpack8(*(const GAS v4u*)(ur + C_CKV + 8 * F.lane), f);
#pragma unroll
        for (int q = 0; q < 8; ++q) skv += f[q] * f[q]; }
    sq = wave_sum(sq); skv = wave_sum(skv);
    if (F.lane == 0) { F.p<float>(WS_RSQ)[row] = 1.0f / sqrtf(sq * (1.0f / 384.0f) + 1e-6f); F.p<float>(WS_RSKV)[row] = 1.0f / sqrtf(skv * (1.0f / 256.0f) + 1e-6f); }
    if (F.lane < 16) { const int h = F.lane >> 1, i = F.lane & 1; float x1[8], x2[8];
        unpack8(*(const GAS v4u*)(ur + C_KPE + 8 * i), x1); unpack8(*(const GAS v4u*)(ur + C_KPE + 16 + 8 * i), x2);
        if (lat) { const float* cp = F.p<float>(WS_ROPEC) + t * 16 + 8 * i; const float* sp = F.p<float>(WS_ROPES) + t * 16 + 8 * i;
#pragma unroll
            for (int q = 0; q < 8; ++q) { const float c = cp[q], s = sp[q], a = x1[q] * c - x2[q] * s, bb = x1[q] * s + x2[q] * c; x1[q] = a; x2[q] = bb; } }
        const float o0[8] = {x1[0], x1[1], x1[2], x1[3], x2[0], x2[1], x2[2], x2[3]}, o1[8] = {x1[4], x1[5], x1[6], x1[7], x2[4], x2[5], x2[6], x2[7]};
        const int key = lat ? CTXL + t : t;
        bf16* dst = F.p<bf16>(WS_KV) + ((size_t)(b * NHEAD + h) * NKEY + key) * KVW + 64 + 16 * i;
        *(GAS v4u*)dst = pack8f(o0); *(GAS v4u*)(dst + 8) = pack8f(o1); }
}
__device__ __forceinline__ void prep_phase(const Ctx& F, int l) {
    LAS float* zs = (LAS float*)F.lds;
    const bf16* U = F.p<bf16>(WS_U);
    const float* sw = F.in(I_HSW) + (size_t)l * 3 * 768; const float* sb = F.in(I_HSB) + (size_t)l * 768;
    for (int T = F.vcu; T < LAT / 64; T += F.G) {
        const TileInfo ti = tile_info(T); const bf16* Us = U + (size_t)(ti.r0 - ti.t0) * UW;
#pragma unroll
        for (int i = 0; i < 4; ++i) { const int item = F.tid + 512 * i, tl = item >> 5, j = item & 31; float z[8];
            prep_item(F, Us, ti.t0 + tl, ti.L, ti.r0 + tl, j, sw, sb, z);
#pragma unroll
            for (int q = 0; q < 8; ++q) zs[tl * 257 + 8 * j + q] = z[q]; }
        { const int g = F.wave & 3, chunk = F.lane & 7;
#pragma unroll 1
          for (int i = 0; i < 4; ++i) { const int tl = 32 * (F.wave >> 2) + 8 * i + (F.lane >> 3); pool_item_g(F, g, Us, ti.t0 + tl, ti.L, ti.r0 + tl, chunk); } }
#pragma unroll 2
        for (int rr = 0; rr < 8; ++rr) { const int tl = F.wave * 8 + rr; prep_row(F, ti.r0 + tl, ti.t0 + tl, ti.b, true); }
        __syncthreads();
        { float* zt = F.p<float>(WS_ZT) + (size_t)ti.b * 256 * SEQ + ti.t0;
#pragma unroll 8
          for (int cc = 0; cc < 32; ++cc) { const int c = F.wave * 32 + cc; zt[(size_t)c * SEQ + F.lane] = zs[F.lane * 257 + c]; } }
        __syncthreads();
    }
    for (int P = F.vcu; P < NCTX / 2; P += F.G) {
        const int rc = 2 * P, b = rc >> 8, t0 = rc & (CTXL - 1); const bf16* Us = U + (size_t)(LAT + b * CTXL) * UW;
        if (F.wave == 0) { const int tl = F.lane >> 5, j = F.lane & 31, t = t0 + tl; float z[8];
            prep_item(F, Us, t, CTXL, LAT + rc + tl, j, sw, sb, z);
            float* zc = F.p<float>(WS_ZCT) + ((size_t)b * 256 + 8 * j) * CTXL + t;
#pragma unroll
            for (int q = 0; q < 8; ++q) zc[(size_t)q * CTXL] = z[q]; }
        else if (F.wave <= 2) { const int tl = F.wave - 1; prep_row(F, LAT + rc + tl, t0 + tl, b, false); }
        else if (F.wave == 3) { const int tl = F.lane >> 5, j = F.lane & 31; pool_item_g(F, j >> 3, Us, t0 + tl, CTXL, LAT + rc + tl, j & 7); }
    }
}
__device__ __forceinline__ void hyena_finalize(const Ctx& F, int l) {
    LAS float* ys = (LAS float*)F.lds;
    const bf16* U = F.p<bf16>(WS_U);
    const float* sw = F.in(I_HSW) + (size_t)l * 3 * 768; const float* sb = F.in(I_HSB) + (size_t)l * 768;
    for (int T = F.vcu; T < MT / 64; T += F.G) {
        const TileInfo ti = tile_info(T); const bf16* Us = U + (size_t)(ti.r0 - ti.t0) * UW;
        { const float* zt = ti.lat ? F.p<float>(WS_YT) + (size_t)ti.b * 256 * SEQ + ti.t0 : F.p<float>(WS_ZCT) + (size_t)ti.b * 256 * CTXL + ti.t0; const int pitch = ti.lat ? SEQ : CTXL;
#pragma unroll 8
          for (int cc = 0; cc < 32; ++cc) { const int c = F.wave * 32 + cc; ys[F.lane * 257 + c] = zt[(size_t)c * pitch + F.lane]; } }
        __syncthreads();
#pragma unroll
        for (int i = 0; i < 4; ++i) { const int item = F.tid + 512 * i, tl = item >> 5, j = item & 31, t = ti.t0 + tl;
            float x0[8]; sconv8(Us, t, ti.L, C_HY + 8 * j, sw, sb, x0);
#pragma unroll
            for (int q = 0; q < 8; ++q) x0[q] *= ys[tl * 257 + 8 * j + q];
            *(GAS v4u*)(F.p<bf16>(WS_MIX) + (size_t)(ti.r0 + tl) * D + 8 * j) = pack8f(x0); }
        __syncthreads();
    }
}

typedef float c32 __attribute__((ext_vector_type(2)));
__device__ __forceinline__ c32 cmul(c32 a, c32 b) { return (c32){a.x * b.x - a.y * b.y, a.x * b.y + a.y * b.x}; }
__device__ __forceinline__ c32 cis_turns(float x) { return (c32){cos_turns(x), sin_turns(x)}; }
constexpr int FN = SEQ;
template <int Q, bool INV> __device__ __forceinline__ void fft_stage(LAS c32* X, int tid) {
    asm volatile("" : "+v"(tid));
    constexpr float invLs = (INV ? 1.0f : -1.0f) / (float)(4 * Q);
#pragma unroll 4
    for (int it = 0; it < 8; ++it) { const int i = tid + 512 * it, j = i & (Q - 1), base = ((i - j) << 2) + j;
        c32 w1, w2, w3;
        if (Q > 1) { w1 = cis_turns((float)j * invLs); w2 = cmul(w1, w1); w3 = cmul(w2, w1); }
        if (!INV) {
            const c32 a0 = X[base], a1 = X[base + Q], a2 = X[base + 2 * Q], a3 = X[base + 3 * Q];
            const c32 t0 = a0 + a2, t1 = a0 - a2, t2 = a1 + a3, t3 = a1 - a3;
            const c32 b0 = t0 + t2, b2 = t0 - t2, b1 = (c32){t1.x + t3.y, t1.y - t3.x}, b3 = (c32){t1.x - t3.y, t1.y + t3.x};
            X[base] = b0;
            if (Q > 1) { X[base + Q] = cmul(b1, w1); X[base + 2 * Q] = cmul(b2, w2); X[base + 3 * Q] = cmul(b3, w3); } else { X[base + Q] = b1; X[base + 2 * Q] = b2; X[base + 3 * Q] = b3; }
        } else {
            c32 a0 = X[base], a1 = X[base + Q], a2 = X[base + 2 * Q], a3 = X[base + 3 * Q];
            if (Q > 1) { a1 = cmul(a1, w1); a2 = cmul(a2, w2); a3 = cmul(a3, w3); }
            const c32 t0 = a0 + a2, t1 = a0 - a2, t2 = a1 + a3, t3 = a1 - a3;
            X[base] = t0 + t2; X[base + 2 * Q] = t0 - t2; X[base + Q] = (c32){t1.x - t3.y, t1.y + t3.x}; X[base + 3 * Q] = (c32){t1.x + t3.y, t1.y - t3.x};
        } }
    __syncthreads();
}
__device__ __forceinline__ void fft_fwd(LAS c32* X, int tid) {
    fft_stage<4096, false>(X, tid); fft_stage<1024, false>(X, tid); fft_stage<256, false>(X, tid); fft_stage<64, false>(X, tid); fft_stage<16, false>(X, tid); fft_stage<4, false>(X, tid); fft_stage<1, false>(X, tid);
}
__device__ __forceinline__ void fft_inv(LAS c32* X, int tid) {
    fft_stage<1, true>(X, tid); fft_stage<4, true>(X, tid); fft_stage<16, true>(X, tid); fft_stage<64, true>(X, tid); fft_stage<256, true>(X, tid); fft_stage<1024, true>(X, tid); fft_stage<4096, true>(X, tid);
}
__device__ __forceinline__ void hyena_fft_channel(const Ctx& F, int l, int c) {
    LAS c32* X = (LAS c32*)F.lds; const int tid = F.tid;
    const float* hf = F.p<float>(WS_HF) + (size_t)c * SEQ + tid; const float* hb = F.p<float>(WS_HF) + (size_t)(256 + c) * SEQ + SEQ - tid;
    const float* z0 = F.p<float>(WS_ZT) + (size_t)c * SEQ + tid; const float* z1 = z0 + (size_t)256 * SEQ;
    float* y0 = F.p<float>(WS_YT) + (size_t)c * SEQ + tid; float* y1 = y0 + (size_t)256 * SEQ;
    float nrm = 0.f; { const float* fp = F.p<float>(WS_FPART);
#pragma unroll
        for (int k = 0; k < 4; ++k) { const int tile = F.lane + 64 * k; nrm += fp[(size_t)tile * 512 + c] + fp[(size_t)tile * 512 + 256 + c]; }
        nrm = wave_sum(nrm); }
    const float scale = 1.0f / (nrm * 2.0f * (float)FN); const float bias = F.in(I_HBIAS)[l * 256 + c];
    c32 G[32];
#pragma unroll 1
    for (int pass = 0; pass < 2; ++pass) {
        const float sgn = pass == 0 ? 1.0f : -1.0f; const float tw = pass == 0 ? 0.0f : -1.0f / 32768.0f;
#pragma unroll 1
        for (int kb = 0; kb < 32; kb += 8) { float fa[8], fb[8];
#pragma unroll
            for (int q = 0; q < 8; ++q) { fa[q] = hf[512 * (kb + q)]; fb[q] = hb[-512 * (kb + q)]; }
#pragma unroll
            for (int q = 0; q < 8; ++q) { const int n = tid + 512 * (kb + q); const float g = fa[q] + sgn * (n > 0 ? fb[q] : 0.f); X[n] = cis_turns((float)n * tw) * g; } }
        __syncthreads(); fft_fwd(X, tid);
#pragma unroll
        for (int k = 0; k < 32; ++k) G[k] = X[tid + 512 * k];
        __syncthreads();
#pragma unroll 1
        for (int kb = 0; kb < 32; kb += 8) { float ua[8], ub[8];
#pragma unroll
            for (int q = 0; q < 8; ++q) { ua[q] = z0[512 * (kb + q)]; ub[q] = z1[512 * (kb + q)]; }
#pragma unroll
            for (int q = 0; q < 8; ++q) { const int n = tid + 512 * (kb + q); const c32 u = {ua[q], ub[q]}; X[n] = cmul(u, cis_turns((float)n * tw)); } }
        __syncthreads(); fft_fwd(X, tid);
#pragma unroll
        for (int k = 0; k < 32; ++k) { const int n = tid + 512 * k; X[n] = cmul(X[n], G[k]); if ((k & 7) == 7) asm volatile("" ::: "memory"); }
        __syncthreads(); fft_inv(X, tid);
        if (pass == 0) {
#pragma unroll 1
            for (int kb = 0; kb < 32; kb += 8) { float ua[8], ub[8];
#pragma unroll
                for (int q = 0; q < 8; ++q) { ua[q] = z0[512 * (kb + q)]; ub[q] = z1[512 * (kb + q)]; }
#pragma unroll
                for (int q = 0; q < 8; ++q) { const c32 y = X[tid + 512 * (kb + q)] * scale; y0[512 * (kb + q)] = y.x + bias * ua[q]; y1[512 * (kb + q)] = y.y + bias * ub[q]; } }
        } else {
#pragma unroll 1
            for (int kb = 0; kb < 32; kb += 8) { float ya[8], yb[8];
#pragma unroll
                for (int q = 0; q < 8; ++q) { ya[q] = y0[512 * (kb + q)]; yb[q] = y1[512 * (kb + q)]; }
#pragma unroll
                for (int q = 0; q < 8; ++q) { const int n = tid + 512 * (kb + q); const c32 y = cmul(X[n], cis_turns((float)n * (1.0f / 32768.0f))) * scale; y0[512 * (kb + q)] = ya[q] + y.x; y1[512 * (kb + q)] = yb[q] + y.y; } }
        }
        __syncthreads();
    }
}
__device__ __forceinline__ void hyena_ctx_item(const Ctx& F, int l, int item) {
    LAS float* zs = (LAS float*)F.lds;
    LAS float* fs = zs + 256 * 32;
    LAS float* nr = fs + 511 * 32;
    const int b = item >> 3, c0 = (item & 7) * 32; float* zc = F.p<float>(WS_ZCT) + ((size_t)b * 256 + c0) * CTXL;
#pragma unroll 8
    for (int i = F.tid; i < 32 * 256; i += 512) { const int c = i >> 8, s = i & 255; zs[s * 32 + c] = zc[(size_t)c * CTXL + s]; }
#pragma unroll 8
    for (int i = F.tid; i < 32 * 511; i += 512) { const int c = i / 511, lg = i % 511 - 255;
        fs[(lg + 255) * 32 + c] = lg >= 0 ? F.p<float>(WS_HFC)[(size_t)(c0 + c) * CTXL + lg] : F.p<float>(WS_HFC)[(size_t)(256 + c0 + c) * CTXL - lg]; }
    if (F.tid < 32) { float s = 0.f; for (int tl = 256; tl < 260; ++tl) s += F.p<float>(WS_FPART)[(size_t)tl * 512 + c0 + F.tid] + F.p<float>(WS_FPART)[(size_t)tl * 512 + 256 + c0 + F.tid]; nr[F.tid] = 1.0f / s; }
    __syncthreads();
    const int c = F.tid & 31, tg = F.tid >> 5; const float bias = F.in(I_HBIAS)[l * 256 + c0 + c];
    float acc[16];
#pragma unroll
    for (int i = 0; i < 16; ++i) acc[i] = 0.f;
#pragma unroll 1
    for (int sb = 0; sb < 16; ++sb) { float w[31];
        const int lag0 = 16 * tg - (16 * sb + 15);
#pragma unroll
        for (int k = 0; k < 31; ++k) w[k] = fs[(lag0 + k + 255) * 32 + c];
#pragma unroll
        for (int ss = 0; ss < 16; ++ss) { const float zv = zs[(16 * sb + ss) * 32 + c];
#pragma unroll
            for (int i = 0; i < 16; ++i) acc[i] += zv * w[i - ss + 15]; } }
    const float inv = nr[c];
    float outv[16];
#pragma unroll
    for (int i = 0; i < 16; ++i) outv[i] = acc[i] * inv + bias * zs[(16 * tg + i) * 32 + c];
    __syncthreads();
#pragma unroll
    for (int i = 0; i < 16; ++i) zc[(size_t)c * CTXL + 16 * tg + i] = outv[i];
    __syncthreads();
}
#ifndef MK_PER_PHASE
#define MK_PER_PHASE 0
#endif
#ifndef MK_EN
#define MK_EN 0xFFFFFFFFu
#endif
#define EN(k) (((MK_EN) >> (k)) & 1u)
#ifndef MK_DUP
#define MK_DUP 0u
#endif
#define REP(k) _Pragma("unroll 1") for (int rep_ = 0; rep_ < ((((MK_DUP) >> (k)) & 1u) ? 2 : 1); ++rep_)
#ifdef ATT_USE_PP
#define ATT_MAIN(q, k, o, s, l, t) att::attn_unit_pp(q, k, o, s, (att::lds_u8*)l, t)
#define ATT_PROBE(q, k, o, s, l, t) att::attn_unit_pp<PROBE_ATT>(q, k, o, s, (att::lds_u8*)l, t)
#else
#define ATT_MAIN(q, k, o, s, l, t) att::attn_unit<true>(q, k, o, s, (char*)l, t)
#define ATT_PROBE(q, k, o, s, l, t) att::attn_unit<true, PROBE_ATT>(q, k, o, s, (char*)l, t)
#endif
constexpr int N_PHASES = 1 + 2 * 9 + 2 * 12 + 1;

__global__ void __launch_bounds__(512, 2) mk_fwd(Args args) {
    extern __shared__ __attribute__((aligned(16))) unsigned char lds[];
    Ctx F0;
    F0.out = args.out; F0.ws = args.ws; F0.lds = (LAS unsigned char*)lds; F0.MISC = (volatile LAS unsigned*)(F0.lds + MISC_OFF);
    F0.tid = threadIdx.x; F0.lane = F0.tid & 63; F0.wave = __builtin_amdgcn_readfirstlane(F0.tid >> 6);
    F0.G = gridDim.x; { const int bx = blockIdx.x; F0.vcu = (F0.G % 8 == 0) ? (bx % 8) * (F0.G / 8) + bx / 8 : bx; }
#define PHASE_CTX() Ctx F = F0; { unsigned m_ = ~0u; int w_ = F0.wave, v_ = F0.vcu; unsigned wl_ = (unsigned)(uintptr_t)F0.ws, wh_ = (unsigned)((uintptr_t)F0.ws >> 32), ol_ = (unsigned)(uintptr_t)F0.out, oh_ = (unsigned)((uintptr_t)F0.out >> 32); \
        asm volatile("" : "+s"(m_), "+s"(w_), "+s"(v_), "+s"(wl_), "+s"(wh_), "+s"(ol_), "+s"(oh_)); \
        F.lane = (int)__builtin_amdgcn_mbcnt_hi(m_, __builtin_amdgcn_mbcnt_lo(m_, 0u)); F.wave = w_; F.tid = w_ * 64 + F.lane; F.vcu = v_;     \
        F.ws = (unsigned char*)(GAS unsigned char*)(((uintptr_t)wh_ << 32) | wl_); F.out = (float*)(GAS float*)(((uintptr_t)oh_ << 32) | ol_); }
    { Ctx& F = F0;
    for (int u = F.tid; u < (LDS_BYTES - RING_BYTES) / 4; u += 512) ((LAS unsigned*)(F.lds + RING_BYTES))[u] = 0u;
    __syncthreads(); }
    gu32* ctl = (gu32*)(args.ws + WS_CTL);
    XcdBarrier bar = xcd_barrier_post((unsigned*)(ctl + CW_BAR), F0.MISC + 8);
    const int lo = args.ph_lo, hi = args.ph_hi; int pid = 0;
#define RUN() (lo <= pid && pid < hi)
#define SEAM() do { if (pid + 1 < hi) { unsigned ms_ = ~0u; asm volatile("" : "+s"(ms_)); xcd_barrier(bar, F.wave == 0 && __builtin_amdgcn_mbcnt_hi(ms_, __builtin_amdgcn_mbcnt_lo(ms_, 0u)) == 0u); } } while (0)
    LAS unsigned char* ring = F0.lds;
    LAS int* tsl = (LAS int*)(F0.lds + MISC_OFF + 64);
    const int bid = (int)blockIdx.x;

    if (RUN()) { PHASE_CTX(); if (EN(0)) REP(0) p0_prologue(F); SEAM(); } ++pid;

#pragma unroll 1
    for (int l = 0; l < DEPTH; ++l) {
        const bool moe = (l & 1) != 0; const int mi = l >> 1;
        if (RUN()) { PHASE_CTX();
            if (EN(1)) REP(1) for (int tile = F.vcu; tile < 256; tile += F.G) filter_tile(F, l, tile);
            if (EN(19)) REP(19) { if (l == 0) norm_phase<0, false, false, true>(F, 0, 0, 0); else if ((l - 1) & 1) norm_phase<0, true, false>(F, l, l - 1, 0); else norm_phase<0, false, false, false, 2>(F, l, 0, 0); }
            SEAM(); } ++pid;
        if (RUN()) { PHASE_CTX(); if (EN(2)) REP(2) {
            pg8::Gemm g{F.p<bf16>(WS_HN), F.p<bf16>(WS_WIN) + (size_t)l * UW * D, MT, UW, D, D, D}; pg8::StaticOrder S; S.init(MT, UW, F.G, bid);
            pg8::EpiBf16<0> E{F.p<bf16>(WS_U), UW, nullptr, 0, 0, 1.f};
            pg8::gemm_phase<pg8::EpiBf16<0>, pg8::StaticOrder, true, true>(ring, g, S, E, F.tid); }
            if (EN(1)) for (int tile = 256 + (F.G - 1 - bid); tile < NFT; tile += F.G) filter_tile(F, l, tile);
            SEAM(); } ++pid;
        if (RUN()) { PHASE_CTX(); if (EN(3)) REP(3) prep_phase(F, l); SEAM(); } ++pid;
        if (RUN()) { PHASE_CTX();
            if (EN(4)) REP(4) for (int c = F.vcu; c < 256; c += F.G) hyena_fft_channel(F, l, c);
            if (EN(5)) REP(5) for (int it = bid - 8; it >= 0 && it < 2 * 8; it += F.G) hyena_ctx_item(F, l, it);
            if (EN(6)) REP(6) { pg8::Gemm g{F.p<bf16>(WS_U) + C_CQ, F.p<bf16>(WS_WUQ) + (size_t)l * 768 * 384, MT, 768, 384, UW, 384}; pg8::StaticOrder S; S.init(MT, 768, F.G, (bid + F.G / 2) % F.G);
              pg8::EpiQRope E{F.p<bf16>(WS_Q), F.p<float>(WS_RSQ), F.p<float>(WS_ROPEC), F.p<float>(WS_ROPES)};
              pg8::gemm_phase<pg8::EpiQRope, pg8::StaticOrder, true, true>(ring, g, S, E, F.tid); }
            if (EN(7)) REP(7) { pg8::Gemm g{F.p<bf16>(WS_U) + C_CKV, F.p<bf16>(WS_WUKV) + (size_t)l * 1024 * 256, MT, 1024, 256, UW, 256}; pg8::StaticOrder S; S.init(MT, 1024, F.G, bid);
              pg8::EpiKV E{F.p<bf16>(WS_KV), F.p<float>(WS_RSKV)};
              pg8::gemm_phase<pg8::EpiKV, pg8::StaticOrder, true, true>(ring, g, S, E, F.tid); }
            if (EN(8)) REP(8) { pg8::Gemm g{F.p<bf16>(WS_DP), F.p<bf16>(WS_WPOOL) + (size_t)l * 256 * 256, MT, 256, 256, 256, 256}; pg8::StaticOrder S; S.init(MT, 256, F.G, F.G - 1 - bid);
              pg8::EpiColScale E{F.p<bf16>(WS_MIX) + 256, D, F.in(I_POOLS) + l * 256};
              pg8::gemm_phase<pg8::EpiColScale, pg8::StaticOrder, true, true>(ring, g, S, E, F.tid); }
            SEAM(); } ++pid;
        if (RUN()) { PHASE_CTX();
            if (EN(9)) REP(9) hyena_finalize(F, l);
#if ATT_W64
            if (EN(10)) REP(10) for (int u = F.vcu, uidx = 0; u < 512 + 16; u += F.G, ++uidx) {
                int b, h, row0, seq, nh;
                if (u < 512) { const int pair = u >> 5, qb = u & 31; b = pair >> 3; h = pair & 7; row0 = b * SEQ + qb * 512; seq = NKEY; nh = 2; }
                else { const int pair = u - 512; b = pair >> 3; h = pair & 7; row0 = LAT + b * CTXL; seq = CTXL; nh = 1; }
                const bf16* qp = F.p<bf16>(WS_Q) + (size_t)row0 * 768 + h * DQK; const bf16* kvp = F.p<bf16>(WS_KV) + (size_t)(b * NHEAD + h) * KV_HEAD_STRIDE; bf16* op = F.p<bf16>(WS_MIX) + (size_t)row0 * D + 512 + h * DV;
                unsigned mk_ = ~0u; asm volatile("" : "+s"(mk_)); const int tf = F.wave * 64 + (int)__builtin_amdgcn_mbcnt_hi(mk_, __builtin_amdgcn_mbcnt_lo(mk_, 0u));
                if (!(u < 512 && att::attn_unit_w64(qp, kvp, op, seq, (att::lds_u8*)lds, tf))) {
#pragma unroll 1
                    for (int hf = 0; hf < nh; ++hf) { unsigned mk2_ = ~0u; asm volatile("" : "+s"(mk2_)); const int ts = F.wave * 64 + (int)__builtin_amdgcn_mbcnt_hi(mk2_, __builtin_amdgcn_mbcnt_lo(mk2_, 0u));
                        att::attn_unit<false>(qp + (size_t)hf * 256 * 768, kvp, op + (size_t)hf * 256 * D, seq, (char*)lds, ts); } }
                if (l == 0 && uidx == ((F.vcu >> 5) & 1)) { unsigned mk3_ = ~0u; asm volatile("" : "+s"(mk3_)); const int ln3 = (int)__builtin_amdgcn_mbcnt_hi(mk3_, __builtin_amdgcn_mbcnt_lo(mk3_, 0u)); int gw3 = F.vcu * 8 + F.wave; asm volatile("" : "+s"(gw3)); convert_cats<3, 10>(F, gw3, F.G * 8, ln3); __syncthreads(); }
            }
#else
            if (EN(10)) REP(10) for (int u = F.vcu, uidx = 0; u < 1024 + 16; u += F.G, ++uidx) {
                int b, h, row0, seq;
                if (u < 1024) { const int pair = u >> 6, qb = u & 63; b = pair >> 3; h = pair & 7; row0 = b * SEQ + qb * 256; seq = NKEY; }
                else { const int pair = u - 1024; b = pair >> 3; h = pair & 7; row0 = LAT + b * CTXL; seq = CTXL; }
                const bf16* qp = F.p<bf16>(WS_Q) + (size_t)row0 * 768 + h * DQK; const bf16* kvp = F.p<bf16>(WS_KV) + (size_t)(b * NHEAD + h) * KV_HEAD_STRIDE; bf16* op = F.p<bf16>(WS_MIX) + (size_t)row0 * D + 512 + h * DV;
                unsigned mk_ = ~0u; asm volatile("" : "+s"(mk_)); const int tf = F.wave * 64 + (int)__builtin_amdgcn_mbcnt_hi(mk_, __builtin_amdgcn_mbcnt_lo(mk_, 0u));
                if (!ATT_MAIN(qp, kvp, op, seq, lds, tf)) { unsigned mk2_ = ~0u; asm volatile("" : "+s"(mk2_)); const int ts = F.wave * 64 + (int)__builtin_amdgcn_mbcnt_hi(mk2_, __builtin_amdgcn_mbcnt_lo(mk2_, 0u)); att::attn_unit<false>(qp, kvp, op, seq, (char*)lds, ts); }
                if (l == 0 && uidx == ((F.vcu >> 6) & 3)) { unsigned mk3_ = ~0u; asm volatile("" : "+s"(mk3_)); const int ln3 = (int)__builtin_amdgcn_mbcnt_hi(mk3_, __builtin_amdgcn_mbcnt_lo(mk3_, 0u)); int gw3 = F.vcu * 8 + F.wave; asm volatile("" : "+s"(gw3)); convert_cats<3, 10>(F, gw3, F.G * 8, ln3); __syncthreads(); }
            }
#endif
#ifdef PROBE_ATT
            for (int u = F.vcu; u < 1024; u += F.G) { const int pair = u >> 6, qb = u & 63; const int b = pair >> 3, h = pair & 7, row0 = b * SEQ + qb * 256;
                const bf16* qp = F.p<bf16>(WS_Q) + (size_t)row0 * 768 + h * DQK; const bf16* kvp = F.p<bf16>(WS_KV) + (size_t)(b * NHEAD + h) * KV_HEAD_STRIDE; bf16* op = (bf16*)F.p<float>(WS_ZT) + (size_t)(row0 & 8191) * D + h * DV;
                unsigned mk_ = ~0u; asm volatile("" : "+s"(mk_)); const int tf = F.wave * 64 + (int)__builtin_amdgcn_mbcnt_hi(mk_, __builtin_amdgcn_mbcnt_lo(mk_, 0u));
                ATT_PROBE(qp, kvp, op, NKEY, lds, tf); }
#endif
            SEAM(); } ++pid;
        if (RUN()) { PHASE_CTX(); if (EN(11)) REP(11) {
            pg8::Gemm g{F.p<bf16>(WS_MIX), F.p<bf16>(WS_WOUT) + (size_t)l * D * D, LAT, D, D, D, D}; pg8::StaticOrder S; S.init(LAT, D, F.G, bid);
            pg8::EpiResGate E{l == 0 ? F.in(I_X) : nullptr, (unsigned short*)F.out, F.p<float>(WS_MODS) + (size_t)l * 3 * 6 * D + 2 * D};
            pg8::gemm_phase<pg8::EpiResGate, pg8::StaticOrder, true, true>(ring, g, S, E, F.tid);
            { pg8::Gemm gc{F.p<bf16>(WS_MIX), F.p<bf16>(WS_WOUT) + (size_t)l * D * D, NCTX, D, D / 4, D, D}; pg8::CtxSplitOrder<4> Sc{F.G, bid, D / 4};
              pg8::EpiCtxSlab Ec{F.p<float>(WS_SLAB), F.p<float>(WS_MODS) + (size_t)l * 3 * 6 * D + 2 * D, D / 4};
              pg8::gemm_phase<pg8::EpiCtxSlab, pg8::CtxSplitOrder<4>, true, true>(ring, gc, Sc, Ec, F.tid); } }
            SEAM(); } ++pid;
        if (RUN()) { PHASE_CTX(); if (EN(12)) REP(12) { if (moe) norm_phase<1, false, true, false, 4>(F, l, 0, mi); else norm_phase<1, false, false, false, 4>(F, l, 0, 0); }   SEAM(); } ++pid;
        if (!moe) {
            if (RUN()) { PHASE_CTX(); if (EN(13)) REP(13) {
                pg8::Gemm g{F.p<bf16>(WS_HN), F.p<bf16>(WS_WGU) + (size_t)mi * 2 * FF * D, MT, 2 * FF, D, D, D}; pg8::StaticOrder S; S.init(MT, 2 * FF, F.G, bid);
                pg8::EpiSwiGLU E{F.p<bf16>(WS_H)};
                pg8::gemm_phase<pg8::EpiSwiGLU, pg8::StaticOrder, true, true>(ring, g, S, E, F.tid); }
                SEAM(); } ++pid;
            if (RUN()) { PHASE_CTX(); if (EN(14)) REP(14) {
                pg8::Gemm g{F.p<bf16>(WS_H), F.p<bf16>(WS_WD) + (size_t)mi * D * FF, LAT, D, FF, FF, FF}; pg8::StaticOrder S; S.init(LAT, D, F.G, bid);
                pg8::EpiResGate E{nullptr, (unsigned short*)F.out, F.p<float>(WS_MODS) + (size_t)l * 3 * 6 * D + 5 * D};
                pg8::gemm_phase<pg8::EpiResGate, pg8::StaticOrder, true, true>(ring, g, S, E, F.tid);
                { pg8::Gemm gc{F.p<bf16>(WS_H), F.p<bf16>(WS_WD) + (size_t)mi * D * FF, NCTX, D, FF / 2, FF, FF}; pg8::CtxSplitOrder<2> Sc{F.G, bid, FF / 2};
                  pg8::EpiCtxSlab Ec{F.p<float>(WS_SLAB), F.p<float>(WS_MODS) + (size_t)l * 3 * 6 * D + 5 * D, FF / 2};
                  pg8::gemm_phase<pg8::EpiCtxSlab, pg8::CtxSplitOrder<2>, true, true>(ring, gc, Sc, Ec, F.tid); } }
                SEAM(); } ++pid;
        } else {
            if (RUN()) { PHASE_CTX(); if (EN(15)) REP(15) moe_scatter(F, mi); SEAM(); } ++pid;
#pragma unroll 1
            for (int ch = 0; ch < 2; ++ch) {
                int ts[9]; { PHASE_CTX(); moe_tile_starts(F, mi, ts); }
                const int Tn = ts[8] < XS_TILES ? ts[8] : XS_TILES, Th = Tn < MOE_CHUNK0 ? Tn : MOE_CHUNK0; const int t0 = ch == 0 ? 0 : Th, nt = ch == 0 ? Th : Tn - Th;
                bf16* hs = F0.p<bf16>(WS_HS) - (size_t)t0 * 256 * FF;
                if (RUN()) { PHASE_CTX(); if (EN(16)) REP(16) {
                    if (F.tid == 0) {
#pragma unroll
                        for (int e = 0; e < 9; ++e) tsl[e] = ts[e]; }
                    __syncthreads();
                    pg8::Gemm g{F.p<bf16>(WS_XS), F.p<bf16>(WS_MGU) + (size_t)mi * NEXP * 2 * FF * D, 0, 0, D, D, D}; pg8::MoeOrder<NJ_GU> S{t0, nt, F.G, bid, tsl};
                    pg8::EpiSwiGLU E{hs};
                    pg8::gemm_phase<pg8::EpiSwiGLU, pg8::MoeOrder<NJ_GU>, true, true>(ring, g, S, E, F.tid); }
                    SEAM(); } ++pid;
                if (RUN()) { PHASE_CTX(); if (EN(17)) REP(17) {
                    if (F.tid == 0) {
#pragma unroll
                        for (int e = 0; e < 9; ++e) tsl[e] = ts[e]; }
                    __syncthreads();
                    pg8::Gemm g{hs, F.p<bf16>(WS_MD) + (size_t)mi * NEXP * D * FF, 0, 0, FF, FF, FF}; pg8::MoeOrder<4> S{t0, nt, F.G, bid, tsl};
                    pg8::EpiBf16<0> E{F.p<bf16>(WS_XS), D, nullptr, D, 0, 1.f};
                    pg8::gemm_phase<pg8::EpiBf16<0>, pg8::MoeOrder<4>, true, true>(ring, g, S, E, F.tid); }
                    SEAM(); } ++pid;
            }
        }
    }
#ifdef PROBE_BARS
    if (RUN()) { PHASE_CTX(); for (int q_ = 0; q_ < 40; ++q_) { unsigned ms_ = ~0u; asm volatile("" : "+s"(ms_)); xcd_barrier(bar, F.wave == 0 && __builtin_amdgcn_mbcnt_hi(ms_, __builtin_amdgcn_mbcnt_lo(ms_, 0u)) == 0u); } }
#endif
    if (RUN()) { PHASE_CTX(); if (EN(18)) REP(18) norm_phase<2, true, false>(F, 0, DEPTH - 1, 0); } ++pid;
#undef RUN
#undef SEAM
}

extern "C" void kernel_launch(void* const* d_in, const int* in_sizes, int n_in, void* d_out, int out_size, void* d_ws, size_t ws_size, hipStream_t stream) {
    static int grid = 0;
    if (grid == 0) {
        if (n_in != 34 || in_sizes[0] != LAT * D || out_size != LAT * D || ws_size < WS_END) {
            fprintf(stderr, "kernel_launch: shape mismatch: n_in %d in0 %d out %d ws %zu (need %zu); nothing launched\n", n_in, n_in > 0 ? in_sizes[0] : -1, out_size, ws_size, (size_t)WS_END); grid = -1; return; }
        if (hipFuncSetAttribute((const void*)mk_fwd, hipFuncAttributeMaxDynamicSharedMemorySize, LDS_BYTES) != hipSuccess) { fprintf(stderr, "kernel_launch: hipFuncSetAttribute failed\n"); grid = -1; return; }
        int dev = 0, cus = 0; (void)hipGetDevice(&dev); (void)hipDeviceGetAttribute(&cus, hipDeviceAttributeMultiprocessorCount, dev);
        int per_cu = 0; (void)hipOccupancyMaxActiveBlocksPerMultiprocessor(&per_cu, (const void*)mk_fwd, 512, LDS_BYTES); (void)hipGetLastError();
        grid = (cus >= 256 && per_cu >= 1) ? 256 : (cus > 8 ? (cus / 8) * 8 : 8);
    }
    if (grid < 0) return;
    (void)hipMemsetAsync((char*)d_ws + WS_CTL, 0, CTL_BYTES, stream);
    Args a{};
    for (int i = 0; i < 34; ++i) a.in[i] = (const float*)d_in[i];
    a.out = (float*)d_out; a.ws = (unsigned char*)d_ws;
#if MK_PER_PHASE
    for (int p = 0; p < N_PHASES; ++p) { a.ph_lo = p; a.ph_hi = p + 1; hipLaunchKernelGGL(mk_fwd, dim3(grid), dim3(512), LDS_BYTES, stream, a); }
#else
    a.ph_lo = 0; a.ph_hi = N_PHASES; hipLaunchKernelGGL(mk_fwd, dim3(grid), dim3(512), LDS_BYTES, stream, a);
#endif
    const hipError_t le = hipPeekAtLastError();
    if (le != hipSuccess) fprintf(stderr, "kernel_launch: launch failed: %s\n", hipGetErrorName(le));
}
```

```cpp
#include <hip/hip_runtime.h>
#include <cstdio>
#include <cstdint>
namespace pg8 {
#define PG8_LAS __attribute__((address_space(3)))
typedef unsigned short bf16_t;
typedef short bf16x8 __attribute__((ext_vector_type(8)));
typedef float f32x4 __attribute__((ext_vector_type(4)));
typedef unsigned u32x4 __attribute__((ext_vector_type(4)));
constexpr int BM = 256, BK = 64, HALF = 128, HTB = HALF * BK * 2  , STAGE_BYTES = 8 * HTB, NXCD = 8, WGM = 8;

__host__ __device__ __forceinline__ int lds_byte(int r, int c) { const int st = (r >> 4) * 2 + (c >> 5), rr = r & 15, cc = c & 31, ob = rr * 64 + cc * 2; return st * 1024 + (ob ^ (((ob >> 9) & 1) << 5)); }
__host__ __device__ __forceinline__ void stage_rc(int b, int& R, int& C) { const int st = b / 1024, sb = b % 1024, swz = sb ^ (((sb >> 9) & 1) << 5); R = (st >> 1) * 16 + swz / 64; C = (st & 1) * 32 + (swz % 64) / 2; }
__host__ __device__ __forceinline__ int perm32(int rho) { const int n = rho >> 4, i = rho & 15; return 8 * (i >> 2) + 4 * n + (i & 3); }

struct Unit { int pm, pn, ko; };
struct Gemm { const bf16_t* A; const bf16_t* Bt; int M, N, K, lda, ldb; };

struct StaticOrder {
    int nM, nN, nwg, G, c;
    __host__ __device__ void init(int M, int N, int G_, int c_) { nM = M / BM; nN = N / BM; nwg = nM * nN; G = G_; c = c_; }
    __host__ __device__ bool next(int i, Unit& u) const {
        const long L = (long)i * G + c; if (L >= nwg) return false;
        int wgid = (int)L; { const int q = nwg / NXCD, r = nwg % NXCD, xcd = wgid % NXCD, off = wgid / NXCD; wgid = (xcd < r ? xcd * (q + 1) : r * (q + 1) + (xcd - r) * q) + off; }
        const int nig = WGM * nN, gid = wgid / nig, fm = gid * WGM, gsz = (nM - fm) < WGM ? (nM - fm) : WGM;
        u.pm = fm + ((wgid % nig) % gsz); u.pn = (wgid % nig) / gsz; u.ko = 0; return true;
    }
    __device__ __forceinline__ void a_ready(const Unit&) const {}
    __device__ __forceinline__ void done(const Unit&) const {}
};

__device__ __forceinline__ unsigned cvt_pk_bf16(float lo, float hi) { unsigned r; asm volatile("v_cvt_pk_bf16_f32 %0, %1, %2" : "=v"(r) : "v"(lo), "v"(hi)); return r; }
typedef float f32x2 __attribute__((ext_vector_type(2)));
__device__ __forceinline__ f32x2 gelu_pk(f32x2 v) {
    const f32x2 av = __builtin_elementwise_abs(v), d = av * 0.2316418882f + 1.0f;
    f32x2 t; t.x = __builtin_amdgcn_rcpf(d.x); t.y = __builtin_amdgcn_rcpf(d.y);
    f32x2 q = t * 0.5307027145f + (-0.7265760135f); q = q * t + 0.7107068705f; q = q * t + (-0.142248368f); q = q * t + 0.127414796f; q = q * t;
    const f32x2 s = (v * v) * (-0.72134752044f);
    f32x2 e; e.x = __builtin_amdgcn_exp2f(s.x); e.y = __builtin_amdgcn_exp2f(s.y);
    const f32x2 m = v * (q * e), r = v - m;
    f32x2 o; o.x = v.x < 0.f ? m.x : r.x; o.y = v.y < 0.f ? m.y : r.y; return o;
}

template <int ACT  > struct EpiBf16 {
    static constexpr bool PERM = true, AFTER_DRAIN = false; static_assert(ACT == 0 || ACT == 1, "EpiBf16: ACT is 0 (none) or 1 (gelu_pk)");
    bf16_t* O; int ldc; const float* bias; int split_cols; size_t split_stride; float scale0;
    __device__ __forceinline__ void operator()(const f32x4 (&acc)[2][2][4][2], const Unit& u, int wr, int wc, int fr, int fq) const {
        const int row0 = u.pm * BM + wr * 64 + fr; int colt = u.pn * BM; bf16_t* base = O;
        float sc = 1.f; if (split_cols) { const int t = colt / split_cols; base += (size_t)t * split_stride; colt -= t * split_cols; if (t == 0) sc = scale0; }
        const int col0 = colt + wc * 32 + 8 * fq, bcol0 = u.pn * BM + wc * 32 + 8 * fq;
        f32x4 bv[2][2];
#pragma unroll
        for (int bj = 0; bj < 2; ++bj)
#pragma unroll
            for (int n = 0; n < 2; ++n) bv[bj][n] = bias ? *(const f32x4*)(bias + bcol0 + bj * HALF + 4 * n) : (f32x4){0.f, 0.f, 0.f, 0.f};
#pragma unroll
        for (int ai = 0; ai < 2; ++ai)
#pragma unroll
            for (int m = 0; m < 4; ++m) { bf16_t* rowp = base + (size_t)(row0 + ai * HALF + m * 16) * ldc + col0;
#pragma unroll
                for (int bj = 0; bj < 2; ++bj) { f32x4 v0 = acc[ai][bj][m][0] + bv[bj][0], v1 = acc[ai][bj][m][1] + bv[bj][1];
                    if (ACT == 1) { f32x2 a = gelu_pk((f32x2){v0[0], v0[1]}), b = gelu_pk((f32x2){v0[2], v0[3]}), c = gelu_pk((f32x2){v1[0], v1[1]}), d = gelu_pk((f32x2){v1[2], v1[3]});
                        v0 = (f32x4){a.x, a.y, b.x, b.y}; v1 = (f32x4){c.x, c.y, d.x, d.y}; }
                    v0 = v0 * sc; v1 = v1 * sc; u32x4 w; w.x = cvt_pk_bf16(v0[0], v0[1]); w.y = cvt_pk_bf16(v0[2], v0[3]); w.z = cvt_pk_bf16(v1[0], v1[1]); w.w = cvt_pk_bf16(v1[2], v1[3]);
                    *(u32x4*)(rowp + bj * HALF) = w; } }
    }
};

struct PanelStats {
    unsigned* xbuf;
    unsigned* cnt;
    unsigned* tmo;
    int ntn; float eps;
    unsigned code;
    __device__ __forceinline__ bool run(const f32x4 (&v)[2][2][4][2], const Unit& u, int wr, int wc, int fr, int fq, PG8_LAS unsigned char* lds, int wid, int lane) const {
        typedef float f32x2v __attribute__((ext_vector_type(2)));
        PG8_LAS f32x2v* P = (PG8_LAS f32x2v*)lds;
        PG8_LAS f32x2v* S = (PG8_LAS f32x2v*)(lds + 8192);
        PG8_LAS unsigned* flag = (PG8_LAS unsigned*)(lds + 8192 + 2048);
#pragma unroll
        for (int ai = 0; ai < 2; ++ai)
#pragma unroll
            for (int m = 0; m < 4; ++m) {
                float s = 0.f;
#pragma unroll
                for (int bj = 0; bj < 2; ++bj)
#pragma unroll
                    for (int n = 0; n < 2; ++n) { const f32x4 x = v[ai][bj][m][n]; s += (x[0] + x[1]) + (x[2] + x[3]); }
                s += __shfl_xor(s, 16); s += __shfl_xor(s, 32);
                const float mw = s * (1.0f / 64.0f); float q = 0.f;
#pragma unroll
                for (int bj = 0; bj < 2; ++bj)
#pragma unroll
                    for (int n = 0; n < 2; ++n) { const f32x4 d = v[ai][bj][m][n] - mw; q += (d[0] * d[0] + d[1] * d[1]) + (d[2] * d[2] + d[3] * d[3]); }
                q += __shfl_xor(q, 16); q += __shfl_xor(q, 32);
                if (fq == 0) P[(ai * HALF + wr * 64 + m * 16 + fr) * 4 + wc] = (f32x2v){mw, q};
            }
        asm volatile("s_waitcnt lgkmcnt(0)" ::: "memory"); __builtin_amdgcn_s_barrier(); asm volatile("" ::: "memory");
#if defined(BROKEN_EXCHANGE_NO_WAIT)
#warning BROKEN CONTROL BUILD: the row-statistics exchange does not wait; results are wrong by design
        if (blockIdx.x >= 64) { const long long t0_ = clock64(); while (clock64() - t0_ < 60000) __builtin_amdgcn_s_sleep(8); }
#endif
        const int row = wid * 32 + (lane & 31);
        if (lane < 32) {
            const f32x2v a = P[row * 4 + 0], b = P[row * 4 + 1], c = P[row * 4 + 2], d = P[row * 4 + 3];
            const float mt = (a.x + b.x + c.x + d.x) * 0.25f;
            const float da = a.x - mt, db = b.x - mt, dc = c.x - mt, dd = d.x - mt;
            const float m2 = (a.y + b.y) + (c.y + d.y) + 64.0f * ((da * da + db * db) + (dc * dc + dd * dd));
            unsigned long long* slot = (unsigned long long*)xbuf + ((size_t)(u.pm * BM + row) * 4 + u.pn);
            __hip_atomic_store(slot, ((unsigned long long)__float_as_uint(m2) << 32) | __float_as_uint(mt), __ATOMIC_RELAXED, __HIP_MEMORY_SCOPE_AGENT);
        }
        asm volatile("s_waitcnt vmcnt(0)" ::: "memory");
        if (lane == 0) __hip_atomic_fetch_add(cnt + 64 * u.pm, 1u, __ATOMIC_RELAXED, __HIP_MEMORY_SCOPE_AGENT);
        if (wid == 0) {
            bool dead = false; const unsigned long long t0 = __builtin_amdgcn_s_memrealtime(); const unsigned want = 8u * (unsigned)ntn;
            for (;;) {
#if defined(BROKEN_EXCHANGE_NO_WAIT)
                break;
#endif
                if ((unsigned)__builtin_amdgcn_readfirstlane(__hip_atomic_load(cnt + 64 * u.pm, __ATOMIC_RELAXED, __HIP_MEMORY_SCOPE_AGENT)) >= want) break;
                if (__builtin_amdgcn_s_memrealtime() - t0 > 2000000ull) {
                    if (lane == 0) { unsigned expect = 0u; __hip_atomic_compare_exchange_strong(tmo + 1, &expect, code | (unsigned)(u.pm & 0xff), __ATOMIC_RELAXED, __ATOMIC_RELAXED, __HIP_MEMORY_SCOPE_AGENT);
                                     __hip_atomic_store(tmo, 1u, __ATOMIC_RELAXED, __HIP_MEMORY_SCOPE_AGENT); }
                    dead = true; break; }
                __builtin_amdgcn_s_sleep(2);
            }
            __builtin_amdgcn_fence(__ATOMIC_ACQUIRE, "agent");
            if (lane == 0) flag[0] = dead ? 1u : 0u;
        }
        asm volatile("s_waitcnt vmcnt(0) lgkmcnt(0)" ::: "memory"); __builtin_amdgcn_s_barrier(); asm volatile("" ::: "memory");
        const bool bad = flag[0] != 0u;
        if (lane < 32) {
            const unsigned long long* slot = (const unsigned long long*)xbuf + (size_t)(u.pm * BM + row) * 4; float mt[4], m2[4]; float ms = 0.f;
#pragma unroll
            for (int t = 0; t < 4; ++t) { if (t < ntn) { const unsigned long long w = __hip_atomic_load(slot + t, __ATOMIC_RELAXED, __HIP_MEMORY_SCOPE_AGENT); mt[t] = __uint_as_float((unsigned)w); m2[t] = __uint_as_float((unsigned)(w >> 32)); } else { mt[t] = 0.f; m2[t] = 0.f; } ms += mt[t]; }
            const float mean = ms / (float)ntn; float q = 0.f;
#pragma unroll
            for (int t = 0; t < 4; ++t) if (t < ntn) { const float dm = mt[t] - mean; q += m2[t] + 256.0f * dm * dm; }
            S[row] = (f32x2v){mean, 1.0f / sqrtf(q / (256.0f * (float)ntn) + eps)};
        }
        asm volatile("s_waitcnt lgkmcnt(0)" ::: "memory"); __builtin_amdgcn_s_barrier(); asm volatile("" ::: "memory");
        return bad;
    }
};
struct EpiLnRes {
    static constexpr bool PERM = false, AFTER_DRAIN = true;
    const float* base; float* out; int ldc; const float* bias; PanelStats st; unsigned poison;
    __device__ __forceinline__ void fused(f32x4 (&acc)[2][2][4][2], const Unit& u, int wr, int wc, int fr, int fq, PG8_LAS unsigned char* lds, int wid, int lane) const {
        typedef float f32x2v __attribute__((ext_vector_type(2)));
        const PG8_LAS f32x2v* S = (const PG8_LAS f32x2v*)(lds + 8192);
        const int col0 = u.pn * BM + wc * 32 + 4 * fq;
#pragma unroll
        for (int bj = 0; bj < 2; ++bj)
#pragma unroll
            for (int n = 0; n < 2; ++n) { const f32x4 bv = bias ? *(const f32x4*)(bias + col0 + bj * HALF + n * 16) : (f32x4){0.f, 0.f, 0.f, 0.f};
#pragma unroll
                for (int ai = 0; ai < 2; ++ai)
#pragma unroll
                    for (int m = 0; m < 4; ++m) acc[ai][bj][m][n] += bv; }
        f32x4 pre[4][2][2];
#pragma unroll
        for (int m = 0; m < 4; ++m) { const size_t off = (size_t)(u.pm * BM + wr * 64 + m * 16 + fr) * ldc + col0;
#pragma unroll
            for (int bj = 0; bj < 2; ++bj)
#pragma unroll
                for (int n = 0; n < 2; ++n) pre[m][bj][n] = *(const f32x4*)(base + off + bj * HALF + n * 16); }
        const bool bad = st.run(acc, u, wr, wc, fr, fq, lds, wid, lane) || poison != 0u;
        const float qnan = __builtin_nanf("");
#pragma unroll
        for (int ai = 0; ai < 2; ++ai)
#pragma unroll
            for (int m = 0; m < 4; ++m) { const int r = ai * HALF + wr * 64 + m * 16 + fr; const f32x2v sr = S[r]; const size_t off = (size_t)(u.pm * BM + r) * ldc + col0;
#pragma unroll
                for (int bj = 0; bj < 2; ++bj)
#pragma unroll
                    for (int n = 0; n < 2; ++n) { const f32x4 bs = ai == 0 ? pre[m][bj][n] : *(const f32x4*)(base + off + bj * HALF + n * 16); f32x4 o = bs + (acc[ai][bj][m][n] - sr.x) * sr.y;
                        if (bad) o = (f32x4){qnan, qnan, qnan, qnan}; *(f32x4*)(out + off + bj * HALF + n * 16) = o; }
                if (m & 1) asm volatile("" ::: "memory"); }
    }
};
struct EpiLnResLn {
    static constexpr bool PERM = false, AFTER_DRAIN = true;
    const float* base; float* out; bf16_t* xn; int ldc; const float* bias; PanelStats st1, st2; unsigned poison;
    __device__ __forceinline__ void fused(f32x4 (&acc)[2][2][4][2], const Unit& u, int wr, int wc, int fr, int fq, PG8_LAS unsigned char* lds, int wid, int lane) const {
        typedef float f32x2v __attribute__((ext_vector_type(2))); typedef unsigned u32x2v __attribute__((ext_vector_type(2)));
        const PG8_LAS f32x2v* S = (const PG8_LAS f32x2v*)(lds + 8192);
        const int col0 = u.pn * BM + wc * 32 + 4 * fq;
#pragma unroll
        for (int bj = 0; bj < 2; ++bj)
#pragma unroll
            for (int n = 0; n < 2; ++n) { const f32x4 bv = bias ? *(const f32x4*)(bias + col0 + bj * HALF + n * 16) : (f32x4){0.f, 0.f, 0.f, 0.f};
#pragma unroll
                for (int ai = 0; ai < 2; ++ai)
#pragma unroll
                    for (int m = 0; m < 4; ++m) acc[ai][bj][m][n] += bv; }
        bool bad = st1.run(acc, u, wr, wc, fr, fq, lds, wid, lane) || poison != 0u;
        const float qnan = __builtin_nanf("");
#pragma unroll
        for (int ai = 0; ai < 2; ++ai)
#pragma unroll
            for (int m = 0; m < 4; ++m) { const int r = ai * HALF + wr * 64 + m * 16 + fr; const f32x2v sr = S[r]; const size_t off = (size_t)(u.pm * BM + r) * ldc + col0;
#pragma unroll
                for (int bj = 0; bj < 2; ++bj)
#pragma unroll
                    for (int n = 0; n < 2; ++n) { const f32x4 bs = *(const f32x4*)(base + off + bj * HALF + n * 16); acc[ai][bj][m][n] = bs + (acc[ai][bj][m][n] - sr.x) * sr.y; }
                asm volatile("" : "+v"(acc[ai][0][m][0]), "+v"(acc[ai][0][m][1]), "+v"(acc[ai][1][m][0]), "+v"(acc[ai][1][m][1]));
                if (m & 1) asm volatile("" ::: "memory"); }
        const bool bad1 = bad;
        bad = st2.run(acc, u, wr, wc, fr, fq, lds, wid, lane) || bad;
#pragma unroll
        for (int ai = 0; ai < 2; ++ai)
#pragma unroll
            for (int m = 0; m < 4; ++m) { const int r = ai * HALF + wr * 64 + m * 16 + fr; const f32x2v sr = S[r]; const size_t off = (size_t)(u.pm * BM + r) * ldc + col0;
#pragma unroll
                for (int bj = 0; bj < 2; ++bj)
#pragma unroll
                    for (int n = 0; n < 2; ++n) { const f32x4 x1 = acc[ai][bj][m][n]; *(f32x4*)(out + off + bj * HALF + n * 16) = bad1 ? (f32x4){qnan, qnan, qnan, qnan} : x1;
                        const f32x4 o = (x1 - sr.x) * sr.y; u32x2v w; w.x = cvt_pk_bf16(o[0], o[1]); w.y = cvt_pk_bf16(o[2], o[3]);
                        if (bad) { w.x = 0x7fc07fc0u; w.y = 0x7fc07fc0u; } *(u32x2v*)(xn + off + bj * HALF + n * 16) = w; }
                asm volatile("" ::: "memory"); }
    }
};

template <class Epi, class Sched, bool ALIGN_EPI = false, bool SP2 = false>
__device__ __forceinline__ void gemm_phase(PG8_LAS unsigned char* lds, const Gemm g, const Sched& S, const Epi& E, int tid_in) {
    int tid_ = tid_in; asm volatile("" : "+v"(tid_));
    const int tid = tid_, wid = __builtin_amdgcn_readfirstlane(tid >> 6), lane = tid & 63, wr = wid >> 2, wc = wid & 3, fr = lane & 15, fq = lane >> 4;
    int K_ = g.K; asm volatile("" : "+s"(K_)); const int K = K_, nt = K / BK;
    unsigned voffA[2], voffB[2];
#pragma unroll
    for (int i = 0; i < 2; ++i) { int R, C; stage_rc(tid * 16 + i * 8192, R, C); const int Rb = Epi::PERM ? ((R & ~31) + perm32(R & 31)) : R;
        voffA[i] = (unsigned)(R * g.lda + C) * 2u; voffB[i] = (unsigned)(Rb * g.ldb + C) * 2u; }
    const size_t kstep = (size_t)(BK * 2);
    const size_t hstepA = (size_t)HALF * g.lda * 2, hstepB = (size_t)HALF * g.ldb * 2;
    const size_t tstepA = 2 * hstepA, tstepB = 2 * hstepB;
    const unsigned ldsw = (unsigned)wid * 1024u;
    const int aoff = lds_byte(wr * 64 + fr, fq * 8), boff = lds_byte(wc * 32 + fr, fq * 8);
#define PG8_SA(b, h) (((b) * 2 + (h)) * HTB)
#define PG8_SB(b, h) ((4 + (b) * 2 + (h)) * HTB)
#define PG8_STAGE(bufoff, gbase, voff) do { _Pragma("unroll") for (int _i = 0; _i < 2; ++_i) \
        __builtin_amdgcn_global_load_lds((const unsigned*)((const char*)(gbase) + (voff)[_i]), (PG8_LAS unsigned*)(lds + (bufoff) + ldsw + _i * 8192), 16, 0, 0); } while (0)
#define PG8_LDA(dst, b, h) do { _Pragma("unroll") for (int m = 0; m < 4; ++m) _Pragma("unroll") for (int k = 0; k < 2; ++k) dst[m][k] = *(const PG8_LAS bf16x8*)(lds + PG8_SA(b, h) + aoff + m * 2048 + k * 1024); } while (0)
#define PG8_LDB(dst, b, h) do { _Pragma("unroll") for (int n = 0; n < 2; ++n) _Pragma("unroll") for (int k = 0; k < 2; ++k) dst[n][k] = *(const PG8_LAS bf16x8*)(lds + PG8_SB(b, h) + boff + n * 2048 + k * 1024); } while (0)
#define PG8_MMA(ai, bj, At, Bt) do { __builtin_amdgcn_s_setprio(1); _Pragma("unroll") for (int m = 0; m < 4; ++m) _Pragma("unroll") for (int n = 0; n < 2; ++n) _Pragma("unroll") for (int k = 0; k < 2; ++k) \
        acc[ai][bj][m][n] = __builtin_amdgcn_mfma_f32_16x16x32_bf16(Bt[n][k], At[m][k], acc[ai][bj][m][n], 0, 0, 0); __builtin_amdgcn_s_setprio(0); } while (0)
#define PG8_WAIT_V(n) asm volatile("s_waitcnt vmcnt(" #n ")" ::: "memory")
#define PG8_WAIT_L(n) asm volatile("s_waitcnt lgkmcnt(" #n ")" ::: "memory")
#define PG8_BAR __builtin_amdgcn_s_barrier()
#define PG8_SCHED __builtin_amdgcn_sched_barrier(0)
    Unit cur, nxt; int ui = 0;
    if (!S.next(0, cur)) return;
    f32x4 acc[2][2][4][2];
#pragma unroll
    for (int a = 0; a < 2; ++a)
#pragma unroll
        for (int b = 0; b < 2; ++b)
#pragma unroll
            for (int m = 0; m < 4; ++m)
#pragma unroll
                for (int n = 0; n < 2; ++n) acc[a][b][m][n] = (f32x4){0.f, 0.f, 0.f, 0.f};
    bf16x8 At[4][2], B0[2][2], B1[2][2];
    const char* cA = (const char*)g.A + (size_t)cur.pm * tstepA + (size_t)cur.ko * 2; const char* cB = (const char*)g.Bt + (size_t)cur.pn * tstepB + (size_t)cur.ko * 2;
    S.a_ready(cur);
    if constexpr (SP2) {
        PG8_STAGE(PG8_SB(0, 0), cB, voffB); PG8_STAGE(PG8_SB(0, 1), cB + hstepB, voffB); PG8_STAGE(PG8_SA(0, 0), cA, voffA); PG8_STAGE(PG8_SA(0, 1), cA + hstepA, voffA);
        if (wr == 1) PG8_BAR;
        PG8_WAIT_V(2); PG8_BAR;
        PG8_STAGE(PG8_SB(1, 0), cB + kstep, voffB); PG8_STAGE(PG8_SA(1, 0), cA + kstep, voffA); PG8_STAGE(PG8_SB(1, 1), cB + hstepB + kstep, voffB);
        PG8_WAIT_V(6); PG8_BAR;
    } else {
        PG8_STAGE(PG8_SB(0, 0), cB, voffB); PG8_STAGE(PG8_SA(0, 0), cA, voffA); PG8_STAGE(PG8_SB(0, 1), cB + hstepB, voffB); PG8_STAGE(PG8_SA(0, 1), cA + hstepA, voffA);
        if (wr == 1) PG8_BAR;
        PG8_WAIT_V(4); PG8_BAR;
        PG8_STAGE(PG8_SB(1, 0), cB + kstep, voffB); PG8_STAGE(PG8_SA(1, 0), cA + kstep, voffA); PG8_STAGE(PG8_SB(1, 1), cB + hstepB + kstep, voffB);
        PG8_WAIT_V(6); PG8_BAR;
    }
    for (;;) {
        const bool has_next = S.next(ui + 1, nxt);
        const char* nA = has_next ? (const char*)g.A + (size_t)nxt.pm * tstepA + (size_t)nxt.ko * 2 : cA; const char* nB = has_next ? (const char*)g.Bt + (size_t)nxt.pn * tstepB + (size_t)nxt.ko * 2 : cB;
#pragma unroll 1
        for (int t = 0; t < nt; t += 2) {
            const bool last = (t == nt - 2);
            const char* a1 = cA + (size_t)(t + 1) * kstep;
            const char* a2 = last ? nA : cA + (size_t)(t + 2) * kstep; const char* b2 = last ? nB : cB + (size_t)(t + 2) * kstep;
            const char* a3 = a2 + kstep; const char* b3 = b2 + kstep;
            if (last && has_next) S.a_ready(nxt);
            if constexpr (SP2) {
            PG8_LDB(B0, 0, 0); PG8_LDB(B1, 0, 1); PG8_SCHED; PG8_LDA(At, 0, 0); PG8_STAGE(PG8_SA(1, 1), a1 + hstepA, voffA);
            PG8_WAIT_V(8); PG8_WAIT_L(0); PG8_BAR; PG8_MMA(0, 0, At, B0); PG8_MMA(0, 1, At, B1); PG8_BAR; PG8_SCHED;
            PG8_LDA(At, 0, 1); PG8_STAGE(PG8_SB(0, 0), b2, voffB); PG8_STAGE(PG8_SB(0, 1), b2 + hstepB, voffB); PG8_STAGE(PG8_SA(0, 0), a2, voffA);
            PG8_WAIT_V(8); PG8_WAIT_L(0); PG8_BAR; PG8_MMA(1, 0, At, B0); PG8_MMA(1, 1, At, B1); PG8_BAR; PG8_SCHED;
            PG8_LDB(B0, 1, 0); PG8_LDB(B1, 1, 1); PG8_SCHED; PG8_LDA(At, 1, 0); PG8_STAGE(PG8_SA(0, 1), a2 + hstepA, voffA);
            PG8_WAIT_V(8); PG8_WAIT_L(0); PG8_BAR; PG8_MMA(0, 0, At, B0); PG8_MMA(0, 1, At, B1); PG8_BAR; PG8_SCHED;
            PG8_LDA(At, 1, 1); PG8_STAGE(PG8_SB(1, 0), b3, voffB); PG8_STAGE(PG8_SB(1, 1), b3 + hstepB, voffB); PG8_STAGE(PG8_SA(1, 0), a3, voffA);
            PG8_WAIT_V(8); PG8_WAIT_L(0); PG8_BAR; PG8_MMA(1, 0, At, B0); PG8_MMA(1, 1, At, B1); PG8_BAR; PG8_SCHED;
            } else {
            PG8_LDB(B0, 0, 0); PG8_SCHED; PG8_LDA(At, 0, 0); PG8_STAGE(PG8_SA(1, 1), a1 + hstepA, voffA);
            PG8_WAIT_L(8); PG8_BAR; PG8_WAIT_L(0); PG8_MMA(0, 0, At, B0); PG8_BAR; PG8_SCHED;
            PG8_LDB(B1, 0, 1); PG8_STAGE(PG8_SB(0, 0), b2, voffB);
            PG8_BAR; PG8_WAIT_L(0); PG8_MMA(0, 1, At, B1); PG8_BAR;
            PG8_LDA(At, 0, 1); PG8_STAGE(PG8_SA(0, 0), a2, voffA);
            PG8_BAR; PG8_WAIT_L(0); PG8_MMA(1, 0, At, B0); PG8_BAR; PG8_SCHED;
            PG8_STAGE(PG8_SB(0, 1), b2 + hstepB, voffB);
            PG8_WAIT_V(6); PG8_BAR; PG8_MMA(1, 1, At, B1); PG8_BAR;
            PG8_LDB(B0, 1, 0); PG8_SCHED; PG8_LDA(At, 1, 0); PG8_STAGE(PG8_SA(0, 1), a2 + hstepA, voffA);
            PG8_WAIT_L(8); PG8_BAR; PG8_WAIT_L(0); PG8_MMA(0, 0, At, B0); PG8_BAR; PG8_SCHED;
            PG8_LDB(B1, 1, 1); PG8_STAGE(PG8_SB(1, 0), b3, voffB);
            PG8_BAR; PG8_WAIT_L(0); PG8_MMA(0, 1, At, B1); PG8_BAR;
            PG8_LDA(At, 1, 1); PG8_STAGE(PG8_SA(1, 0), a3, voffA);
            PG8_BAR; PG8_WAIT_L(0); PG8_MMA(1, 0, At, B0); PG8_BAR; PG8_SCHED;
            PG8_STAGE(PG8_SB(1, 1), b3 + hstepB, voffB);
            PG8_WAIT_V(6); PG8_BAR; PG8_MMA(1, 1, At, B1); PG8_BAR;
            }
        }
        if constexpr (ALIGN_EPI) { if (wr == 0) PG8_BAR; }
        if constexpr (!Epi::AFTER_DRAIN) { E(acc, cur, wr, wc, fr, fq); S.done(cur); }
        if (!has_next) break;
#pragma unroll
        for (int a = 0; a < 2; ++a)
#pragma unroll
            for (int b = 0; b < 2; ++b)
#pragma unroll
                for (int m = 0; m < 4; ++m)
#pragma unroll
                    for (int n = 0; n < 2; ++n) acc[a][b][m][n] = (f32x4){0.f, 0.f, 0.f, 0.f};
        cur = nxt; cA = nA; cB = nB; ++ui;
        if constexpr (ALIGN_EPI) { if (wr == 1) PG8_BAR; }
    }
    PG8_WAIT_V(0);
    if constexpr (!ALIGN_EPI) { if (wr == 0) PG8_BAR; }
    PG8_BAR;
    if constexpr (Epi::AFTER_DRAIN) { E.fused(acc, cur, wr, wc, fr, fq, lds, wid, lane); S.done(cur); }
#undef PG8_SA
#undef PG8_SB
#undef PG8_STAGE
#undef PG8_LDA
#undef PG8_LDB
#undef PG8_MMA
#undef PG8_WAIT_V
#undef PG8_WAIT_L
#undef PG8_BAR
#undef PG8_SCHED
}
}
constexpr int D = 1024, NB = 2, SEQ = 16384, LAT = NB * SEQ, CTXL = 256, NCTX = NB * CTXL, MT = LAT + NCTX;
constexpr int DEPTH = 4, NHEAD = 8, DQK = 96, DV = 64, NKEY = CTXL + SEQ;
constexpr int UW = 1792, KVW = 160;
constexpr int C_HY = 0, C_POOL = 768, C_CQ = 1024, C_CKV = 1408, C_KPE = 1664;
constexpr int FF = 2816, NJ_GU = FF / 128, NEXP = 8;
constexpr size_t KV_HEAD_STRIDE = (size_t)NKEY * KVW;
constexpr float QSCALE = 0.10206207261596577f * 1.4426950408889634f;

namespace pg8 {
__device__ __forceinline__ u32x4 pack8(f32x4 v0, f32x4 v1) { u32x4 w; w.x = cvt_pk_bf16(v0[0], v0[1]); w.y = cvt_pk_bf16(v0[2], v0[3]); w.z = cvt_pk_bf16(v1[0], v1[1]); w.w = cvt_pk_bf16(v1[2], v1[3]); return w; }

struct EpiQRope {
    static constexpr bool PERM = true, AFTER_DRAIN = false;
    bf16_t* Q; const float* rstd; const float* ropec; const float* ropes;
    __device__ __forceinline__ void operator()(const f32x4 (&acc)[2][2][4][2], const Unit& u, int wr, int wc, int fr, int fq) const {
        asm volatile("" : "+v"(fr), "+v"(fq));
        const int row0 = u.pm * BM + wr * 64 + fr; const bool lat = u.pm < (LAT / BM);
        int c0[2], j0[2]; bool rp[2];
#pragma unroll
        for (int bj = 0; bj < 2; ++bj) { c0[bj] = u.pn * BM + bj * HALF + wc * 32 + 8 * fq; const int dl = c0[bj] % DQK; rp[bj] = lat && dl >= 64; j0[bj] = rp[bj] ? ((dl - 64) >> 1) : 0; }
#pragma unroll
        for (int ai = 0; ai < 2; ++ai)
#pragma unroll
            for (int m = 0; m < 4; ++m) { const int row = row0 + ai * HALF + m * 16; const float rs = rstd[row] * QSCALE; const int t = row & (SEQ - 1);
#pragma unroll
                for (int bj = 0; bj < 2; ++bj) { f32x4 v0 = acc[ai][bj][m][0] * rs, v1 = acc[ai][bj][m][1] * rs;
                    if (rp[bj]) { const f32x4 c = *(const f32x4*)(ropec + t * 16 + j0[bj]), s = *(const f32x4*)(ropes + t * 16 + j0[bj]);
                        const f32x4 a = v0 * c - v1 * s, b = v0 * s + v1 * c; v0 = a; v1 = b; }
                    *(u32x4*)(Q + (unsigned)(row * 768 + c0[bj])) = pack8(v0, v1); }
                asm volatile("" ::: "memory"); }
    }
};
struct EpiKV {
    static constexpr bool PERM = true, AFTER_DRAIN = false;
    bf16_t* KV; const float* rstd;
    __device__ __forceinline__ void operator()(const f32x4 (&acc)[2][2][4][2], const Unit& u, int wr, int wc, int fr, int fq) const {
        asm volatile("" : "+v"(fr), "+v"(fq));
        const int row0 = u.pm * BM + wr * 64 + fr; const bool lat = u.pm < (LAT / BM);
        const int d = wc * 32 + 8 * fq, off = d < 64 ? d : d + 32;
#pragma unroll
        for (int ai = 0; ai < 2; ++ai)
#pragma unroll
            for (int m = 0; m < 4; ++m) { const int row = row0 + ai * HALF + m * 16; const float rs = rstd[row];
                int b, key; if (lat) { b = row >> 14; key = CTXL + (row & (SEQ - 1)); } else { const int rc = row - LAT; b = rc >> 8; key = rc & (CTXL - 1); }
                const unsigned ro = (unsigned)((b * NHEAD + 2 * u.pn) * NKEY + key) * KVW + off;
#pragma unroll
                for (int bj = 0; bj < 2; ++bj) *(u32x4*)(KV + ro + bj * (unsigned)KV_HEAD_STRIDE) = pack8(acc[ai][bj][m][0] * rs, acc[ai][bj][m][1] * rs);
                asm volatile("" ::: "memory"); }
    }
};
struct EpiColScale {
    static constexpr bool PERM = true, AFTER_DRAIN = false;
    bf16_t* O; int ldc; const float* cs;
    __device__ __forceinline__ void operator()(const f32x4 (&acc)[2][2][4][2], const Unit& u, int wr, int wc, int fr, int fq) const {
        asm volatile("" : "+v"(fr), "+v"(fq));
        const int row0 = u.pm * BM + wr * 64 + fr;
#pragma unroll
        for (int bj = 0; bj < 2; ++bj) { const int c = u.pn * BM + bj * HALF + wc * 32 + 8 * fq; const f32x4 s0 = *(const f32x4*)(cs + c), s1 = *(const f32x4*)(cs + c + 4);
#pragma unroll
            for (int ai = 0; ai < 2; ++ai)
#pragma unroll
                for (int m = 0; m < 4; ++m) { *(u32x4*)(O + (unsigned)((row0 + ai * HALF + m * 16) * ldc + c)) = pack8(acc[ai][bj][m][0] * s0, acc[ai][bj][m][1] * s1); if (m & 1) asm volatile("" ::: "memory"); } }
    }
};
struct EpiSwiGLU {
    static constexpr bool PERM = true, AFTER_DRAIN = false;
    bf16_t* H;
    __device__ __forceinline__ void operator()(const f32x4 (&acc)[2][2][4][2], const Unit& u, int wr, int wc, int fr, int fq) const {
        asm volatile("" : "+v"(fr), "+v"(fq));
        const int row0 = u.pm * BM + wr * 64 + fr; const int hc = (u.pn % NJ_GU) * HALF + wc * 32 + 8 * fq;
#pragma unroll
        for (int ai = 0; ai < 2; ++ai)
#pragma unroll
            for (int m = 0; m < 4; ++m) { f32x4 h[2];
#pragma unroll
                for (int n = 0; n < 2; ++n) { const f32x4 g = acc[ai][0][m][n], up = acc[ai][1][m][n];
#pragma unroll
                    for (int j = 0; j < 4; ++j) { const float e = __builtin_amdgcn_exp2f(g[j] * -1.4426950408889634f); h[n][j] = g[j] * __builtin_amdgcn_rcpf(1.0f + e) * up[j]; } }
                *(u32x4*)(H + (size_t)(row0 + ai * HALF + m * 16) * FF + hc) = pack8(h[0], h[1]); if (m & 1) asm volatile("" ::: "memory"); }
    }
};
typedef unsigned u32x2g __attribute__((ext_vector_type(2)));
constexpr int XBP = 2 * D;
struct EpiResGate {
    static constexpr bool PERM = false, AFTER_DRAIN = false;
    const float* src_f32; unsigned short* xb; const float* gate;
    __device__ __forceinline__ void operator()(const f32x4 (&acc)[2][2][4][2], const Unit& u, int wr, int wc, int fr, int fq) const {
        asm volatile("" : "+v"(fr), "+v"(fq));
        const int vsel = u.pm < (SEQ / BM) ? 0 : 1;
        unsigned short* base = xb + (size_t)u.pm * BM * XBP; const float* sbase = src_f32 ? src_f32 + (size_t)u.pm * BM * D : nullptr;
        const int col0 = u.pn * BM + wc * 32 + 4 * fq; const float* gp = gate + vsel * 6 * D + col0;
        f32x4 gv[2][2];
#pragma unroll
        for (int bj = 0; bj < 2; ++bj)
#pragma unroll
            for (int n = 0; n < 2; ++n) gv[bj][n] = *(const f32x4*)(gp + bj * HALF + n * 16);
#pragma unroll
        for (int ai = 0; ai < 2; ++ai)
#pragma unroll
            for (int m = 0; m < 4; ++m) { const unsigned rr = (unsigned)(ai * HALF + wr * 64 + m * 16 + fr);
#pragma unroll
                for (int bj = 0; bj < 2; ++bj)
#pragma unroll
                    for (int n = 0; n < 2; ++n) { const unsigned c = (unsigned)(col0 + bj * HALF + n * 16); f32x4 xi;
                        if (sbase) xi = *(const f32x4*)(sbase + rr * D + c);
                        else { const u32x2g w = *(const u32x2g*)(base + rr * XBP + c); xi = (f32x4){__uint_as_float(w.x << 16), __uint_as_float(w.x & 0xffff0000u), __uint_as_float(w.y << 16), __uint_as_float(w.y & 0xffff0000u)}; }
                        const f32x4 o = xi + gv[bj][n] * acc[ai][bj][m][n]; u32x2g ow; ow.x = cvt_pk_bf16(o[0], o[1]); ow.y = cvt_pk_bf16(o[2], o[3]);
                        *(u32x2g*)(base + rr * XBP + c) = ow; }
                if (m & 1) asm volatile("" ::: "memory"); }
    }
};
template <int NJ> struct MoeOrder {
    int t0, nt, G, c; const PG8_LAS int* tstart;
    __device__ __forceinline__ bool next(int i, Unit& u) const {
        int tile, j;
        if (G == 256) { constexpr int NJH = NJ / 2; const int x = c & 7, r = x & 3, ch = x >> 2, w = c >> 3; const int ntr = (nt - r + 3) >> 2; const int Lx = i * 32 + w;
            if (Lx >= ntr * NJH) return false; tile = t0 + 4 * (Lx / NJH) + r; j = ch * NJH + Lx % NJH; }
        else { const int L = i * G + c; if (L >= nt * NJ) return false; tile = t0 + L / NJ; j = L % NJ; }
        int e = 0;
#pragma unroll
        for (int k = 1; k < NEXP; ++k) e += (tile >= tstart[k]) ? 1 : 0;
        u.pm = __builtin_amdgcn_readfirstlane(tile); u.pn = __builtin_amdgcn_readfirstlane(e * NJ + j); u.ko = 0; return true;
    }
    __device__ __forceinline__ void a_ready(const Unit&) const {}
    __device__ __forceinline__ void done(const Unit&) const {}
};
template <int S> struct CtxSplitOrder {
    int G, c, Kp;
    __device__ __forceinline__ bool next(int i, Unit& u) const {
        const int L = i * G + c; if (L >= 8 * S) return false;
        const int ks = L % S, t = L / S; u.pm = LAT / BM + (t >> 2); u.pn = t & 3; u.ko = ks * Kp; return true;
    }
    __device__ __forceinline__ void a_ready(const Unit&) const {}
    __device__ __forceinline__ void done(const Unit&) const {}
};
struct EpiCtxSlab {
    static constexpr bool PERM = false, AFTER_DRAIN = false;
    float* slab; const float* gate; int Kp;
    __device__ __forceinline__ void operator()(const f32x4 (&acc)[2][2][4][2], const Unit& u, int wr, int wc, int fr, int fq) const {
        asm volatile("" : "+v"(fr), "+v"(fq));
        float* base = slab + ((size_t)(u.ko / Kp) * NCTX + (size_t)(u.pm - LAT / BM) * BM) * D;
        const int col0 = u.pn * BM + wc * 32 + 4 * fq; const float* gp = gate + 2 * 6 * D + col0;
        f32x4 gv[2][2];
#pragma unroll
        for (int bj = 0; bj < 2; ++bj)
#pragma unroll
            for (int n = 0; n < 2; ++n) gv[bj][n] = *(const f32x4*)(gp + bj * HALF + n * 16);
#pragma unroll
        for (int ai = 0; ai < 2; ++ai)
#pragma unroll
            for (int m = 0; m < 4; ++m) { const unsigned ro = (unsigned)((ai * HALF + wr * 64 + m * 16 + fr) * D + col0);
#pragma unroll
                for (int bj = 0; bj < 2; ++bj)
#pragma unroll
                    for (int n = 0; n < 2; ++n) *(f32x4*)(base + ro + bj * HALF + n * 16) = gv[bj][n] * acc[ai][bj][m][n];
                if (m & 1) asm volatile("" ::: "memory"); }
    }
};
}
#ifndef ATT_W64
#define ATT_W64 1
#endif
namespace att {
using bf16x8 = __attribute__((ext_vector_type(8))) short;
using s16x4  = __attribute__((ext_vector_type(4))) short;
using f32x16 = __attribute__((ext_vector_type(16))) float;
using u32x4  = __attribute__((ext_vector_type(4))) unsigned;
constexpr int NW = 8, QBLK = 32, KVBLK = 64;
constexpr float SCALE = 0.10206207261596577f;
constexpr float THR = 8.f;
constexpr int SHM_K = KVBLK * 256, SHM_V = KVBLK * DV * 2, BUF = SHM_K + SHM_V, SHM_ATTN = 2 * BUF + NW * 64 * 4 + 16;
#define ATT_KSWZ(row, colB) ((row) * 256 + ((colB) ^ (((row) & 7) << 4)))
#define ATT_SBAR() __builtin_amdgcn_sched_barrier(0)
__device__ __forceinline__ int crow(int r, int hi) { return (r & 3) + 8 * (r >> 2) + 4 * hi; }
__device__ __forceinline__ unsigned cvtpk(float lo, float hi) { unsigned r; asm volatile("v_cvt_pk_bf16_f32 %0, %1, %2" : "=v"(r) : "v"(lo), "v"(hi)); return r; }
constexpr float THRL = THR * 1.4426950408889634f;
template <bool FIRST> __device__ __forceinline__ void partialSM_a(f32x16& p0, f32x16& p1, float& m_ref, f32x16& negm, float& alpha) {
  float pmax = p0[0];
#pragma unroll
  for (int r = 1; r < 16; ++r) pmax = fmaxf(pmax, p0[r]);
#pragma unroll
  for (int r = 0; r < 16; ++r) pmax = fmaxf(pmax, p1[r]);
  { auto rr = __builtin_amdgcn_permlane32_swap(__float_as_uint(pmax), __float_as_uint(pmax), false, false);
    pmax = fmaxf(__uint_as_float(rr[0]), __uint_as_float(rr[1])); }
  if (!FIRST && __builtin_expect(__all(pmax <= THRL), 1)) { alpha = 1.f; }
  else { const float dl = FIRST ? pmax : fmaxf(pmax, 0.f); m_ref += dl; alpha = FIRST ? 1.f : __builtin_amdgcn_exp2f(-dl);
#pragma unroll
    for (int r = 0; r < 16; ++r) { p0[r] -= dl; p1[r] -= dl; }
#pragma unroll
    for (int r = 0; r < 16; ++r) negm[r] = -m_ref;
    asm volatile("" : "+v"(negm)); }
}
__device__ __forceinline__ void partialSM_b(f32x16& p0) {
#pragma unroll
  for (int r = 0; r < 16; ++r) p0[r] = __builtin_amdgcn_exp2f(p0[r]);
}
template <bool DO_EXP = true> __device__ __forceinline__ void finishSM(f32x16& p0, f32x16& p1, float alpha, float& l_reg, bf16x8& pa0, bf16x8& pa1, bf16x8& pa2, bf16x8& pa3) {
  if (DO_EXP) {
#pragma unroll
  for (int r = 0; r < 16; ++r) p1[r] = __builtin_amdgcn_exp2f(p1[r]); }
  float ps = 0;
#pragma unroll
  for (int r = 0; r < 16; ++r) ps += p0[r];
#pragma unroll
  for (int r = 0; r < 16; ++r) ps += p1[r];
  { auto rr = __builtin_amdgcn_permlane32_swap(__float_as_uint(ps), __float_as_uint(ps), false, false);
    ps = __uint_as_float(rr[0]) + __uint_as_float(rr[1]); }
  l_reg = l_reg * alpha + ps;
#define ATT_PK4(P, BASE, OUT) do { unsigned a0 = cvtpk(P[BASE + 0], P[BASE + 1]), a1 = cvtpk(P[BASE + 2], P[BASE + 3]);   \
    unsigned b0 = cvtpk(P[BASE + 4], P[BASE + 5]), b1 = cvtpk(P[BASE + 6], P[BASE + 7]);                              \
    auto r0 = __builtin_amdgcn_permlane32_swap(a0, b0, false, false); auto r1 = __builtin_amdgcn_permlane32_swap(a1, b1, false, false); \
    u32x4 w = {r0[0], r1[0], r0[1], r1[1]}; OUT = *reinterpret_cast<bf16x8*>(&w); } while (0)
  ATT_PK4(p0, 0, pa0); ATT_PK4(p0, 8, pa1); ATT_PK4(p1, 0, pa2); ATT_PK4(p1, 8, pa3);
#undef ATT_PK4
}
__device__ __forceinline__ void kload(bf16x8 (&kf)[12], const char* Ks, int r32, int hi) {
#pragma unroll
  for (int d0 = 0; d0 < DQK / 16; ++d0) { const int cb = (d0 * 16 + hi * 8) * 2;
    kf[2 * d0] = *reinterpret_cast<const bf16x8*>(Ks + ATT_KSWZ(r32, cb)); kf[2 * d0 + 1] = *reinterpret_cast<const bf16x8*>(Ks + ATT_KSWZ(32 + r32, cb)); }
}
__device__ __forceinline__ void qk_mma(f32x16& p0, f32x16& p1, const bf16x8 (&kf)[12], const bf16x8* qr, const f32x16& negm) {
  p0 = negm; p1 = negm;
#pragma unroll
  for (int d0 = 0; d0 < DQK / 16; ++d0) { p0 = __builtin_amdgcn_mfma_f32_32x32x16_bf16(kf[2 * d0], qr[d0], p0, 0, 0, 0); p1 = __builtin_amdgcn_mfma_f32_32x32x16_bf16(kf[2 * d0 + 1], qr[d0], p1, 0, 0, 0); }
}
__device__ __forceinline__ void qkt(f32x16& p0, f32x16& p1, const char* Ks, const bf16x8* qr, int r32, int hi, const f32x16& negm) { bf16x8 kf[12]; kload(kf, Ks, r32, hi); qk_mma(p0, p1, kf, qr, negm); }
__device__ __forceinline__ int v_st(int k, int c) { const int kk = (k & ~0xC) | ((k & 4) << 1) | ((k & 8) >> 1); return ((kk >> 3) * 2 + (c >> 5)) * 512 + ((kk & 7) * 32 + (c & 31)) * 2; }
__device__ __forceinline__ int v_rd_base(int lane) { return ((lane & 3) << 3) | (((lane >> 2) & 3) << 6) | (((lane >> 4) & 1) << 5) | (((lane >> 5) & 1) << 8); }
constexpr int v_rd_off(int d0, int ks, int half) { return d0 * 512 + ks * 2048 + half * 1024; }
template <int OFF> __device__ __forceinline__ s16x4 tr_read(int vb) {
  s16x4 r; asm volatile("ds_read_b64_tr_b16 %0, %1 offset:%2" : "=&v"(r) : "v"(vb), "i"(OFF) : "memory"); return r;
}
struct VFrag { s16x4 l[2][4], h[2][4]; };
__device__ __forceinline__ void vload(VFrag& v, int vb) {
#define ATT_VR(D0, KS) v.l[D0][KS] = tr_read<v_rd_off(D0, KS, 0)>(vb); v.h[D0][KS] = tr_read<v_rd_off(D0, KS, 1)>(vb);
  ATT_VR(0, 0) ATT_VR(1, 0) ATT_VR(0, 1) ATT_VR(1, 1) ATT_VR(0, 2) ATT_VR(1, 2) ATT_VR(0, 3) ATT_VR(1, 3)
#undef ATT_VR
}
__device__ __forceinline__ void pv_mma(f32x16* o, const VFrag& v, bf16x8 pa0, bf16x8 pa1, bf16x8 pa2, bf16x8 pa3) {
#define ATT_PK(L, H) (bf16x8){L[0], L[1], L[2], L[3], H[0], H[1], H[2], H[3]}
  o[0] = __builtin_amdgcn_mfma_f32_32x32x16_bf16(pa0, ATT_PK(v.l[0][0], v.h[0][0]), o[0], 0, 0, 0); o[1] = __builtin_amdgcn_mfma_f32_32x32x16_bf16(pa0, ATT_PK(v.l[1][0], v.h[1][0]), o[1], 0, 0, 0);
  o[0] = __builtin_amdgcn_mfma_f32_32x32x16_bf16(pa1, ATT_PK(v.l[0][1], v.h[0][1]), o[0], 0, 0, 0); o[1] = __builtin_amdgcn_mfma_f32_32x32x16_bf16(pa1, ATT_PK(v.l[1][1], v.h[1][1]), o[1], 0, 0, 0);
  o[0] = __builtin_amdgcn_mfma_f32_32x32x16_bf16(pa2, ATT_PK(v.l[0][2], v.h[0][2]), o[0], 0, 0, 0); o[1] = __builtin_amdgcn_mfma_f32_32x32x16_bf16(pa2, ATT_PK(v.l[1][2], v.h[1][2]), o[1], 0, 0, 0);
  o[0] = __builtin_amdgcn_mfma_f32_32x32x16_bf16(pa3, ATT_PK(v.l[0][3], v.h[0][3]), o[0], 0, 0, 0); o[1] = __builtin_amdgcn_mfma_f32_32x32x16_bf16(pa3, ATT_PK(v.l[1][3], v.h[1][3]), o[1], 0, 0, 0);
#undef ATT_PK
}
__device__ __forceinline__ void pv_d0(f32x16* o, int vb, bf16x8 pa0, bf16x8 pa1, bf16x8 pa2, bf16x8 pa3) {
  VFrag v; vload(v, vb); asm volatile("s_waitcnt lgkmcnt(0)" ::: "memory"); ATT_SBAR(); pv_mma(o, v, pa0, pa1, pa2, pa3);
}
#define ATT_SEGB(P0, P1, AL, VB) do { VFrag v_; if (!(STRIP & 4)) vload(v_, (VB)); else { _Pragma("unroll") for (int a_ = 0; a_ < 2; ++a_) _Pragma("unroll") for (int b_ = 0; b_ < 4; ++b_) { v_.l[a_][b_] = (s16x4){pa0[0], pa1[1], pa2[2], pa3[3]}; v_.h[a_][b_] = (s16x4){pa0[4], pa1[5], pa2[6], pa3[7]}; } } \
    if (!FAST) partialSM_a<false>(P0, P1, m_ref, negm, AL); asm volatile("s_waitcnt lgkmcnt(0)" ::: "memory"); ATT_SBAR(); \
    pv_mma(o, v_, pa0, pa1, pa2, pa3); if (!(STRIP & 1)) partialSM_b(P0); } while (0)
template <bool FAST, int STRIP = 0> __device__ __forceinline__ bool attn_unit(const unsigned short* __restrict__ Qb, const unsigned short* __restrict__ KVh, unsigned short* __restrict__ Ob, int seq, char* lds, int tid) {
  const int wid = __builtin_amdgcn_readfirstlane(tid >> 6), lane = tid & 63, r32 = lane & 31, hi = lane >> 5;
  float* ws = (float*)(lds + 2 * BUF) + wid * 64; float* li_l = ws; float* al_l = ws + 32; unsigned* okflag = (unsigned*)(lds + 2 * BUF + NW * 64 * 4);
  if (FAST && tid == 0) *okflag = 0u;
  float m_ref = 0.f, l_reg = 0; f32x16 o[2] = {}; f32x16 negm = {}; bf16x8 qr[DQK / 16];
  { const unsigned qoff = (unsigned)((wid * QBLK + r32) * 768 + hi * 8);
#pragma unroll
    for (int d0 = 0; d0 < DQK / 16; ++d0) qr[d0] = *reinterpret_cast<const bf16x8*>(Qb + qoff + d0 * 16); }
  int dst[3];
#pragma unroll
  for (int i = 0; i < 3; ++i) { const int c = tid + 512 * i, row = c / 20, part = c % 20; dst[i] = part < 12 ? ATT_KSWZ(row, part * 16) : SHM_K + v_st(row, (part - 12) * 8); }
  const bool third = wid < 4;
  const char* kvb = (const char*)KVh; const unsigned voff = (unsigned)tid * 16u; const unsigned off2 = third ? 16384u : 0u;
  const int vb0 = (int)(uintptr_t)(lds + SHM_K) + v_rd_base(lane);
  bf16x8 sA0, sA1, sA2, sB0, sB1, sB2;
#define ATT_SLOAD(S, k0) do { const char* p_ = kvb + (long)(k0) * (KVW * 2);     \
    S##0 = *reinterpret_cast<const bf16x8*>(p_ + voff); S##1 = *reinterpret_cast<const bf16x8*>(p_ + 8192 + voff); S##2 = *reinterpret_cast<const bf16x8*>(p_ + off2 + voff); } while (0)
#define ATT_SWRITE(b, S) do { char* q_ = lds + (b) * BUF; *reinterpret_cast<bf16x8*>(q_ + dst[0]) = S##0; *reinterpret_cast<bf16x8*>(q_ + dst[1]) = S##1; \
    if (third) *reinterpret_cast<bf16x8*>(q_ + dst[2]) = S##2; } while (0)
#define ATT_RESC(a) do { if (!FAST && __any((a) < 1.f)) { if (hi == 0) al_l[r32] = (a); asm volatile("s_waitcnt lgkmcnt(0)" ::: "memory"); \
    _Pragma("unroll") for (int d = 0; d < 2; ++d) _Pragma("unroll") for (int r = 0; r < 16; ++r) o[d][r] *= al_l[crow(r, hi)]; } } while (0)
#define ATT_FIN(P0, P1, AL) do { if (!(STRIP & 1)) finishSM(P0, P1, AL, l_reg, pa0, pa1, pa2, pa3); else { u32x4 w0_ = {__float_as_uint(P0[0]), __float_as_uint(P0[1]), __float_as_uint(P0[2]), __float_as_uint(P0[3])}, w1_ = {__float_as_uint(P0[4]), __float_as_uint(P0[5]), __float_as_uint(P0[6]), __float_as_uint(P0[7])}, \
           w2_ = {__float_as_uint(P1[0]), __float_as_uint(P1[1]), __float_as_uint(P1[2]), __float_as_uint(P1[3])}, w3_ = {__float_as_uint(P1[4]), __float_as_uint(P1[5]), __float_as_uint(P1[6]), __float_as_uint(P1[7])}; \
           pa0 = *reinterpret_cast<bf16x8*>(&w0_); pa1 = *reinterpret_cast<bf16x8*>(&w1_); pa2 = *reinterpret_cast<bf16x8*>(&w2_); pa3 = *reinterpret_cast<bf16x8*>(&w3_); l_reg += P1[8]; } } while (0)
#define ATT_QKT(P0, P1, KS) do { bf16x8 kf_[12]; if (!(STRIP & 16)) kload(kf_, (KS), r32, hi); else { _Pragma("unroll") for (int i_ = 0; i_ < 12; ++i_) kf_[i_] = qr[i_ % 6]; } qk_mma(P0, P1, kf_, qr, negm); } while (0)
  f32x16 pA0, pA1, pB0, pB1; float alA = 1.f, alB = 1.f; bf16x8 pa0, pa1, pa2, pa3; const int NT = seq / KVBLK;
  ATT_SLOAD(sA, 0); ATT_SWRITE(0, sA); __syncthreads();
  ATT_QKT(pA0, pA1, lds); partialSM_a<true>(pA0, pA1, m_ref, negm, alA); partialSM_b(pA0);
  ATT_SLOAD(sB, KVBLK); if (2 < NT) ATT_SLOAD(sA, 2 * KVBLK);
  ATT_SWRITE(1, sB); __syncthreads();
#define ATT_LBAR() do { if (!(STRIP & 8)) __syncthreads(); } while (0)
  for (int j = 1; j + 1 < NT; j += 2) {
    ATT_SBAR(); if (!(STRIP & 2)) ATT_SLOAD(sB, (STRIP & 32) ? 0 : (j + 2) * KVBLK); ATT_SBAR();
    ATT_QKT(pB0, pB1, lds + BUF);
    ATT_FIN(pA0, pA1, alA); ATT_SBAR();
    ATT_SEGB(pB0, pB1, alB, vb0);
    ATT_LBAR(); if (!(STRIP & 2)) ATT_SWRITE(0, sA);
    ATT_RESC(alB); ATT_LBAR();
    ATT_SBAR(); if (!(STRIP & 2) && j + 3 < NT) ATT_SLOAD(sA, (STRIP & 32) ? 0 : (j + 3) * KVBLK); ATT_SBAR();
    ATT_QKT(pA0, pA1, lds);
    ATT_FIN(pB0, pB1, alB); ATT_SBAR();
    ATT_SEGB(pA0, pA1, alA, vb0 + BUF);
    ATT_LBAR(); if (!(STRIP & 2)) ATT_SWRITE(1, sB);
    ATT_RESC(alA); ATT_LBAR();
  }
#undef ATT_LBAR
  ATT_SBAR(); ATT_QKT(pB0, pB1, lds + BUF);
  ATT_FIN(pA0, pA1, alA); ATT_SBAR();
  ATT_SEGB(pB0, pB1, alB, vb0);
  __syncthreads(); ATT_RESC(alB);
  ATT_FIN(pB0, pB1, alB); ATT_SBAR();
  pv_d0(o, vb0 + BUF, pa0, pa1, pa2, pa3);
  if (FAST) { const bool bad = !(l_reg < 1.3e36f);
    if (__any(bad) && lane == 0) *okflag = 1u;
    __syncthreads(); if (*okflag != 0u) { __syncthreads(); return false; } }
  if (hi == 0) li_l[r32] = l_reg; asm volatile("s_waitcnt lgkmcnt(0)" ::: "memory");
  float rli[16];
#pragma unroll
  for (int r = 0; r < 16; ++r) rli[r] = __builtin_amdgcn_rcpf(li_l[crow(r, hi)]);
  unsigned short* Ow = Ob + (long)(wid * QBLK) * D;
#pragma unroll
  for (int r = 0; r < 16; ++r) { const int orow = crow(r, hi);
    *reinterpret_cast<unsigned*>(Ow + (long)orow * D + 2 * r32) = cvtpk(o[0][r] * rli[r], o[1][r] * rli[r]); }
  __syncthreads();
  return true;
#undef ATT_QKT
#undef ATT_FIN
#undef ATT_SLOAD
#undef ATT_SWRITE
#undef ATT_RESC
}
constexpr int PKP = 192, PSHK = KVBLK * PKP, PBUF = PSHK + SHM_V;
#ifndef ATT_PNB
#define ATT_PNB 5
#endif
constexpr int PNB = ATT_PNB;
#ifdef ATT_PP_SETPRIO
#define PP_PRIO(x) __builtin_amdgcn_s_setprio(x)
#else
#define PP_PRIO(x) do {} while (0)
#endif
typedef __attribute__((address_space(3))) unsigned lds_u32;
typedef __attribute__((address_space(3))) unsigned char lds_u8;
__device__ __forceinline__ void kload_pp(bf16x8 (&kf)[12], const char* Ks, int kbe, int kbo) {
#pragma unroll
  for (int d0 = 0; d0 < DQK / 16; ++d0) { const int a = ((d0 & 1) ? kbo : kbe) + (d0 >> 1) * 64;
    kf[2 * d0] = *reinterpret_cast<const bf16x8*>(Ks + a); kf[2 * d0 + 1] = *reinterpret_cast<const bf16x8*>(Ks + a + 32 * PKP); }
}
template <int STRIP = 0> __device__ __forceinline__ bool attn_unit_pp(const unsigned short* __restrict__ Qb, const unsigned short* __restrict__ KVh, unsigned short* __restrict__ Ob, int seq, lds_u8* ldsl, int tid) {
  char* lds = (char*)ldsl;
  const int wid = __builtin_amdgcn_readfirstlane(tid >> 6), lane = tid & 63, r32 = lane & 31, hi = lane >> 5;
  float* ws = (float*)(lds + PNB * PBUF) + wid * 64; float* li_l = ws; unsigned* okflag = (unsigned*)(lds + PNB * PBUF + NW * 64 * 4);
  if (tid == 0) *okflag = 0u;
  float m_ref = 0.f, l_reg = 0.f, alpha = 1.f; f32x16 o[2] = {}; f32x16 negm = {}; bf16x8 qr[DQK / 16];
  { const unsigned qoff = (unsigned)((wid * QBLK + r32) * 768 + hi * 8);
#pragma unroll
    for (int d0 = 0; d0 < DQK / 16; ++d0) qr[d0] = *reinterpret_cast<const bf16x8*>(Qb + qoff + d0 * 16); }
  const bool third = wid < 4;
  unsigned g0, g1, g2;
  { const int q0 = wid * 64 + lane, r0 = q0 / 12, s0 = q0 % 12; g0 = (unsigned)(r0 * (KVW * 2) + ((s0 ^ ((r0 >> 2) & 3)) << 4));
    const int q1 = (wid + 8) * 64 + lane, r1 = q1 / 12, s1 = q1 % 12; const unsigned g1k = (unsigned)(r1 * (KVW * 2) + ((s1 ^ ((r1 >> 2) & 3)) << 4));
    const int v1 = (wid - 4) * 64 + lane, v2 = (wid + 4) * 64 + lane;
    auto vsrc = [](int v) { const int sub = v >> 5, w = v & 31, kk = (sub >> 1) * 8 + (w >> 2), k = (kk & ~0xC) | ((kk & 4) << 1) | ((kk & 8) >> 1), c = (sub & 1) * 32 + (w & 3) * 8; return (unsigned)(k * (KVW * 2) + 192 + c * 2); };
    g1 = third ? g1k : vsrc(v1); g2 = vsrc(v2 & 511); }
  const int fsw = (r32 >> 2) & 3; const int kbe = r32 * PKP + ((hi ^ fsw) << 4), kbo = r32 * PKP + (((2 + hi) ^ fsw) << 4);
  const int vb0 = (int)(uintptr_t)(lds + PSHK) + v_rd_base(lane);
  const char* kvb = (const char*)KVh; const int NT = seq / KVBLK;
#define PP_DMA(T, OFF) do { const char* tb_ = kvb + (long)(T) * (KVBLK * KVW * 2); lds_u8* sb_ = ldsl + (OFF) + wid * 1024; \
    __builtin_amdgcn_global_load_lds((const unsigned*)(tb_ + g0), (lds_u32*)sb_, 16, 0, 0); \
    __builtin_amdgcn_global_load_lds((const unsigned*)(tb_ + g1), (lds_u32*)(sb_ + 8192), 16, 0, 0); \
    if (third) __builtin_amdgcn_global_load_lds((const unsigned*)(tb_ + g2), (lds_u32*)(sb_ + 16384), 16, 0, 0); } while (0)
#define PP_WAITV() do { if (third) asm volatile("s_waitcnt vmcnt(%0)" :: "n"(3 * (PNB - 3)) : "memory"); else asm volatile("s_waitcnt vmcnt(%0)" :: "n"(2 * (PNB - 3)) : "memory"); } while (0)
  f32x16 p0, p1; bf16x8 pa0, pa1, pa2, pa3; bf16x8 kf[12]; VFrag vf;
#pragma unroll
  for (int T = 0; T < PNB - 1; ++T) { const int Tc = T < NT ? T : NT - 1; PP_DMA(Tc, T * PBUF); }
  PP_WAITV();
  __builtin_amdgcn_s_barrier();
  kload_pp(kf, lds, kbe, kbo); if (STRIP & 4) vload(vf, vb0); asm volatile("s_waitcnt lgkmcnt(0)" ::: "memory");
  if (wid >= 4) __builtin_amdgcn_s_barrier();
  int oK = PBUF, oV = 0, oD = (PNB - 1) * PBUF;
#define PP_ADV(x) do { x += PBUF; if (x == PNB * PBUF) x = 0; } while (0)
#define PP_LSEG(FIRST_, t_) do { ATT_SBAR(); if (!(STRIP & 4)) { kload_pp(kf, lds + oK, kbe, kbo); vload(vf, vb0 + oV); } ATT_SBAR(); \
    if (!(STRIP & 2) && (t_) + PNB - 1 < NT) { PP_DMA((t_) + PNB - 1, oD); } ATT_SBAR(); \
    if (FIRST_) partialSM_a<true>(p0, p1, m_ref, negm, alpha); \
    if (!(STRIP & 1)) { partialSM_b(p0); finishSM(p0, p1, 1.f, l_reg, pa0, pa1, pa2, pa3); } \
    else { u32x4 w0_ = {__float_as_uint(p0[0]), __float_as_uint(p0[1]), __float_as_uint(p0[2]), __float_as_uint(p0[3])}, w1_ = {__float_as_uint(p0[4]), __float_as_uint(p0[5]), __float_as_uint(p0[6]), __float_as_uint(p0[7])}, \
           w2_ = {__float_as_uint(p1[0]), __float_as_uint(p1[1]), __float_as_uint(p1[2]), __float_as_uint(p1[3])}, w3_ = {__float_as_uint(p1[4]), __float_as_uint(p1[5]), __float_as_uint(p1[6]), __float_as_uint(p1[7])}; \
           pa0 = *reinterpret_cast<bf16x8*>(&w0_); pa1 = *reinterpret_cast<bf16x8*>(&w1_); pa2 = *reinterpret_cast<bf16x8*>(&w2_); pa3 = *reinterpret_cast<bf16x8*>(&w3_); l_reg += p1[8]; } ATT_SBAR(); \
    if ((t_) + PNB - 1 < NT) PP_WAITV(); else asm volatile("s_waitcnt vmcnt(0)" ::: "memory"); \
    asm volatile("s_waitcnt lgkmcnt(0)" ::: "memory"); ATT_SBAR(); __builtin_amdgcn_s_barrier(); ATT_SBAR(); PP_ADV(oK); PP_ADV(oV); PP_ADV(oD); } while (0)
  PP_PRIO(1); qk_mma(p0, p1, kf, qr, negm); PP_PRIO(0); ATT_SBAR(); __builtin_amdgcn_s_barrier(); ATT_SBAR();
  PP_LSEG(true, 0);
#pragma unroll 1
  for (int t = 1; t < NT; ++t) {
    if (!(STRIP & 8)) { PP_PRIO(1); qk_mma(p0, p1, kf, qr, negm); pv_mma(o, vf, pa0, pa1, pa2, pa3); PP_PRIO(0); }
    else { _Pragma("unroll") for (int i_ = 0; i_ < 12; ++i_) asm volatile("" :: "v"(kf[i_])); asm volatile("" :: "v"(vf.l[0][0]), "v"(vf.h[1][3]), "v"(pa0), "v"(pa1), "v"(pa2), "v"(pa3)); asm volatile("" : "+v"(p0), "+v"(p1)); }
    ATT_SBAR(); __builtin_amdgcn_s_barrier(); ATT_SBAR();
    PP_LSEG(false, t);
  }
  PP_PRIO(1); pv_mma(o, vf, pa0, pa1, pa2, pa3); PP_PRIO(0); ATT_SBAR();
  if (wid < 4) __builtin_amdgcn_s_barrier();
  { const bool bad = !(l_reg < 1.3e36f);
    if (__any(bad) && lane == 0) *okflag = 1u;
    __syncthreads(); if (*okflag != 0u) { __syncthreads(); return false; } }
  if (hi == 0) li_l[r32] = l_reg; asm volatile("s_waitcnt lgkmcnt(0)" ::: "memory");
  float rli[16];
#pragma unroll
  for (int r = 0; r < 16; ++r) rli[r] = __builtin_amdgcn_rcpf(li_l[crow(r, hi)]);
  unsigned short* Ow = Ob + (long)(wid * QBLK) * D;
#pragma unroll
  for (int r = 0; r < 16; ++r) { const int orow = crow(r, hi);
    *reinterpret_cast<unsigned*>(Ow + (long)orow * D + 2 * r32) = cvtpk(o[0][r] * rli[r], o[1][r] * rli[r]); }
  __syncthreads();
  return true;
#undef PP_DMA
#undef PP_WAITV
#undef PP_ADV
#undef PP_LSEG
}
#ifndef ATT_WNB
#define ATT_WNB 4
#endif
constexpr int WNB = ATT_WNB;
__device__ __forceinline__ bool attn_unit_w64(const unsigned short* __restrict__ Qb, const unsigned short* __restrict__ KVh, unsigned short* __restrict__ Ob, int seq, lds_u8* ldsl, int tid) {
  char* lds = (char*)ldsl;
  const int wid = __builtin_amdgcn_readfirstlane(tid >> 6), lane = tid & 63, r32 = lane & 31, hi = lane >> 5;
  float* ws = (float*)(lds + WNB * PBUF) + wid * 64; unsigned* okflag = (unsigned*)(lds + WNB * PBUF + NW * 64 * 4);
  if (tid == 0) *okflag = 0u;
  float lA = 0.f, lB = 0.f; f32x16 oA[2] = {}, oB[2] = {}; const f32x16 zero = {}; bf16x8 qA[DQK / 16], qB[DQK / 16];
  { const unsigned qoff = (unsigned)((wid * 64 + r32) * 768 + hi * 8);
#pragma unroll
    for (int d0 = 0; d0 < DQK / 16; ++d0) { qA[d0] = *reinterpret_cast<const bf16x8*>(Qb + qoff + d0 * 16); qB[d0] = *reinterpret_cast<const bf16x8*>(Qb + qoff + 32 * 768 + d0 * 16); } }
  const bool third = wid < 4;
  unsigned g0, g1, g2;
  { const int q0 = wid * 64 + lane, r0 = q0 / 12, s0 = q0 % 12; g0 = (unsigned)(r0 * (KVW * 2) + ((s0 ^ ((r0 >> 2) & 3)) << 4));
    const int q1 = (wid + 8) * 64 + lane, r1 = q1 / 12, s1 = q1 % 12; const unsigned g1k = (unsigned)(r1 * (KVW * 2) + ((s1 ^ ((r1 >> 2) & 3)) << 4));
    const int v1 = (wid - 4) * 64 + lane, v2 = (wid + 4) * 64 + lane;
    auto vsrc = [](int v) { const int sub = v >> 5, w = v & 31, kk = (sub >> 1) * 8 + (w >> 2), k = (kk & ~0xC) | ((kk & 4) << 1) | ((kk & 8) >> 1), c = (sub & 1) * 32 + (w & 3) * 8; return (unsigned)(k * (KVW * 2) + 192 + c * 2); };
    g1 = third ? g1k : vsrc(v1 & 511); g2 = vsrc(v2 & 511); }
  const int fsw = (r32 >> 2) & 3; const int kbe = r32 * PKP + ((hi ^ fsw) << 4), kbo = r32 * PKP + (((2 + hi) ^ fsw) << 4);
  const int vb0 = (int)(uintptr_t)(lds + PSHK) + v_rd_base(lane);
  const char* kvb = (const char*)KVh; const int NT = seq / KVBLK;
#define W64_DMA(T, OFF) do { const char* tb_ = kvb + (long)(T) * (KVBLK * KVW * 2); lds_u8* sb_ = ldsl + (OFF) + wid * 1024; \
    __builtin_amdgcn_global_load_lds((const unsigned*)(tb_ + g0), (lds_u32*)sb_, 16, 0, 0); \
    __builtin_amdgcn_global_load_lds((const unsigned*)(tb_ + g1), (lds_u32*)(sb_ + 8192), 16, 0, 0); \
    if (third) __builtin_amdgcn_global_load_lds((const unsigned*)(tb_ + g2), (lds_u32*)(sb_ + 16384), 16, 0, 0); } while (0)
#define W64_WAITV() do { if (third) asm volatile("s_waitcnt vmcnt(%0)" :: "n"(3 * (WNB - 2)) : "memory"); else asm volatile("s_waitcnt vmcnt(%0)" :: "n"(2 * (WNB - 2)) : "memory"); } while (0)
#pragma unroll
  for (int T = 0; T < WNB; ++T) { const int Tc = T < NT ? T : NT - 1; W64_DMA(Tc, T * PBUF); }
  f32x16 pA0, pA1, pB0, pB1; bf16x8 pa0, pa1, pa2, pa3, pb0, pb1, pb2, pb3; bf16x8 kf[12];
  if (third) asm volatile("s_waitcnt vmcnt(%0)" :: "n"(3 * (WNB - 1)) : "memory"); else asm volatile("s_waitcnt vmcnt(%0)" :: "n"(2 * (WNB - 1)) : "memory");
  __builtin_amdgcn_s_barrier(); ATT_SBAR();
  kload_pp(kf, lds, kbe, kbo);
#ifdef W64_V1
  if (wid >= 4) __builtin_amdgcn_s_setprio(1);
#endif
  int oT = 0;
#pragma unroll 1
  for (int t = 0; t < NT; ++t) {
    ATT_SBAR(); qk_mma(pA0, pA1, kf, qA, zero);
    qk_mma(pB0, pB1, kf, qB, zero); partialSM_b(pA0); finishSM(pA0, pA1, 1.f, lA, pa0, pa1, pa2, pa3); ATT_SBAR();
    VFrag vf; vload(vf, vb0 + oT); ATT_SBAR();
    partialSM_b(pB0); partialSM_b(pB1); asm volatile("s_waitcnt lgkmcnt(0)" ::: "memory"); ATT_SBAR();
    pv_mma(oA, vf, pa0, pa1, pa2, pa3); finishSM<false>(pB0, pB1, 1.f, lB, pb0, pb1, pb2, pb3); ATT_SBAR();

    if (t + WNB - 1 < NT) W64_WAITV(); else asm volatile("s_waitcnt vmcnt(0)" ::: "memory");
    __builtin_amdgcn_s_barrier(); ATT_SBAR();
    if (t + WNB < NT) W64_DMA(t + WNB, oT);
    oT += PBUF; if (oT == WNB * PBUF) oT = 0;
    ATT_SBAR(); kload_pp(kf, lds + oT, kbe, kbo); ATT_SBAR();
    pv_mma(oB, vf, pb0, pb1, pb2, pb3); ATT_SBAR();
  }
#ifdef ATT_W64_CHECK_FALLBACK
  lA = -1.f;
#endif
#ifdef W64_V1
  __builtin_amdgcn_s_setprio(0);
#endif
  { const bool bad = !(lA < 1.3e36f) || !(lA > 1e-30f) || !(lB < 1.3e36f) || !(lB > 1e-30f);
    if (__any(bad) && lane == 0) *okflag = 1u;
    __syncthreads(); if (*okflag != 0u) { __syncthreads(); return false; } }
  if (hi == 0) { ws[r32] = lA; ws[32 + r32] = lB; } asm volatile("s_waitcnt lgkmcnt(0)" ::: "memory");
  unsigned short* Ow = Ob + (long)(wid * 64) * D;
#pragma unroll
  for (int r = 0; r < 16; ++r) { const int orow = crow(r, hi); const float ra = __builtin_amdgcn_rcpf(ws[orow]), rb = __builtin_amdgcn_rcpf(ws[32 + orow]);
    *reinterpret_cast<unsigned*>(Ow + (long)orow * D + 2 * r32) = cvtpk(oA[0][r] * ra, oA[1][r] * ra);
    *reinterpret_cast<unsigned*>(Ow + (long)(32 + orow) * D + 2 * r32) = cvtpk(oB[0][r] * rb, oB[1][r] * rb); }
  __syncthreads();
  return true;
#undef W64_DMA
#undef W64_WAITV
}
#undef ATT_SEGB
#undef ATT_KSWZ
#undef ATT_SBAR
}
#define GAS __attribute__((address_space(1)))
#define LAS __attribute__((address_space(3)))
typedef unsigned short bf16;
typedef unsigned v4u __attribute__((ext_vector_type(4)));
typedef unsigned v2u __attribute__((ext_vector_type(2)));
typedef float f32x4 __attribute__((ext_vector_type(4)));
typedef short bf16x8 __attribute__((ext_vector_type(8)));
typedef GAS unsigned gu32;
typedef GAS unsigned long long gu64;
#define RLX_AGENT __ATOMIC_RELAXED, __HIP_MEMORY_SCOPE_AGENT
#define LDS_WAIT() asm volatile("s_waitcnt lgkmcnt(0)" ::: "memory")
#define VM_WAIT() asm volatile("s_waitcnt vmcnt(0)" ::: "memory")
__device__ __forceinline__ unsigned long long rt() { return __builtin_amdgcn_s_memrealtime(); }
__device__ __forceinline__ unsigned f2bf(float f) { unsigned u = __builtin_bit_cast(unsigned, f); return (u + 0x7fffu + ((u >> 16) & 1u)) >> 16; }
__device__ __forceinline__ unsigned pk2(float lo, float hi) { return f2bf(lo) | (f2bf(hi) << 16); }

#define XB_TMO      128
#define XB_XCNT(j)  (256  + 64 * (j))
#define XB_XSUB(j)  (1280 + 64 * (j))
#define XB_XGEN(j)  (2304 + 64 * (j))
#define XB_TOP      3328
#define XB_TOPGEN   3392
#define XCD_BAR_WORDS 3456
#define XB_SPIN_CAP (1u << 18)

__device__ __forceinline__ unsigned xb_ld(unsigned* p)              { return __hip_atomic_load(p, __ATOMIC_RELAXED, __HIP_MEMORY_SCOPE_AGENT); }
__device__ __forceinline__ unsigned xb_add(unsigned* p, unsigned v) { return __hip_atomic_fetch_add(p, v, __ATOMIC_RELAXED, __HIP_MEMORY_SCOPE_AGENT); }
__device__ __forceinline__ unsigned xb_xcc_id() { return (unsigned)__builtin_amdgcn_s_getreg((3 << 11) | 20) & 0xFu; }
#define XB_SPIN(cond, bar) do { unsigned _sp = 0; while (cond) { __builtin_amdgcn_s_sleep(1); \
    if ((++_sp & 255u) == 0u) { if (xb_ld(&(bar)[XB_TMO])) break; if (_sp > XB_SPIN_CAP) { atomicAdd(&(bar)[XB_TMO], 1u); break; } } } } while (0)

struct XcdBarrier {
    unsigned* bar; unsigned x;
    volatile LAS unsigned* st;
};

__device__ __forceinline__ XcdBarrier xcd_barrier_post(unsigned* bar, volatile LAS unsigned* st) {
    XcdBarrier b; b.bar = bar; b.x = xb_xcc_id(); b.st = st;
    if (threadIdx.x == 0) (void)xb_add(&bar[XB_XCNT(b.x)], 1u);
    return b;
}
__device__ __forceinline__ void xcd_barrier_complete(unsigned* bar, unsigned x, unsigned& nloc, unsigned& nx) {
    const unsigned G = gridDim.x * gridDim.y * gridDim.z;
    unsigned sum, cnt, mine, sp = 0u;
    for (;;) {
        sum = 0u; cnt = 0u; mine = 0u;
#pragma unroll
        for (unsigned j = 0; j < 16; ++j) { const unsigned c = xb_ld(&bar[XB_XCNT(j)]); sum += c; cnt += (c > 0u) ? 1u : 0u; mine = (j == x) ? c : mine; }
        if (sum == G) break;
        __builtin_amdgcn_s_sleep(1);
        if ((++sp & 255u) == 0u) { if (xb_ld(&bar[XB_TMO])) break; if (sp > XB_SPIN_CAP) { atomicAdd(&bar[XB_TMO], 1u); break; } }
    }
    nloc = mine > 0u ? mine : 1u; nx = cnt > 0u ? cnt : 1u;
}

__device__ __forceinline__ void xcd_barrier(const XcdBarrier& b, const bool leader_thread  ) {
    asm volatile("s_waitcnt vmcnt(0)" ::: "memory");
    __syncthreads();
    if (leader_thread) {
        unsigned* bar = b.bar;
        __builtin_amdgcn_s_waitcnt(0);
        unsigned nloc = b.st[0], nx = b.st[1];
        if (nloc == 0u) { xcd_barrier_complete(bar, b.x, nloc, nx); b.st[0] = nloc; b.st[1] = nx; }
        const unsigned old = xb_add(&bar[XB_XSUB(b.x)], 1u);
        const unsigned gen = old / nloc;
        if (old + 1u == (gen + 1u) * nloc) {
            __builtin_amdgcn_fence(__ATOMIC_RELEASE, "agent");
            asm volatile("s_waitcnt vmcnt(0)" ::: "memory");
            const unsigned og = xb_add(&bar[XB_TOP], 1u);
            const unsigned tg = og / nx;
            if (og + 1u == (tg + 1u) * nx) xb_add(&bar[XB_TOPGEN], 1u);
            else XB_SPIN(xb_ld(&bar[XB_TOPGEN]) == tg, bar);
            __builtin_amdgcn_fence(__ATOMIC_ACQUIRE, "agent");
            xb_add(&bar[XB_XGEN(b.x)], 1u);
            asm volatile("s_waitcnt vmcnt(0)" ::: "memory");
        } else {
            XB_SPIN(xb_ld(&bar[XB_XGEN(b.x)]) == gen, bar);
            __builtin_amdgcn_fence(__ATOMIC_ACQUIRE, "agent");
            asm volatile("s_waitcnt vmcnt(0)" ::: "memory");
        }
    }
    __syncthreads();
}
constexpr size_t MiB = 1u << 20;
constexpr size_t al4k(size_t x) { return (x + 4095) & ~(size_t)4095; }
constexpr int NFT = 260;
constexpr int XS_TILES = 268, HS_TILES = 140, MOE_CHUNK0 = 128;
constexpr size_t WS_CTL = 0, CTL_BYTES = 1 * MiB;
constexpr size_t WS_MODS = WS_CTL + CTL_BYTES;
constexpr size_t WS_ROPEC = WS_MODS + al4k((size_t)DEPTH * 3 * 6 * D * 4);
constexpr size_t WS_ROPES = WS_ROPEC + al4k((size_t)SEQ * 16 * 4);
constexpr size_t WS_RSQ = WS_ROPES + al4k((size_t)SEQ * 16 * 4);
constexpr size_t WS_RSKV = WS_RSQ + al4k((size_t)MT * 4);
constexpr size_t WS_FPART = WS_RSKV + al4k((size_t)MT * 4);
constexpr size_t WS_TOKE = WS_FPART + al4k((size_t)NFT * 512 * 4);
constexpr size_t WS_TOKP = WS_TOKE + al4k((size_t)MT * 4);
constexpr size_t WS_TOKG = WS_TOKP + al4k((size_t)MT * 8);
constexpr size_t WS_XC = WS_TOKG + al4k((size_t)MT * 8);
constexpr size_t WS_WIN = WS_XC + al4k((size_t)NCTX * D * 4);
constexpr size_t WS_WUQ = WS_WIN + al4k((size_t)DEPTH * UW * D * 2);
constexpr size_t WS_WUKV = WS_WUQ + al4k((size_t)DEPTH * 768 * 384 * 2);
constexpr size_t WS_WPOOL = WS_WUKV + al4k((size_t)DEPTH * 1024 * 256 * 2);
constexpr size_t WS_WOUT = WS_WPOOL + al4k((size_t)DEPTH * 256 * 256 * 2);
constexpr size_t WS_WGU = WS_WOUT + al4k((size_t)DEPTH * D * D * 2);
constexpr size_t WS_WD = WS_WGU + al4k((size_t)2 * 2 * FF * D * 2);
constexpr size_t WS_MGU = WS_WD + al4k((size_t)2 * D * FF * 2);
constexpr size_t WS_MD = WS_MGU + al4k((size_t)2 * NEXP * 2 * FF * D * 2);
constexpr size_t WS_HF = WS_MD + al4k((size_t)2 * NEXP * D * FF * 2);
constexpr size_t WS_HFC = WS_HF + al4k((size_t)512 * SEQ * 4);
constexpr size_t WS_HN = WS_HFC + al4k((size_t)512 * CTXL * 4);
constexpr size_t WS_U = WS_HN + al4k((size_t)MT * D * 2);
constexpr size_t WS_DP = WS_U + al4k((size_t)MT * UW * 2);
constexpr size_t WS_Q = WS_DP + al4k((size_t)MT * 256 * 2);
constexpr size_t WS_KV = WS_Q + al4k((size_t)MT * 768 * 2);
constexpr size_t WS_MIX = WS_KV + al4k((size_t)NB * NHEAD * NKEY * KVW * 2);
constexpr size_t WS_ZT = WS_MIX + al4k((size_t)MT * D * 2);
constexpr size_t WS_ZCT = WS_ZT + al4k((size_t)NB * 256 * SEQ * 4);
constexpr size_t WS_YT = WS_ZCT + al4k((size_t)NB * 256 * CTXL * 4);
constexpr size_t WS_SLAB = WS_YT + al4k((size_t)NB * 256 * SEQ * 4);
constexpr size_t WS_END = WS_SLAB + al4k((size_t)4 * NCTX * D * 4);
constexpr size_t WS_H = WS_U;
constexpr size_t WS_XS = WS_U;
constexpr size_t WS_HS = WS_XS + al4k((size_t)XS_TILES * 256 * D * 2);
static_assert(WS_H + (size_t)MT * FF * 2 <= WS_KV + (size_t)NB * NHEAD * NKEY * KVW * 2, "dense hidden overlay");
static_assert(WS_HS + (size_t)HS_TILES * 256 * FF * 2 <= WS_END, "MoE overlay");
constexpr int CW_TMO = 0, CW_BAR = 4096, CW_GCNT = 16384;
constexpr int RING_BYTES = 131072, MISC_OFF = RING_BYTES + 320, LDS_BYTES = 147456;

struct Args { const float* in[34]; float* out; unsigned char* ws; int ph_lo, ph_hi; };
enum { I_X = 0, I_C, I_CTX, I_CCTX, I_N1G, I_N2G, I_WADA, I_BADA, I_WIN, I_HSW, I_HSB, I_FW1, I_FB1, I_FF1, I_FW2, I_FB2, I_FF2, I_FW3, I_HBIAS, I_POOLW, I_POOLS, I_QNG, I_WUQ, I_KVNG, I_WUKV,
       I_WOUT, I_FWG, I_FWU, I_FWD, I_ROUTER, I_MWG, I_MWU, I_MWD, I_FING };

struct Ctx {
    float* out; unsigned char* ws; LAS unsigned char* lds; volatile LAS unsigned* MISC;
    __device__ __forceinline__ const float* in(int k) const { const __attribute__((address_space(4))) Args* a = (const __attribute__((address_space(4))) Args*)__builtin_amdgcn_kernarg_segment_ptr();
        asm volatile("" : "+s"(a)); return (const float*)(const GAS float*)a->in[k]; }
    int tid, lane, wave, vcu, G;
    template <typename T> __device__ __forceinline__ T* p(size_t off) const { return (T*)(ws + off); }
};

template <int XM> __device__ __forceinline__ float swz_xor(float v) { return __builtin_bit_cast(float, __builtin_amdgcn_ds_swizzle(__builtin_bit_cast(int, v), (XM << 10) | 0x1f)); }
__device__ __forceinline__ float wave_sum(float v) {
    v += swz_xor<1>(v); v += swz_xor<2>(v); v += swz_xor<4>(v); v += swz_xor<8>(v); v += swz_xor<16>(v);
    { auto rr = __builtin_amdgcn_permlane32_swap(__float_as_uint(v), __float_as_uint(v), false, false); v = __uint_as_float(rr[0]) + __uint_as_float(rr[1]); }
    return v;
}
__device__ __forceinline__ float sin_turns(float x) { return __builtin_amdgcn_sinf(x); }
__device__ __forceinline__ float cos_turns(float x) { return __builtin_amdgcn_cosf(x); }
constexpr float INV_2PI = 0.15915494309189535f;
__device__ __forceinline__ float bf2f(unsigned short h) { return __uint_as_float((unsigned)h << 16); }
__device__ __forceinline__ void unpack8(const v4u w, float (&f)[8]) {
    f[0] = __uint_as_float(w.x << 16); f[1] = __uint_as_float(w.x & 0xffff0000u); f[2] = __uint_as_float(w.y << 16); f[3] = __uint_as_float(w.y & 0xffff0000u);
    f[4] = __uint_as_float(w.z << 16); f[5] = __uint_as_float(w.z & 0xffff0000u); f[6] = __uint_as_float(w.w << 16); f[7] = __uint_as_float(w.w & 0xffff0000u);
}
__device__ __forceinline__ v4u pack8f(const float (&f)[8]) { v4u o; o.x = pk2(f[0], f[1]); o.y = pk2(f[2], f[3]); o.z = pk2(f[4], f[5]); o.w = pk2(f[6], f[7]); return o; }

__device__ __forceinline__ int maprow(int mode, int n) {
    if (mode == 1) return 256 * (n >> 7) + (n & 127);
    if (mode == 2) return 256 * (n >> 7) + 128 + (n & 127);
    if (mode == 3) { const int h = n / DQK, d = n % DQK; if (d < 64) return n; const int r = d - 64, j = r & 15, g = j >> 2, i = j & 3; return h * DQK + 64 + 8 * g + (r < 16 ? 0 : 4) + i; }
    if (mode == 4) { const int d = n & 127; if (d < 64) return n; const int c = d - 64; return (n & ~127) + 64 + (c & 1) * 32 + (c >> 1); }
    return n;
}
__device__ __forceinline__ void transpose_item(const float* W, int K, int N, bf16* WT, int mode, const float* kscale, LAS float* scr, int item, int lane) {
    const int nblk = N / 32, kb = item / nblk, nb = item % nblk, k0 = 64 * kb, n0 = 32 * nb;
    float wv[32];
#pragma unroll
    for (int i = 0; i < 32; ++i) { const int kk = 2 * i + (lane >> 5); wv[i] = __builtin_nontemporal_load(W + (size_t)(k0 + kk) * N + n0 + (lane & 31)); }
#pragma unroll
    for (int i = 0; i < 32; ++i) { const int kk = 2 * i + (lane >> 5); float v = wv[i]; if (kscale) v *= kscale[k0 + kk]; scr[kk * 33 + (lane & 31)] = v; }
    LDS_WAIT(); asm volatile("" ::: "memory");
    const int c = lane & 7;
#pragma unroll
    for (int j = 0; j < 4; ++j) { const int n = (lane >> 3) + 8 * j; const LAS float* s = scr + (8 * c) * 33 + n;
        v4u o; o.x = pk2(s[0 * 33], s[1 * 33]); o.y = pk2(s[2 * 33], s[3 * 33]); o.z = pk2(s[4 * 33], s[5 * 33]); o.w = pk2(s[6 * 33], s[7 * 33]);
        *(GAS v4u*)(WT + (size_t)maprow(mode, n0 + n) * K + k0 + 8 * c) = o; }
    LDS_WAIT(); asm volatile("" ::: "memory");
}
struct Cat { int count, per; const float* src; size_t sstride; int K, N; bf16* dst; size_t dstride; int mode; const float* ks; int kstride; };
struct ItemD { const float* W; bf16* WT; const float* ks; int K, N, mode, k0, n0; };
__device__ __forceinline__ void ti_load(const ItemD& d, float (&wv)[32], int lane) {
#pragma unroll
    for (int i = 0; i < 32; ++i) { const int kk = 2 * i + (lane >> 5); wv[i] = __builtin_nontemporal_load(d.W + (size_t)(d.k0 + kk) * d.N + d.n0 + (lane & 31)); }
}
__device__ __forceinline__ void ti_store(const ItemD& d, const float (&wv)[32], LAS float* scr, int lane) {
#pragma unroll
    for (int i = 0; i < 32; ++i) { const int kk = 2 * i + (lane >> 5); float v = wv[i]; if (d.ks) v *= d.ks[d.k0 + kk]; scr[kk * 33 + (lane & 31)] = v; }
    LDS_WAIT(); asm volatile("" ::: "memory");
    const int c = lane & 7;
#pragma unroll
    for (int j = 0; j < 4; ++j) { const int n = (lane >> 3) + 8 * j; const LAS float* s = scr + (8 * c) * 33 + n;
        v4u o; o.x = pk2(s[0 * 33], s[1 * 33]); o.y = pk2(s[2 * 33], s[3 * 33]); o.z = pk2(s[4 * 33], s[5 * 33]); o.w = pk2(s[6 * 33], s[7 * 33]);
        *(GAS v4u*)(d.WT + (size_t)maprow(d.mode, d.n0 + n) * d.K + d.k0 + 8 * c) = o; }
    LDS_WAIT(); asm volatile("" ::: "memory");
}
template <int CLO, int CHI> __device__ __forceinline__ void item_resolve(const Cat (&cats)[11], int it, ItemD& d) {
    int r = it;
#pragma unroll
    for (int k = CLO; k < CHI; ++k) { const int n = cats[k].count * cats[k].per;
        if (r >= 0 && r < n) { const int mi = r / cats[k].per, item = r % cats[k].per; const int nblk = cats[k].N / 32;
            d.W = cats[k].src + mi * cats[k].sstride; d.WT = cats[k].dst + mi * cats[k].dstride; d.ks = cats[k].ks ? cats[k].ks + mi * cats[k].kstride : nullptr;
            d.K = cats[k].K; d.N = cats[k].N; d.mode = cats[k].mode; d.k0 = 64 * (item / nblk); d.n0 = 32 * (item % nblk); }
        r -= n; }
}
template <int CLO, int CHI> __device__ __forceinline__ void convert_cats(const Ctx& F, int gw, int NGW, int lane) {
    LAS float* scr = (LAS float*)(F.lds + F.wave * 16384);
    const Cat cats[11] = {
        {DEPTH, 16 * 53, F.in(I_WIN), (size_t)D * 1696, D, 1696, F.p<bf16>(WS_WIN), (size_t)UW * D, 0, nullptr, 0},
        {DEPTH, 6 * 24, F.in(I_WUQ), (size_t)384 * 768, 384, 768, F.p<bf16>(WS_WUQ), (size_t)768 * 384, 3, F.in(I_QNG), 384},
        {DEPTH, 4 * 32, F.in(I_WUKV), (size_t)256 * 1024, 256, 1024, F.p<bf16>(WS_WUKV), (size_t)1024 * 256, 4, F.in(I_KVNG), 256},
        {DEPTH, 16 * 32, F.in(I_WOUT), (size_t)D * D, D, D, F.p<bf16>(WS_WOUT), (size_t)D * D, 0, nullptr, 0},
        {2, 16 * 88, F.in(I_FWG), (size_t)D * FF, D, FF, F.p<bf16>(WS_WGU), (size_t)2 * FF * D, 1, nullptr, 0},
        {2, 16 * 88, F.in(I_FWU), (size_t)D * FF, D, FF, F.p<bf16>(WS_WGU), (size_t)2 * FF * D, 2, nullptr, 0},
        {2, 44 * 32, F.in(I_FWD), (size_t)FF * D, FF, D, F.p<bf16>(WS_WD), (size_t)D * FF, 0, nullptr, 0},
        {2 * NEXP, 16 * 88, F.in(I_MWG), (size_t)D * FF, D, FF, F.p<bf16>(WS_MGU), (size_t)2 * FF * D, 1, nullptr, 0},
        {2 * NEXP, 16 * 88, F.in(I_MWU), (size_t)D * FF, D, FF, F.p<bf16>(WS_MGU), (size_t)2 * FF * D, 2, nullptr, 0},
        {2 * NEXP, 44 * 32, F.in(I_MWD), (size_t)FF * D, FF, D, F.p<bf16>(WS_MD), (size_t)D * FF, 0, nullptr, 0},
        {0, 1, nullptr, 0, 0, 0, nullptr, 0, 0, nullptr, 0}};
    int total = 0;
#pragma unroll
    for (int k = CLO; k < CHI; ++k) total += cats[k].count * cats[k].per;
    int it = 2 * gw; ItemD dA, dB, dC, dD; float wA[32], wB[32], wC[32], wD[32]; bool hA, hC;
#define CV_LD(X, Y) do { h##X = it < total; if (h##X) { item_resolve<CLO, CHI>(cats, it, d##X); ti_load(d##X, w##X, lane); item_resolve<CLO, CHI>(cats, it + 1, d##Y); ti_load(d##Y, w##Y, lane); } it += 2 * NGW; } while (0)
    CV_LD(A, B); CV_LD(C, D);
    while (hA) {
        ti_store(dA, wA, scr, lane); ti_store(dB, wB, scr, lane); CV_LD(A, B); if (!hC) break;
        ti_store(dC, wC, scr, lane); ti_store(dD, wD, scr, lane); CV_LD(C, D);
    }
#undef CV_LD
}
__device__ __forceinline__ void p0_prologue(const Ctx& F) {
    convert_cats<0, 3>(F, F.vcu * 8 + F.wave, F.G * 8, F.lane);
    const int gt = F.vcu * 512 + F.tid, NGT = F.G * 512;
    for (int i = gt; i < DEPTH * 96 * (D / 8); i += NGT) { const int l = i / (96 * (D / 8)), r = i % (96 * (D / 8)); *(GAS v4u*)(F.p<bf16>(WS_WIN) + ((size_t)l * UW + 1696) * D + (size_t)r * 8) = (v4u){0u, 0u, 0u, 0u}; }
    { const float* poolw = F.in(I_POOLW);
    for (int i = gt; i < DEPTH * 256 * 256; i += NGT) { const int l = i >> 16, n = (i >> 8) & 255, k = i & 255, g = n >> 6;
        const float v = (k >> 6) == g ? poolw[(((size_t)l * 4 + g) * 64 + (k & 63)) * 64 + (n & 63)] : 0.f; F.p<bf16>(WS_WPOOL)[i] = (bf16)f2bf(v); } }
    for (int i = gt; i < SEQ * 16; i += NGT) { const int t = i >> 4, j = i & 15; const int pos = j < 8 ? (t >> 6) : (t & 63);
        const float invf[8] = {1.0f, 0.31622776601683794f, 0.1f, 0.031622776601683791f, 0.01f, 0.0031622776601683794f, 0.001f, 0.00031622776601683794f};
        const float ang = (float)pos * invf[j & 7];
        const double tr = (double)ang * 0.15915494309189535; const float fr = (float)(tr - __builtin_floor(tr));
        F.p<float>(WS_ROPEC)[i] = cos_turns(fr); F.p<float>(WS_ROPES)[i] = sin_turns(fr); }
    { const GAS f32x4* s2 = (const GAS f32x4*)F.in(I_CTX); GAS f32x4* d2 = (GAS f32x4*)F.p<float>(WS_XC); for (int i = gt; i < NCTX * D / 4; i += NGT) d2[i] = s2[i]; }
    __syncthreads();
    LAS float* red = (LAS float*)F.lds;
    const float* cvec = F.in(I_C); const float* cctx = F.in(I_CCTX); const float* wada = F.in(I_WADA); const float* bada = F.in(I_BADA);
    LAS float* sl = (LAS float*)(F.lds + 8192);
    for (int i = F.tid; i < 3 * D; i += 512) { const float c0 = i < 2 * D ? cvec[i] : cctx[i - 2 * D]; sl[i] = c0 * __builtin_amdgcn_rcpf(1.f + __expf(-c0)); }
    __syncthreads();
    for (int it = F.vcu; it < DEPTH * 96; it += F.G) {
        const int l = it / 96, n = (it % 96) * 64 + F.lane; const float* W = wada + (size_t)l * D * 6 * D + n;
        float a0 = 0.f, a1 = 0.f, a2 = 0.f;
#pragma unroll 1
        for (int kb = 0; kb < 128; kb += 32) {
            float wv[32];
#pragma unroll
            for (int j = 0; j < 32; ++j) wv[j] = __builtin_nontemporal_load(W + (size_t)(F.wave * 128 + kb + j) * 6 * D);
#pragma unroll
            for (int j = 0; j < 32; ++j) { const int k = F.wave * 128 + kb + j; a0 += wv[j] * sl[k]; a1 += wv[j] * sl[D + k]; a2 += wv[j] * sl[2 * D + k]; }
        }
        red[(F.wave * 3 + 0) * 64 + F.lane] = a0; red[(F.wave * 3 + 1) * 64 + F.lane] = a1; red[(F.wave * 3 + 2) * 64 + F.lane] = a2;
        __syncthreads();
        if (F.tid < 192) { const int v = F.tid >> 6, ln = F.tid & 63; float s = 0.f;
#pragma unroll
            for (int w = 0; w < 8; ++w) s += red[(w * 3 + v) * 64 + ln];
            const int nn = (it % 96) * 64 + ln; F.p<float>(WS_MODS)[((size_t)l * 3 + v) * 6 * D + nn] = s + bada[(size_t)l * 6 * D + nn]; }
        __syncthreads();
    }
}

__device__ __forceinline__ void filter_tile(const Ctx& F, int l, int tile) {
    LAS float* feat = (LAS float*)F.lds;
    LAS float* h1 = feat + 64 * 33;
    constexpr int H2P = 65;
    LAS float* h2 = h1 + 64 * 64;
    const bool lat = tile < 256; const int L = lat ? SEQ : CTXL; const int p0 = (lat ? tile : tile - 256) * 64;
    const float invLm1 = 1.0f / (float)(L - 1), invL = 1.0f / (float)L;
    for (int idx = F.tid; idx < 64 * 33; idx += 512) { const int p = idx / 33, k = idx % 33; const float pos = (float)(p0 + p);
        float v;
        if (k == 0) v = pos * invLm1;
        else { const int j = (k - 1) & 15; const float fj = 1e-4f + (float)j * ((15.0f - 1e-4f) / 15.0f); const float x = fj * pos * invL; const float fr = x - __builtin_floorf(x);
            v = k <= 16 ? cos_turns(fr) : -sin_turns(fr); }
        feat[idx] = v; }
    __syncthreads();
    { const int j = F.tid & 63, pg = F.tid >> 6; const float* w1 = F.in(I_FW1) + (size_t)l * 33 * 64 + j; float w[33];
#pragma unroll
      for (int k = 0; k < 33; ++k) w[k] = w1[k * 64];
      const float b = F.in(I_FB1)[l * 64 + j], fq = F.in(I_FF1)[l * 64 + j];
#pragma unroll 1
      for (int pp = 0; pp < 8; ++pp) { const int p = pg * 8 + pp; float a = b;
#pragma unroll
          for (int k = 0; k < 33; ++k) a += feat[p * 33 + k] * w[k];
          const float x = fq * a * INV_2PI; h1[p * 64 + j] = sin_turns(x - __builtin_floorf(x)); } }
    __syncthreads();
    { const int j = F.tid & 63, pg = F.tid >> 6; const float* w2 = F.in(I_FW2) + (size_t)l * 64 * 64 + j; float w[64];
#pragma unroll
      for (int k = 0; k < 64; ++k) w[k] = w2[k * 64];
      const float b = F.in(I_FB2)[l * 64 + j], fq = F.in(I_FF2)[l * 64 + j];
#pragma unroll 1
      for (int pp = 0; pp < 8; ++pp) { const int p = pg * 8 + pp; float a = b;
#pragma unroll
          for (int k = 0; k < 64; ++k) a += h1[p * 64 + k] * w[k];
          const float x = fq * a * INV_2PI; h2[p * H2P + j] = sin_turns(x - __builtin_floorf(x)); } }
    __syncthreads();
    {
      typedef float f32x16v __attribute__((ext_vector_type(16)));
      const int r32 = F.lane & 31, hi = F.lane >> 5;
      const float* w3 = F.in(I_FW3) + (size_t)l * 64 * 512 + F.wave * 64 + r32 + hi * 512;
      const LAS float* ha = h2 + r32 * H2P + hi;
      f32x16v acc[2][2] = {};
      float wb0[32], wb1[32];
#pragma unroll
      for (int s2 = 0; s2 < 32; ++s2) { wb0[s2] = w3[(size_t)(2 * s2) * 512]; wb1[s2] = w3[(size_t)(2 * s2) * 512 + 32]; }
#pragma unroll
      for (int s2 = 0; s2 < 32; ++s2) {
          const float a0 = ha[2 * s2], a1 = ha[32 * H2P + 2 * s2], b0 = wb0[s2], b1 = wb1[s2];
          acc[0][0] = __builtin_amdgcn_mfma_f32_32x32x2f32(a0, b0, acc[0][0], 0, 0, 0); acc[0][1] = __builtin_amdgcn_mfma_f32_32x32x2f32(a0, b1, acc[0][1], 0, 0, 0);
          acc[1][0] = __builtin_amdgcn_mfma_f32_32x32x2f32(a1, b0, acc[1][0], 0, 0, 0); acc[1][1] = __builtin_amdgcn_mfma_f32_32x32x2f32(a1, b1, acc[1][1], 0, 0, 0); }
      LAS float* T = h2 + 64 * H2P;
      float* dst = lat ? F.p<float>(WS_HF) + p0 : F.p<float>(WS_HFC) + p0; const int pitch = lat ? SEQ : CTXL;
      float asum[2] = {0.f, 0.f};
#pragma unroll
      for (int pb = 0; pb < 2; ++pb) {
#pragma unroll
          for (int cb = 0; cb < 2; ++cb) { const int n = F.wave * 64 + 32 * cb + r32, c = n & 255; const float dl = 3.0701134573253946f + (float)c * ((15.350567286626973f - 3.0701134573253946f) / 255.0f);
#pragma unroll
              for (int r = 0; r < 16; ++r) { const int pq = (r & 3) + 8 * (r >> 2) + 4 * hi, p = 32 * pb + pq; const float tt = (float)(p0 + p) * invLm1; const float v = acc[pb][cb][r] * __expf(-tt * dl);
                  T[n * 33 + pq] = v; if (!(n >= 256 && p0 + p == 0)) asum[cb] += __builtin_fabsf(v); } }
          __syncthreads();
#pragma unroll 4
          for (int i = 0; i < 32; ++i) { const int row = F.wave * 64 + 2 * i + (F.lane >> 5), pl = F.lane & 31; dst[(size_t)row * pitch + pb * 32 + pl] = T[row * 33 + pl]; }
          __syncthreads(); }
#pragma unroll
      for (int cb = 0; cb < 2; ++cb) { auto rr = __builtin_amdgcn_permlane32_swap(__float_as_uint(asum[cb]), __float_as_uint(asum[cb]), false, false); const float tot = __uint_as_float(rr[0]) + __uint_as_float(rr[1]);
          if (hi == 0) F.p<float>(WS_FPART)[(size_t)tile * 512 + F.wave * 64 + 32 * cb + r32] = tot; } }
    __syncthreads();
}

template <int WHICH, bool COMBINE, bool ROUTE, bool FROM_INPUT = false, int NSLAB = 0  >
__device__ __forceinline__ void norm_phase(const Ctx& F, int l, int lprev  , int moe_idx  ) {
    const float* xin = FROM_INPUT ? F.in(I_X) : nullptr;
    const int gw = F.vcu * 8 + F.wave, NGW = F.G * 8;
    const float* gain = WHICH == 0 ? F.in(I_N1G) + l * D : WHICH == 1 ? F.in(I_N2G) + l * D : F.in(I_FING);
    const float* mods = F.p<float>(WS_MODS) + (size_t)l * 3 * 6 * D;
    const float* modp = F.p<float>(WS_MODS) + (size_t)lprev * 3 * 6 * D + 5 * D;
    const int rows = WHICH == 2 ? LAT : MT;
    LAS float* wr_l = (LAS float*)F.lds;
    LAS int* lcnt = (LAS int*)(F.lds + 32768);
    LAS int* rec = (LAS int*)(F.lds + 32768 + 64);
    if (ROUTE) {
        const float* wr = F.in(I_ROUTER) + (size_t)moe_idx * D * NEXP;
        for (int i = F.tid; i < D * NEXP / 4; i += 512) ((LAS f32x4*)wr_l)[i] = ((const f32x4*)wr)[i];
        if (F.tid < 16) lcnt[F.tid] = 0;
        __syncthreads();
    }
    int ri = 0;
    int nd0 = 0, nd1 = 0; float ng0 = 0.f, ng1 = 0.f;
    if (COMBINE && gw < rows) { nd0 = F.p<int>(WS_TOKP)[2 * gw]; nd1 = F.p<int>(WS_TOKP)[2 * gw + 1]; ng0 = F.p<float>(WS_TOKG)[2 * gw]; ng1 = F.p<float>(WS_TOKG)[2 * gw + 1]; }
    f32x4 vn[4];
    const bf16* xbf = (const bf16*)F.out;
#define NRM_LOAD(r) do { const int r_ = (r); if ((FROM_INPUT && r_ < LAT) || r_ >= LAT) { const float* xs_ = (FROM_INPUT && r_ < LAT) ? xin + (size_t)r_ * D : F.p<float>(WS_XC) + (size_t)(r_ - LAT) * D; \
        _Pragma("unroll") for (int j = 0; j < 4; ++j) vn[j] = ((const GAS f32x4*)xs_)[F.lane + 64 * j]; } \
      else { const bf16* xs_ = xbf + (size_t)r_ * (2 * D); \
        _Pragma("unroll") for (int j = 0; j < 4; ++j) { const v2u w_ = ((const GAS v2u*)xs_)[F.lane + 64 * j]; vn[j] = (f32x4){__uint_as_float(w_.x), __uint_as_float(w_.y), 0.f, 0.f}; } } } while (0)
#define NRM_UNPACK(r, V) do { const int r_ = (r); if (!((FROM_INPUT && r_ < LAT) || r_ >= LAT)) { _Pragma("unroll") for (int j = 0; j < 4; ++j) { const unsigned a_ = __float_as_uint(V[j].x), b_ = __float_as_uint(V[j].y); \
        V[j] = (f32x4){__uint_as_float(a_ << 16), __uint_as_float(a_ & 0xffff0000u), __uint_as_float(b_ << 16), __uint_as_float(b_ & 0xffff0000u)}; } } } while (0)
    if (gw < rows) NRM_LOAD(gw);
    for (int row = gw; row < rows; row += NGW, ++ri) {
        const int vsel = row < SEQ ? 0 : (row < LAT ? 1 : 2);
        float* xr = row < LAT ? F.out + (size_t)row * D : F.p<float>(WS_XC) + (size_t)(row - LAT) * D;
        bf16* xrb = (bf16*)F.out + (size_t)row * (2 * D);
        f32x4 v[4];
#pragma unroll
        for (int j = 0; j < 4; ++j) v[j] = vn[j];
        NRM_UNPACK(row, v);
        if (NSLAB > 0 && row >= LAT) { const float* sl = F.p<float>(WS_SLAB) + (size_t)(row - LAT) * D;
#pragma unroll
            for (int k = 0; k < NSLAB; ++k)
#pragma unroll
                for (int j = 0; j < 4; ++j) v[j] = v[j] + ((const GAS f32x4*)(sl + (size_t)k * NCTX * D))[F.lane + 64 * j];
#pragma unroll
            for (int j = 0; j < 4; ++j) ((GAS f32x4*)xr)[F.lane + 64 * j] = v[j]; }
        if (COMBINE) {
            const int d0 = nd0, d1 = nd1; const float g0 = ng0, g1 = ng1;
            if (row + NGW < rows) { const int rn = row + NGW; nd0 = F.p<int>(WS_TOKP)[2 * rn]; nd1 = F.p<int>(WS_TOKP)[2 * rn + 1]; ng0 = F.p<float>(WS_TOKG)[2 * rn]; ng1 = F.p<float>(WS_TOKG)[2 * rn + 1]; }
            const bf16* y0 = F.p<bf16>(WS_XS) + (size_t)d0 * D, *y1 = F.p<bf16>(WS_XS) + (size_t)d1 * D;
#pragma unroll
            for (int j = 0; j < 4; ++j) { const int col = 4 * F.lane + 256 * j; const uint2 a = *(const uint2*)(y0 + col), b = *(const uint2*)(y1 + col); const f32x4 m5 = *(const f32x4*)(modp + vsel * 6 * D + col);
                f32x4 ya = {__uint_as_float(a.x << 16), __uint_as_float(a.x & 0xffff0000u), __uint_as_float(a.y << 16), __uint_as_float(a.y & 0xffff0000u)};
                f32x4 yb = {__uint_as_float(b.x << 16), __uint_as_float(b.x & 0xffff0000u), __uint_as_float(b.y << 16), __uint_as_float(b.y & 0xffff0000u)};
                v[j] = v[j] + m5 * (ya * g0 + yb * g1);
                if (WHICH != 2) { if (row < LAT) ((GAS v2u*)xrb)[F.lane + 64 * j] = (v2u){pk2(v[j].x, v[j].y), pk2(v[j].z, v[j].w)}; else ((GAS f32x4*)xr)[F.lane + 64 * j] = v[j]; } }
        }
        float s = 0.f;
#pragma unroll
        for (int j = 0; j < 4; ++j) s += (v[j].x * v[j].x + v[j].y * v[j].y) + (v[j].z * v[j].z + v[j].w * v[j].w);
        const float* sh = mods + vsel * 6 * D + (WHICH == 0 ? 0 : 3) * D; const float* sc = sh + D;
        f32x4 gv[4], av[4], bv[4];
#pragma unroll
        for (int j = 0; j < 4; ++j) { const int col = 4 * F.lane + 256 * j; gv[j] = *(const f32x4*)(gain + col); if (WHICH != 2) { av[j] = *(const f32x4*)(sh + col); bv[j] = *(const f32x4*)(sc + col); } }
        asm volatile("" ::: "memory");
        if (row + NGW < rows) NRM_LOAD(row + NGW);
        asm volatile("" ::: "memory");
        const float rstd = 1.0f / sqrtf(wave_sum(s) * (1.0f / D) + 1e-6f);
        if (WHICH == 2) {
#pragma unroll
            for (int j = 0; j < 4; ++j) { const f32x4 g = gv[j]; ((GAS f32x4*)xr)[F.lane + 64 * j] = v[j] * rstd * g; }
        } else {
            bf16* hn = F.p<bf16>(WS_HN) + (size_t)row * D;
            float lg[8] = {0.f, 0.f, 0.f, 0.f, 0.f, 0.f, 0.f, 0.f};
#pragma unroll
            for (int j = 0; j < 4; ++j) { const int col = 4 * F.lane + 256 * j; const f32x4 g = gv[j], a = av[j], b = bv[j];
                const f32x4 h = v[j] * rstd * g * (b + 1.0f) + a;
                *(uint2*)(hn + col) = make_uint2(pk2(h.x, h.y), pk2(h.z, h.w));
                if (ROUTE) {
#pragma unroll
                    for (int q = 0; q < 4; ++q) { const f32x4 w0 = *(const LAS f32x4*)(wr_l + (col + q) * 8), w1 = *(const LAS f32x4*)(wr_l + (col + q) * 8 + 4);
                        lg[0] += h[q] * w0.x; lg[1] += h[q] * w0.y; lg[2] += h[q] * w0.z; lg[3] += h[q] * w0.w; lg[4] += h[q] * w1.x; lg[5] += h[q] * w1.y; lg[6] += h[q] * w1.z; lg[7] += h[q] * w1.w; } } }
            if (ROUTE) {
#pragma unroll
                for (int e = 0; e < 8; ++e) lg[e] = wave_sum(lg[e]);
                int e0 = 0; float v0 = lg[0];
#pragma unroll
                for (int e = 1; e < 8; ++e) if (lg[e] > v0) { v0 = lg[e]; e0 = e; }
                int e1 = -1; float v1 = -3.0e38f;
#pragma unroll
                for (int e = 0; e < 8; ++e) if (e != e0 && lg[e] > v1) { v1 = lg[e]; e1 = e; }
                const float g1 = 1.0f / (1.0f + __expf(v0 - v1)), g0 = 1.0f - g1;
                if (F.lane == 0) { const int p0 = __hip_atomic_fetch_add(lcnt + e0, 1, __ATOMIC_RELAXED, __HIP_MEMORY_SCOPE_WORKGROUP), p1 = __hip_atomic_fetch_add(lcnt + e1, 1, __ATOMIC_RELAXED, __HIP_MEMORY_SCOPE_WORKGROUP);
                    LAS int* rc = rec + (F.wave * 20 + ri) * 3; rc[0] = e0 | (e1 << 8); rc[1] = p0; rc[2] = p1;
                    F.p<float>(WS_TOKG)[2 * row] = g0; F.p<float>(WS_TOKG)[2 * row + 1] = g1; }
            }
        }
    }
    if (ROUTE) {
        __syncthreads();
        if (F.tid < 8) lcnt[8 + F.tid] = (int)__hip_atomic_fetch_add(F.p<unsigned>(WS_CTL) + CW_GCNT + 64 * (8 * moe_idx + F.tid), (unsigned)lcnt[F.tid], __ATOMIC_RELAXED, __HIP_MEMORY_SCOPE_AGENT);
        __syncthreads();
        if (F.lane == 0) { int k = 0; for (int row = gw; row < rows; row += NGW, ++k) { const LAS int* rc = rec + (F.wave * 20 + k) * 3; const int ee = rc[0], e0 = ee & 255, e1 = ee >> 8;
            F.p<int>(WS_TOKE)[row] = ee; F.p<int>(WS_TOKP)[2 * row] = lcnt[8 + e0] + rc[1]; F.p<int>(WS_TOKP)[2 * row + 1] = lcnt[8 + e1] + rc[2]; } }
        __syncthreads();
    }
}
__device__ __forceinline__ void moe_tile_starts(const Ctx& F, int moe_idx, int (&ts)[9]) {
    int acc = 0;
#pragma unroll
    for (int e = 0; e < 8; ++e) { ts[e] = acc; const unsigned c = (unsigned)__builtin_amdgcn_readfirstlane((int)__hip_atomic_load(F.p<unsigned>(WS_CTL) + CW_GCNT + 64 * (8 * moe_idx + e), __ATOMIC_RELAXED, __HIP_MEMORY_SCOPE_AGENT)); acc += (int)((c + 255u) >> 8); }
    ts[8] = acc;
}
__device__ __forceinline__ void moe_scatter(const Ctx& F, int moe_idx) {
    int ts[9]; moe_tile_starts(F, moe_idx, ts);
    const int gw = F.vcu * 8 + F.wave, NGW = F.G * 8;
    for (int row0 = gw; row0 < MT; row0 += 4 * NGW) {
        int ee[4], p0[4], p1[4]; bool ok[4];
#pragma unroll
        for (int q = 0; q < 4; ++q) { const int row = row0 + q * NGW; ok[q] = row < MT; const int r = ok[q] ? row : row0; ee[q] = F.p<int>(WS_TOKE)[r]; p0[q] = F.p<int>(WS_TOKP)[2 * r]; p1[q] = F.p<int>(WS_TOKP)[2 * r + 1]; }
        v4u a[4], b[4]; int d0[4], d1[4];
#pragma unroll
        for (int q = 0; q < 4; ++q) { const int row = ok[q] ? row0 + q * NGW : row0; const GAS v4u* src = (const GAS v4u*)(F.p<bf16>(WS_HN) + (size_t)row * D); a[q] = src[F.lane]; b[q] = src[64 + F.lane];
            const int e0 = ee[q] & 255, e1 = ee[q] >> 8; int s0 = 0, s1 = 0;
#pragma unroll
            for (int e = 0; e < 8; ++e) { s0 = e == e0 ? ts[e] : s0; s1 = e == e1 ? ts[e] : s1; }
            d0[q] = s0 * 256 + p0[q]; d1[q] = s1 * 256 + p1[q]; }
#pragma unroll
        for (int q = 0; q < 4; ++q) if (ok[q]) { const int row = row0 + q * NGW;
            GAS v4u* o0 = (GAS v4u*)(F.p<bf16>(WS_XS) + (size_t)d0[q] * D); GAS v4u* o1 = (GAS v4u*)(F.p<bf16>(WS_XS) + (size_t)d1[q] * D);
            o0[F.lane] = a[q]; o0[64 + F.lane] = b[q]; o1[F.lane] = a[q]; o1[64 + F.lane] = b[q];
            if (F.lane == 0) { F.p<int>(WS_TOKP)[2 * row] = d0[q]; F.p<int>(WS_TOKP)[2 * row + 1] = d1[q]; } }
    }
}
struct TileInfo { int r0, b, t0, L; bool lat; };
__device__ __forceinline__ TileInfo tile_info(int T) {
    TileInfo ti; ti.lat = T < 512;
    if (ti.lat) { ti.r0 = T * 64; ti.b = T >> 8; ti.t0 = (T & 255) * 64; ti.L = SEQ; }
    else { const int rc = (T - 512) * 64; ti.r0 = LAT + rc; ti.b = rc >> 8; ti.t0 = rc & 255; ti.L = CTXL; }
    return ti;
}
__device__ __forceinline__ void sconv8(const bf16* Urow0  , int t, int L, int col, const float* sw, const float* sb, float (&o)[8]) {
    float a[8], b[8], c[8];
    const v4u z = {0u, 0u, 0u, 0u};
    const v4u um = t > 0 ? *(const GAS v4u*)(Urow0 + (size_t)(t - 1) * UW + col) : z;
    const v4u u0 = *(const GAS v4u*)(Urow0 + (size_t)t * UW + col);
    const v4u up = t + 1 < L ? *(const GAS v4u*)(Urow0 + (size_t)(t + 1) * UW + col) : z;
    unpack8(um, a); unpack8(u0, b); unpack8(up, c);
    const f32x4 w0a = *(const f32x4*)(sw + col), w0b = *(const f32x4*)(sw + col + 4), w1a = *(const f32x4*)(sw + 768 + col), w1b = *(const f32x4*)(sw + 768 + col + 4),
                w2a = *(const f32x4*)(sw + 1536 + col), w2b = *(const f32x4*)(sw + 1536 + col + 4), ba = *(const f32x4*)(sb + col), bb = *(const f32x4*)(sb + col + 4);
#pragma unroll
    for (int i = 0; i < 4; ++i) { o[i] = a[i] * w0a[i] + b[i] * w1a[i] + c[i] * w2a[i] + ba[i]; o[4 + i] = a[4 + i] * w0b[i] + b[4 + i] * w1b[i] + c[4 + i] * w2b[i] + bb[i]; }
}
__device__ __forceinline__ void prep_item(const Ctx& F, const bf16* Us, int t, int L, int row, int j, const float* sw, const float* sb, float (&z)[8]) {
    float x1[8], vv[8]; sconv8(Us, t, L, C_HY + 256 + 8 * j, sw, sb, x1); sconv8(Us, t, L, C_HY + 512 + 8 * j, sw, sb, vv);
#pragma unroll
    for (int q = 0; q < 8; ++q) z[q] = x1[q] * vv[q];
}
template <int HALF> __device__ __forceinline__ void pool_item(const Ctx& F, const bf16* Us, int t, int L, int row, int col  , int dcol) {
    v4u w[2 * HALF];
#pragma unroll
    for (int k = 0; k < 2 * HALF; ++k) { int s = t - HALF + k; s = s < 0 ? 0 : (s >= L ? L - 1 : s); w[k] = *(const GAS v4u*)(Us + (size_t)s * UW + col); }
    float acc[8] = {0.f, 0.f, 0.f, 0.f, 0.f, 0.f, 0.f, 0.f}, pt[8];
#pragma unroll
    for (int k = 0; k < 2 * HALF; ++k) { const int s = t - HALF + k; const float m = (s >= 0 && s < L) ? 1.0f : 0.0f; float f[8]; unpack8(w[k], f);
#pragma unroll
        for (int q = 0; q < 8; ++q) acc[q] += m * f[q]; }
    unpack8(w[HALF], pt);
    const int lo = t - HALF < 0 ? 0 : t - HALF, hi = t + HALF > L ? L : t + HALF; const float inv = 1.0f / (float)(hi - lo);
#pragma unroll
    for (int q = 0; q < 8; ++q) acc[q] = acc[q] * inv - pt[q];
    *(GAS v4u*)(F.p<bf16>(WS_DP) + (size_t)row * 256 + dcol) = pack8f(acc);
}
__device__ __forceinline__ void pool_item_g(const Ctx& F, int g, const bf16* Us, int t, int L, int row, int chunk  ) {
    const int dcol = 64 * g + 8 * chunk, col = C_POOL + dcol;
    if (g == 0) pool_item<1>(F, Us, t, L, row, col, dcol); else if (g == 1) pool_item<2>(F, Us, t, L, row, col, dcol); else if (g == 2) pool_item<4>(F, Us, t, L, row, col, dcol); else pool_item<8>(F, Us, t, L, row, col, dcol);
}
__device__ __forceinline__ void prep_row(const Ctx& F, int row, int t, int b, bool lat) {
    const bf16* ur = F.p<bf16>(WS_U) + (size_t)row * UW;
    float sq = 0.f, skv = 0.f;
    if (F.lane < 48) { float f[8]; unpack8(*(const GAS v4u*)(ur + C_CQ + 8 * F.lane), f);
#pragma unroll
        for (int q = 0; q < 8; ++q) sq += f[q] * f[q]; }
    if (F.lane < 32) { float f[8]; unpack8(*(const GAS v4u*)(ur + C_CKV + 8 * F.lane), f);
#pragma unroll
        for (int q = 0; q < 8; ++q) skv += f[q] * f[q]; }
    sq = wave_sum(sq); skv = wave_sum(skv);
    if (F.lane == 0) { F.p<float>(WS_RSQ)[row] = 1.0f / sqrtf(sq * (1.0f / 384.0f) + 1e-6f); F.p<float>(WS_RSKV)[row] = 1.0f / sqrtf(skv * (1.0f / 256.0f) + 1e-6f); }
    if (F.lane < 16) { const int h = F.lane >> 1, i = F.lane & 1; float x1[8], x2[8];
        unpack8(*(const GAS v4u*)(ur + C_KPE + 8 * i), x1); unpack8(*(const GAS v4u*)(ur + C_KPE + 16 + 8 * i), x2);
        if (lat) { const float* cp = F.p<float>(WS_ROPEC) + t * 16 + 8 * i; const float* sp = F.p<float>(WS_ROPES) + t * 16 + 8 * i;
#pragma unroll
            for (int q = 0; q < 8; ++q) { const float c = cp[q], s = sp[q], a = x1[q] * c - x2[q] * s, bb = x1[q] * s + x2[q] * c; x1[q] = a; x2[q] = bb; } }
        const float o0[8] = {x1[0], x1[1], x1[2], x1[3], x2[0], x2[1], x2[2], x2[3]}, o1[8] = {x1[4], x1[5], x1[6], x1[7], x2[4], x2[5], x2[6], x2[7]};
        const int key = lat ? CTXL + t : t;
        bf16* dst = F.p<bf16>(WS_KV) + ((size_t)(b * NHEAD + h) * NKEY + key) * KVW + 64 + 16 * i;
        *(GAS v4u*)dst = pack8f(o0); *(GAS v4u*)(dst + 8) = pack8f(o1); }
}
__device__ __forceinline__ void prep_phase(const Ctx& F, int l) {
    LAS float* zs = (LAS float*)F.lds;
    const bf16* U = F.p<bf16>(WS_U);
    const float* sw = F.in(I_HSW) + (size_t)l * 3 * 768; const float* sb = F.in(I_HSB) + (size_t)l * 768;
    for (int T = F.vcu; T < LAT / 64; T += F.G) {
        const TileInfo ti = tile_info(T); const bf16* Us = U + (size_t)(ti.r0 - ti.t0) * UW;
#pragma unroll
        for (int i = 0; i < 4; ++i) { const int item = F.tid + 512 * i, tl = item >> 5, j = item & 31; float z[8];
            prep_item(F, Us, ti.t0 + tl, ti.L, ti.r0 + tl, j, sw, sb, z);
#pragma unroll
            for (int q = 0; q < 8; ++q) zs[tl * 257 + 8 * j + q] = z[q]; }
        { const int g = F.wave & 3, chunk = F.lane & 7;
#pragma unroll 1
          for (int i = 0; i < 4; ++i) { const int tl = 32 * (F.wave >> 2) + 8 * i + (F.lane >> 3); pool_item_g(F, g, Us, ti.t0 + tl, ti.L, ti.r0 + tl, chunk); } }
#pragma unroll 2
        for (int rr = 0; rr < 8; ++rr) { const int tl = F.wave * 8 + rr; prep_row(F, ti.r0 + tl, ti.t0 + tl, ti.b, true); }
        __syncthreads();
        { float* zt = F.p<float>(WS_ZT) + (size_t)ti.b * 256 * SEQ + ti.t0;
#pragma unroll 8
          for (int cc = 0; cc < 32; ++cc) { const int c = F.wave * 32 + cc; zt[(size_t)c * SEQ + F.lane] = zs[F.lane * 257 + c]; } }
        __syncthreads();
    }
    for (int P = F.vcu; P < NCTX / 2; P += F.G) {
        const int rc = 2 * P, b = rc >> 8, t0 = rc & (CTXL - 1); const bf16* Us = U + (size_t)(LAT + b * CTXL) * UW;
        if (F.wave == 0) { const int tl = F.lane >> 5, j = F.lane & 31, t = t0 + tl; float z[8];
            prep_item(F, Us, t, CTXL, LAT + rc + tl, j, sw, sb, z);
            float* zc = F.p<float>(WS_ZCT) + ((size_t)b * 256 + 8 * j) * CTXL + t;
#pragma unroll
            for (int q = 0; q < 8; ++q) zc[(size_t)q * CTXL] = z[q]; }
        else if (F.wave <= 2) { const int tl = F.wave - 1; prep_row(F, LAT + rc + tl, t0 + tl, b, false); }
        else if (F.wave == 3) { const int tl = F.lane >> 5, j = F.lane & 31; pool_item_g(F, j >> 3, Us, t0 + tl, CTXL, LAT + rc + tl, j & 7); }
    }
}
__device__ __forceinline__ void hyena_finalize(const Ctx& F, int l) {
    LAS float* ys = (LAS float*)F.lds;
    const bf16* U = F.p<bf16>(WS_U);
    const float* sw = F.in(I_HSW) + (size_t)l * 3 * 768; const float* sb = F.in(I_HSB) + (size_t)l * 768;
    for (int T = F.vcu; T < MT / 64; T += F.G) {
        const TileInfo ti = tile_info(T); const bf16* Us = U + (size_t)(ti.r0 - ti.t0) * UW;
        { const float* zt = ti.lat ? F.p<float>(WS_YT) + (size_t)ti.b * 256 * SEQ + ti.t0 : F.p<float>(WS_ZCT) + (size_t)ti.b * 256 * CTXL + ti.t0; const int pitch = ti.lat ? SEQ : CTXL;
#pragma unroll 8
          for (int cc = 0; cc < 32; ++cc) { const int c = F.wave * 32 + cc; ys[F.lane * 257 + c] = zt[(size_t)c * pitch + F.lane]; } }
        __syncthreads();
#pragma unroll
        for (int i = 0; i < 4; ++i) { const int item = F.tid + 512 * i, tl = item >> 5, j = item & 31, t = ti.t0 + tl;
            float x0[8]; sconv8(Us, t, ti.L, C_HY + 8 * j, sw, sb, x0);
#pragma unroll
            for (int q = 0; q < 8; ++q) x0[q] *= ys[tl * 257 + 8 * j + q];
            *(GAS v4u*)(F.p<bf16>(WS_MIX) + (size_t)(ti.r0 + tl) * D + 8 * j) = pack8f(x0); }
        __syncthreads();
    }
}

typedef float c32 __attribute__((ext_vector_type(2)));
__device__ __forceinline__ c32 cmul(c32 a, c32 b) { return (c32){a.x * b.x - a.y * b.y, a.x * b.y + a.y * b.x}; }
__device__ __forceinline__ c32 cis_turns(float x) { return (c32){cos_turns(x), sin_turns(x)}; }
constexpr int FN = SEQ;
template <int Q, bool INV> __device__ __forceinline__ void fft_stage(LAS c32* X, int tid) {
    asm volatile("" : "+v"(tid));
    constexpr float invLs = (INV ? 1.0f : -1.0f) / (float)(4 * Q);
#pragma unroll 4
    for (int it = 0; it < 8; ++it) { const int i = tid + 512 * it, j = i & (Q - 1), base = ((i - j) << 2) + j;
        c32 w1, w2, w3;
        if (Q > 1) { w1 = cis_turns((float)j * invLs); w2 = cmul(w1, w1); w3 = cmul(w2, w1); }
        if (!INV) {
            const c32 a0 = X[base], a1 = X[base + Q], a2 = X[base + 2 * Q], a3 = X[base + 3 * Q];
            const c32 t0 = a0 + a2, t1 = a0 - a2, t2 = a1 + a3, t3 = a1 - a3;
            const c32 b0 = t0 + t2, b2 = t0 - t2, b1 = (c32){t1.x + t3.y, t1.y - t3.x}, b3 = (c32){t1.x - t3.y, t1.y + t3.x};
            X[base] = b0;
            if (Q > 1) { X[base + Q] = cmul(b1, w1); X[base + 2 * Q] = cmul(b2, w2); X[base + 3 * Q] = cmul(b3, w3); } else { X[base + Q] = b1; X[base + 2 * Q] = b2; X[base + 3 * Q] = b3; }
        } else {
            c32 a0 = X[base], a1 = X[base + Q], a2 = X[base + 2 * Q], a3 = X[base + 3 * Q];
            if (Q > 1) { a1 = cmul(a1, w1); a2 = cmul(a2, w2); a3 = cmul(a3, w3); }
            const c32 t0 = a0 + a2, t1 = a0 - a2, t2 = a1 + a3, t3 = a1 - a3;
            X[base] = t0 + t2; X[base + 2 * Q] = t0 - t2; X[base + Q] = (c32){t1.x - t3.y, t1.y + t3.x}; X[base + 3 * Q] = (c32){t1.x + t3.y, t1.y - t3.x};
        } }
    __syncthreads();
}
__device__ __forceinline__ void fft_fwd(LAS c32* X, int tid) {
    fft_stage<4096, false>(X, tid); fft_stage<1024, false>(X, tid); fft_stage<256, false>(X, tid); fft_stage<64, false>(X, tid); fft_stage<16, false>(X, tid); fft_stage<4, false>(X, tid); fft_stage<1, false>(X, tid);
}
__device__ __forceinline__ void fft_inv(LAS c32* X, int tid) {
    fft_stage<1, true>(X, tid); fft_stage<4, true>(X, tid); fft_stage<16, true>(X, tid); fft_stage<64, true>(X, tid); fft_stage<256, true>(X, tid); fft_stage<1024, true>(X, tid); fft_stage<4096, true>(X, tid);
}
__device__ __forceinline__ void hyena_fft_channel(const Ctx& F, int l, int c) {
    LAS c32* X = (LAS c32*)F.lds; const int tid = F.tid;
    const float* hf = F.p<float>(WS_HF) + (size_t)c * SEQ + tid; const float* hb = F.p<float>(WS_HF) + (size_t)(256 + c) * SEQ + SEQ - tid;
    const float* z0 = F.p<float>(WS_ZT) + (size_t)c * SEQ + tid; const float* z1 = z0 + (size_t)256 * SEQ;
    float* y0 = F.p<float>(WS_YT) + (size_t)c * SEQ + tid; float* y1 = y0 + (size_t)256 * SEQ;
    float nrm = 0.f; { const float* fp = F.p<float>(WS_FPART);
#pragma unroll
        for (int k = 0; k < 4; ++k) { const int tile = F.lane + 64 * k; nrm += fp[(size_t)tile * 512 + c] + fp[(size_t)tile * 512 + 256 + c]; }
        nrm = wave_sum(nrm); }
    const float scale = 1.0f / (nrm * 2.0f * (float)FN); const float bias = F.in(I_HBIAS)[l * 256 + c];
    c32 G[32];
#pragma unroll 1
    for (int pass = 0; pass < 2; ++pass) {
        const float sgn = pass == 0 ? 1.0f : -1.0f; const float tw = pass == 0 ? 0.0f : -1.0f / 32768.0f;
#pragma unroll 1
        for (int kb = 0; kb < 32; kb += 8) { float fa[8], fb[8];
#pragma unroll
            for (int q = 0; q < 8; ++q) { fa[q] = hf[512 * (kb + q)]; fb[q] = hb[-512 * (kb + q)]; }
#pragma unroll
            for (int q = 0; q < 8; ++q) { const int n = tid + 512 * (kb + q); const float g = fa[q] + sgn * (n > 0 ? fb[q] : 0.f); X[n] = cis_turns((float)n * tw) * g; } }
        __syncthreads(); fft_fwd(X, tid);
#pragma unroll
        for (int k = 0; k < 32; ++k) G[k] = X[tid + 512 * k];
        __syncthreads();
#pragma unroll 1
        for (int kb = 0; kb < 32; kb += 8) { float ua[8], ub[8];
#pragma unroll
            for (int q = 0; q < 8; ++q) { ua[q] = z0[512 * (kb + q)]; ub[q] = z1[512 * (kb + q)]; }
#pragma unroll
            for (int q = 0; q < 8; ++q) { const int n = tid + 512 * (kb + q); const c32 u = {ua[q], ub[q]}; X[n] = cmul(u, cis_turns((float)n * tw)); } }
        __syncthreads(); fft_fwd(X, tid);
#pragma unroll
        for (int k = 0; k < 32; ++k) { const int n = tid + 512 * k; X[n] = cmul(X[n], G[k]); if ((k & 7) == 7) asm volatile("" ::: "memory"); }
        __syncthreads(); fft_inv(X, tid);
        if (pass == 0) {
#pragma unroll 1
            for (int kb = 0; kb < 32; kb += 8) { float ua[8], ub[8];
#pragma unroll
                for (int q = 0; q < 8; ++q) { ua[q] = z0[512 * (kb + q)]; ub[q] = z1[512 * (kb + q)]; }
#pragma unroll
                for (int q = 0; q < 8; ++q) { const c32 y = X[tid + 512 * (kb + q)] * scale; y0[512 * (kb + q)] = y.x + bias * ua[q]; y1[512 * (kb + q)] = y.y + bias * ub[q]; } }
        } else {
#pragma unroll 1
            for (int kb = 0; kb < 32; kb += 8) { float ya[8], yb[8];
#pragma unroll
                for (int q = 0; q < 8; ++q) { ya[q] = y0[512 * (kb + q)]; yb[q] = y1[512 * (kb + q)]; }
#pragma unroll
                for (int q = 0; q < 8; ++q) { const int n = tid + 512 * (kb + q); const c32 y = cmul(X[n], cis_turns((float)n * (1.0f / 32768.0f))) * scale; y0[512 * (kb + q)] = ya[q] + y.x; y1[512 * (kb + q)] = yb[q] + y.y; } }
        }
        __syncthreads();
    }
}
__device__ __forceinline__ void hyena_ctx_item(const Ctx& F, int l, int item) {
    LAS float* zs = (LAS float*)F.lds;
    LAS float* fs = zs + 256 * 32;
    LAS float* nr = fs + 511 * 32;
    const int b = item >> 3, c0 = (item & 7) * 32; float* zc = F.p<float>(WS_ZCT) + ((size_t)b * 256 + c0) * CTXL;
#pragma unroll 8
    for (int i = F.tid; i < 32 * 256; i += 512) { const int c = i >> 8, s = i & 255; zs[s * 32 + c] = zc[(size_t)c * CTXL + s]; }
#pragma unroll 8
    for (int i = F.tid; i < 32 * 511; i += 512) { const int c = i / 511, lg = i % 511 - 255;
        fs[(lg + 255) * 32 + c] = lg >= 0 ? F.p<float>(WS_HFC)[(size_t)(c0 + c) * CTXL + lg] : F.p<float>(WS_HFC)[(size_t)(256 + c0 + c) * CTXL - lg]; }
    if (F.tid < 32) { float s = 0.f; for (int tl = 256; tl < 260; ++tl) s += F.p<float>(WS_FPART)[(size_t)tl * 512 + c0 + F.tid] + F.p<float>(WS_FPART)[(size_t)tl * 512 + 256 + c0 + F.tid]; nr[F.tid] = 1.0f / s; }
    __syncthreads();
    const int c = F.tid & 31, tg = F.tid >> 5; const float bias = F.in(I_HBIAS)[l * 256 + c0 + c];
    float acc[16];
#pragma unroll
    for (int i = 0; i < 16; ++i) acc[i] = 0.f;
#pragma unroll 1
    for (int sb = 0; sb < 16; ++sb) { float w[31];
        const int lag0 = 16 * tg - (16 * sb + 15);
#pragma unroll
        for (int k = 0; k < 31; ++k) w[k] = fs[(lag0 + k + 255) * 32 + c];
#pragma unroll
        for (int ss = 0; ss < 16; ++ss) { const float zv = zs[(16 * sb + ss) * 32 + c];
#pragma unroll
            for (int i = 0; i < 16; ++i) acc[i] += zv * w[i - ss + 15]; } }
    const float inv = nr[c];
    float outv[16];
#pragma unroll
    for (int i = 0; i < 16; ++i) outv[i] = acc[i] * inv + bias * zs[(16 * tg + i) * 32 + c];
    __syncthreads();
#pragma unroll
    for (int i = 0; i < 16; ++i) zc[(size_t)c * CTXL + 16 * tg + i] = outv[i];
    __syncthreads();
}
#ifndef MK_PER_PHASE
#define MK_PER_PHASE 0
#endif
#ifndef MK_EN
#define MK_EN 0xFFFFFFFFu
#endif
#define EN(k) (((MK_EN) >> (k)) & 1u)
#ifndef MK_DUP
#define MK_DUP 0u
#endif
#define REP(k) _Pragma("unroll 1") for (int rep_ = 0; rep_ < ((((MK_DUP) >> (k)) & 1u) ? 2 : 1); ++rep_)
#ifdef ATT_USE_PP
#define ATT_MAIN(q, k, o, s, l, t) att::attn_unit_pp(q, k, o, s, (att::lds_u8*)l, t)
#define ATT_PROBE(q, k, o, s, l, t) att::attn_unit_pp<PROBE_ATT>(q, k, o, s, (att::lds_u8*)l, t)
#else
#define ATT_MAIN(q, k, o, s, l, t) att::attn_unit<true>(q, k, o, s, (char*)l, t)
#define ATT_PROBE(q, k, o, s, l, t) att::attn_unit<true, PROBE_ATT>(q, k, o, s, (char*)l, t)
#endif
constexpr int N_PHASES = 1 + 2 * 9 + 2 * 12 + 1;

__global__ void __launch_bounds__(512, 2) mk_fwd(Args args) {
    extern __shared__ __attribute__((aligned(16))) unsigned char lds[];
    Ctx F0;
    F0.out = args.out; F0.ws = args.ws; F0.lds = (LAS unsigned char*)lds; F0.MISC = (volatile LAS unsigned*)(F0.lds + MISC_OFF);
    F0.tid = threadIdx.x; F0.lane = F0.tid & 63; F0.wave = __builtin_amdgcn_readfirstlane(F0.tid >> 6);
    F0.G = gridDim.x; { const int bx = blockIdx.x; F0.vcu = (F0.G % 8 == 0) ? (bx % 8) * (F0.G / 8) + bx / 8 : bx; }
#define PHASE_CTX() Ctx F = F0; { unsigned m_ = ~0u; int w_ = F0.wave, v_ = F0.vcu; unsigned wl_ = (unsigned)(uintptr_t)F0.ws, wh_ = (unsigned)((uintptr_t)F0.ws >> 32), ol_ = (unsigned)(uintptr_t)F0.out, oh_ = (unsigned)((uintptr_t)F0.out >> 32); \
        asm volatile("" : "+s"(m_), "+s"(w_), "+s"(v_), "+s"(wl_), "+s"(wh_), "+s"(ol_), "+s"(oh_)); \
        F.lane = (int)__builtin_amdgcn_mbcnt_hi(m_, __builtin_amdgcn_mbcnt_lo(m_, 0u)); F.wave = w_; F.tid = w_ * 64 + F.lane; F.vcu = v_;     \
        F.ws = (unsigned char*)(GAS unsigned char*)(((uintptr_t)wh_ << 32) | wl_); F.out = (float*)(GAS float*)(((uintptr_t)oh_ << 32) | ol_); }
    { Ctx& F = F0;
    for (int u = F.tid; u < (LDS_BYTES - RING_BYTES) / 4; u += 512) ((LAS unsigned*)(F.lds + RING_BYTES))[u] = 0u;
    __syncthreads(); }
    gu32* ctl = (gu32*)(args.ws + WS_CTL);
    XcdBarrier bar = xcd_barrier_post((unsigned*)(ctl + CW_BAR), F0.MISC + 8);
    const int lo = args.ph_lo, hi = args.ph_hi; int pid = 0;
#define RUN() (lo <= pid && pid < hi)
#define SEAM() do { if (pid + 1 < hi) { unsigned ms_ = ~0u; asm volatile("" : "+s"(ms_)); xcd_barrier(bar, F.wave == 0 && __builtin_amdgcn_mbcnt_hi(ms_, __builtin_amdgcn_mbcnt_lo(ms_, 0u)) == 0u); } } while (0)
    LAS unsigned char* ring = F0.lds;
    LAS int* tsl = (LAS int*)(F0.lds + MISC_OFF + 64);
    const int bid = (int)blockIdx.x;

    if (RUN()) { PHASE_CTX(); if (EN(0)) REP(0) p0_prologue(F); SEAM(); } ++pid;

#pragma unroll 1
    for (int l = 0; l < DEPTH; ++l) {
        const bool moe = (l & 1) != 0; const int mi = l >> 1;
        if (RUN()) { PHASE_CTX();
            if (EN(1)) REP(1) for (int tile = F.vcu; tile < 256; tile += F.G) filter_tile(F, l, tile);
            if (EN(19)) REP(19) { if (l == 0) norm_phase<0, false, false, true>(F, 0, 0, 0); else if ((l - 1) & 1) norm_phase<0, true, false>(F, l, l - 1, 0); else norm_phase<0, false, false, false, 2>(F, l, 0, 0); }
            SEAM(); } ++pid;
        if (RUN()) { PHASE_CTX(); if (EN(2)) REP(2) {
            pg8::Gemm g{F.p<bf16>(WS_HN), F.p<bf16>(WS_WIN) + (size_t)l * UW * D, MT, UW, D, D, D}; pg8::StaticOrder S; S.init(MT, UW, F.G, bid);
            pg8::EpiBf16<0> E{F.p<bf16>(WS_U), UW, nullptr, 0, 0, 1.f};
            pg8::gemm_phase<pg8::EpiBf16<0>, pg8::StaticOrder, true, true>(ring, g, S, E, F.tid); }
            if (EN(1)) for (int tile = 256 + (F.G - 1 - bid); tile < NFT; tile += F.G) filter_tile(F, l, tile);
            SEAM(); } ++pid;
        if (RUN()) { PHASE_CTX(); if (EN(3)) REP(3) prep_phase(F, l); SEAM(); } ++pid;
        if (RUN()) { PHASE_CTX();
            if (EN(4)) REP(4) for (int c = F.vcu; c < 256; c += F.G) hyena_fft_channel(F, l, c);
            if (EN(5)) REP(5) for (int it = bid - 8; it >= 0 && it < 2 * 8; it += F.G) hyena_ctx_item(F, l, it);
            if (EN(6)) REP(6) { pg8::Gemm g{F.p<bf16>(WS_U) + C_CQ, F.p<bf16>(WS_WUQ) + (size_t)l * 768 * 384, MT, 768, 384, UW, 384}; pg8::StaticOrder S; S.init(MT, 768, F.G, (bid + F.G / 2) % F.G);
              pg8::EpiQRope E{F.p<bf16>(WS_Q), F.p<float>(WS_RSQ), F.p<float>(WS_ROPEC), F.p<float>(WS_ROPES)};
              pg8::gemm_phase<pg8::EpiQRope, pg8::StaticOrder, true, true>(ring, g, S, E, F.tid); }
            if (EN(7)) REP(7) { pg8::Gemm g{F.p<bf16>(WS_U) + C_CKV, F.p<bf16>(WS_WUKV) + (size_t)l * 1024 * 256, MT, 1024, 256, UW, 256}; pg8::StaticOrder S; S.init(MT, 1024, F.G, bid);
              pg8::EpiKV E{F.p<bf16>(WS_KV), F.p<float>(WS_RSKV)};
              pg8::gemm_phase<pg8::EpiKV, pg8::StaticOrder, true, true>(ring, g, S, E, F.tid); }
            if (EN(8)) REP(8) { pg8::Gemm g{F.p<bf16>(WS_DP), F.p<bf16>(WS_WPOOL) + (size_t)l * 256 * 256, MT, 256, 256, 256, 256}; pg8::StaticOrder S; S.init(MT, 256, F.G, F.G - 1 - bid);
              pg8::EpiColScale E{F.p<bf16>(WS_MIX) + 256, D, F.in(I_POOLS) + l * 256};
              pg8::gemm_phase<pg8::EpiColScale, pg8::StaticOrder, true, true>(ring, g, S, E, F.tid); }
            SEAM(); } ++pid;
        if (RUN()) { PHASE_CTX();
            if (EN(9)) REP(9) hyena_finalize(F, l);
#if ATT_W64
            if (EN(10)) REP(10) for (int u = F.vcu, uidx = 0; u < 512 + 16; u += F.G, ++uidx) {
                int b, h, row0, seq, nh;
                if (u < 512) { const int pair = u >> 5, qb = u & 31; b = pair >> 3; h = pair & 7; row0 = b * SEQ + qb * 512; seq = NKEY; nh = 2; }
                else { const int pair = u - 512; b = pair >> 3; h = pair & 7; row0 = LAT + b * CTXL; seq = CTXL; nh = 1; }
                const bf16* qp = F.p<bf16>(WS_Q) + (size_t)row0 * 768 + h * DQK; const bf16* kvp = F.p<bf16>(WS_KV) + (size_t)(b * NHEAD + h) * KV_HEAD_STRIDE; bf16* op = F.p<bf16>(WS_MIX) + (size_t)row0 * D + 512 + h * DV;
                unsigned mk_ = ~0u; asm volatile("" : "+s"(mk_)); const int tf = F.wave * 64 + (int)__builtin_amdgcn_mbcnt_hi(mk_, __builtin_amdgcn_mbcnt_lo(mk_, 0u));
                if (!(u < 512 && att::attn_unit_w64(qp, kvp, op, seq, (att::lds_u8*)lds, tf))) {
#pragma unroll 1
                    for (int hf = 0; hf < nh; ++hf) { unsigned mk2_ = ~0u; asm volatile("" : "+s"(mk2_)); const int ts = F.wave * 64 + (int)__builtin_amdgcn_mbcnt_hi(mk2_, __builtin_amdgcn_mbcnt_lo(mk2_, 0u));
                        att::attn_unit<false>(qp + (size_t)hf * 256 * 768, kvp, op + (size_t)hf * 256 * D, seq, (char*)lds, ts); } }
                if (l == 0 && uidx == ((F.vcu >> 5) & 1)) { unsigned mk3_ = ~0u; asm volatile("" : "+s"(mk3_)); const int ln3 = (int)__builtin_amdgcn_mbcnt_hi(mk3_, __builtin_amdgcn_mbcnt_lo(mk3_, 0u)); int gw3 = F.vcu * 8 + F.wave; asm volatile("" : "+s"(gw3)); convert_cats<3, 10>(F, gw3, F.G * 8, ln3); __syncthreads(); }
            }
#else
            if (EN(10)) REP(10) for (int u = F.vcu, uidx = 0; u < 1024 + 16; u += F.G, ++uidx) {
                int b, h, row0, seq;
                if (u < 1024) { const int pair = u >> 6, qb = u & 63; b = pair >> 3; h = pair & 7; row0 = b * SEQ + qb * 256; seq = NKEY; }
                else { const int pair = u - 1024; b = pair >> 3; h = pair & 7; row0 = LAT + b * CTXL; seq = CTXL; }
                const bf16* qp = F.p<bf16>(WS_Q) + (size_t)row0 * 768 + h * DQK; const bf16* kvp = F.p<bf16>(WS_KV) + (size_t)(b * NHEAD + h) * KV_HEAD_STRIDE; bf16* op = F.p<bf16>(WS_MIX) + (size_t)row0 * D + 512 + h * DV;
                unsigned mk_ = ~0u; asm volatile("" : "+s"(mk_)); const int tf = F.wave * 64 + (int)__builtin_amdgcn_mbcnt_hi(mk_, __builtin_amdgcn_mbcnt_lo(mk_, 0u));
                if (!ATT_MAIN(qp, kvp, op, seq, lds, tf)) { unsigned mk2_ = ~0u; asm volatile("" : "+s"(mk2_)); const int ts = F.wave * 64 + (int)__builtin_amdgcn_mbcnt_hi(mk2_, __builtin_amdgcn_mbcnt_lo(mk2_, 0u)); att::attn_unit<false>(qp, kvp, op, seq, (char*)lds, ts); }
                if (l == 0 && uidx == ((F.vcu >> 6) & 3)) { unsigned mk3_ = ~0u; asm volatile("" : "+s"(mk3_)); const int ln3 = (int)__builtin_amdgcn_mbcnt_hi(mk3_, __builtin_amdgcn_mbcnt_lo(mk3_, 0u)); int gw3 = F.vcu * 8 + F.wave; asm volatile("" : "+s"(gw3)); convert_cats<3, 10>(F, gw3, F.G * 8, ln3); __syncthreads(); }
            }
#endif
#ifdef PROBE_ATT
            for (int u = F.vcu; u < 1024; u += F.G) { const int pair = u >> 6, qb = u & 63; const int b = pair >> 3, h = pair & 7, row0 = b * SEQ + qb * 256;
                const bf16* qp = F.p<bf16>(WS_Q) + (size_t)row0 * 768 + h * DQK; const bf16* kvp = F.p<bf16>(WS_KV) + (size_t)(b * NHEAD + h) * KV_HEAD_STRIDE; bf16* op = (bf16*)F.p<float>(WS_ZT) + (size_t)(row0 & 8191) * D + h * DV;
                unsigned mk_ = ~0u; asm volatile("" : "+s"(mk_)); const int tf = F.wave * 64 + (int)__builtin_amdgcn_mbcnt_hi(mk_, __builtin_amdgcn_mbcnt_lo(mk_, 0u));
                ATT_PROBE(qp, kvp, op, NKEY, lds, tf); }
#endif
            SEAM(); } ++pid;
        if (RUN()) { PHASE_CTX(); if (EN(11)) REP(11) {
            pg8::Gemm g{F.p<bf16>(WS_MIX), F.p<bf16>(WS_WOUT) + (size_t)l * D * D, LAT, D, D, D, D}; pg8::StaticOrder S; S.init(LAT, D, F.G, bid);
            pg8::EpiResGate E{l == 0 ? F.in(I_X) : nullptr, (unsigned short*)F.out, F.p<float>(WS_MODS) + (size_t)l * 3 * 6 * D + 2 * D};
            pg8::gemm_phase<pg8::EpiResGate, pg8::StaticOrder, true, true>(ring, g, S, E, F.tid);
            { pg8::Gemm gc{F.p<bf16>(WS_MIX), F.p<bf16>(WS_WOUT) + (size_t)l * D * D, NCTX, D, D / 4, D, D}; pg8::CtxSplitOrder<4> Sc{F.G, bid, D / 4};
              pg8::EpiCtxSlab Ec{F.p<float>(WS_SLAB), F.p<float>(WS_MODS) + (size_t)l * 3 * 6 * D + 2 * D, D / 4};
              pg8::gemm_phase<pg8::EpiCtxSlab, pg8::CtxSplitOrder<4>, true, true>(ring, gc, Sc, Ec, F.tid); } }
            SEAM(); } ++pid;
        if (RUN()) { PHASE_CTX(); if (EN(12)) REP(12) { if (moe) norm_phase<1, false, true, false, 4>(F, l, 0, mi); else norm_phase<1, false, false, false, 4>(F, l, 0, 0); }   SEAM(); } ++pid;
        if (!moe) {
            if (RUN()) { PHASE_CTX(); if (EN(13)) REP(13) {
                pg8::Gemm g{F.p<bf16>(WS_HN), F.p<bf16>(WS_WGU) + (size_t)mi * 2 * FF * D, MT, 2 * FF, D, D, D}; pg8::StaticOrder S; S.init(MT, 2 * FF, F.G, bid);
                pg8::EpiSwiGLU E{F.p<bf16>(WS_H)};
                pg8::gemm_phase<pg8::EpiSwiGLU, pg8::StaticOrder, true, true>(ring, g, S, E, F.tid); }
                SEAM(); } ++pid;
            if (RUN()) { PHASE_CTX(); if (EN(14)) REP(14) {
                pg8::Gemm g{F.p<bf16>(WS_H), F.p<bf16>(WS_WD) + (size_t)mi * D * FF, LAT, D, FF, FF, FF}; pg8::StaticOrder S; S.init(LAT, D, F.G, bid);
                pg8::EpiResGate E{nullptr, (unsigned short*)F.out, F.p<float>(WS_MODS) + (size_t)l * 3 * 6 * D + 5 * D};
                pg8::gemm_phase<pg8::EpiResGate, pg8::StaticOrder, true, true>(ring, g, S, E, F.tid);
                { pg8::Gemm gc{F.p<bf16>(WS_H), F.p<bf16>(WS_WD) + (size_t)mi * D * FF, NCTX, D, FF / 2, FF, FF}; pg8::CtxSplitOrder<2> Sc{F.G, bid, FF / 2};
                  pg8::EpiCtxSlab Ec{F.p<float>(WS_SLAB), F.p<float>(WS_MODS) + (size_t)l * 3 * 6 * D + 5 * D, FF / 2};
                  pg8::gemm_phase<pg8::EpiCtxSlab, pg8::CtxSplitOrder<2>, true, true>(ring, gc, Sc, Ec, F.tid); } }
                SEAM(); } ++pid;
        } else {
            if (RUN()) { PHASE_CTX(); if (EN(15)) REP(15) moe_scatter(F, mi); SEAM(); } ++pid;
#pragma unroll 1
            for (int ch = 0; ch < 2; ++ch) {
                int ts[9]; { PHASE_CTX(); moe_tile_starts(F, mi, ts); }
                const int Tn = ts[8] < XS_TILES ? ts[8] : XS_TILES, Th = Tn < MOE_CHUNK0 ? Tn : MOE_CHUNK0; const int t0 = ch == 0 ? 0 : Th, nt = ch == 0 ? Th : Tn - Th;
                bf16* hs = F0.p<bf16>(WS_HS) - (size_t)t0 * 256 * FF;
                if (RUN()) { PHASE_CTX(); if (EN(16)) REP(16) {
                    if (F.tid == 0) {
#pragma unroll
                        for (int e = 0; e < 9; ++e) tsl[e] = ts[e]; }
                    __syncthreads();
                    pg8::Gemm g{F.p<bf16>(WS_XS), F.p<bf16>(WS_MGU) + (size_t)mi * NEXP * 2 * FF * D, 0, 0, D, D, D}; pg8::MoeOrder<NJ_GU> S{t0, nt, F.G, bid, tsl};
                    pg8::EpiSwiGLU E{hs};
                    pg8::gemm_phase<pg8::EpiSwiGLU, pg8::MoeOrder<NJ_GU>, true, true>(ring, g, S, E, F.tid); }
                    SEAM(); } ++pid;
                if (RUN()) { PHASE_CTX(); if (EN(17)) REP(17) {
                    if (F.tid == 0) {
#pragma unroll
                        for (int e = 0; e < 9; ++e) tsl[e] = ts[e]; }
                    __syncthreads();
                    pg8::Gemm g{hs, F.p<bf16>(WS_MD) + (size_t)mi * NEXP * D * FF, 0, 0, FF, FF, FF}; pg8::MoeOrder<4> S{t0, nt, F.G, bid, tsl};
                    pg8::EpiBf16<0> E{F.p<bf16>(WS_XS), D, nullptr, D, 0, 1.f};
                    pg8::gemm_phase<pg8::EpiBf16<0>, pg8::MoeOrder<4>, true, true>(ring, g, S, E, F.tid); }
                    SEAM(); } ++pid;
            }
        }
    }
#ifdef PROBE_BARS
    if (RUN()) { PHASE_CTX(); for (int q_ = 0; q_ < 40; ++q_) { unsigned ms_ = ~0u; asm volatile("" : "+s"(ms_)); xcd_barrier(bar, F.wave == 0 && __builtin_amdgcn_mbcnt_hi(ms_, __builtin_amdgcn_mbcnt_lo(ms_, 0u)) == 0u); } }
#endif
    if (RUN()) { PHASE_CTX(); if (EN(18)) REP(18) norm_phase<2, true, false>(F, 0, DEPTH - 1, 0); } ++pid;
#undef RUN
#undef SEAM
}

extern "C" void kernel_launch(void* const* d_in, const int* in_sizes, int n_in, void* d_out, int out_size, void* d_ws, size_t ws_size, hipStream_t stream) {
    static int grid = 0;
    if (grid == 0) {
        if (n_in != 34 || in_sizes[0] != LAT * D || out_size != LAT * D || ws_size < WS_END) {
            fprintf(stderr, "kernel_launch: shape mismatch: n_in %d in0 %d out %d ws %zu (need %zu); nothing launched\n", n_in, n_in > 0 ? in_sizes[0] : -1, out_size, ws_size, (size_t)WS_END); grid = -1; return; }
        if (hipFuncSetAttribute((const void*)mk_fwd, hipFuncAttributeMaxDynamicSharedMemorySize, LDS_BYTES) != hipSuccess) { fprintf(stderr, "kernel_launch: hipFuncSetAttribute failed\n"); grid = -1; return; }
        int dev = 0, cus = 0; (void)hipGetDevice(&dev); (void)hipDeviceGetAttribute(&cus, hipDeviceAttributeMultiprocessorCount, dev);
        int per_cu = 0; (void)hipOccupancyMaxActiveBlocksPerMultiprocessor(&per_cu, (const void*)mk_fwd, 512, LDS_BYTES); (void)hipGetLastError();
        grid = (cus >= 256 && per_cu >= 1) ? 256 : (cus > 8 ? (cus / 8) * 8 : 8);
    }
    if (grid < 0) return;
    (void)hipMemsetAsync((char*)d_ws + WS_CTL, 0, CTL_BYTES, stream);
    Args a{};
    for (int i = 0; i < 34; ++i) a.in[i] = (const float*)d_in[i];
    a.out = (float*)d_out; a.ws = (unsigned char*)d_ws;
#if MK_PER_PHASE
    for (int p = 0; p < N_PHASES; ++p) { a.ph_lo = p; a.ph_hi = p + 1; hipLaunchKernelGGL(mk_fwd, dim3(grid), dim3(512), LDS_BYTES, stream, a); }
#else
    a.ph_lo = 0; a.ph_hi = N_PHASES; hipLaunchKernelGGL(mk_fwd, dim3(grid), dim3(512), LDS_BYTES, stream, a);
#endif
    const hipError_t le = hipPeekAtLastError();
    if (le != hipSuccess) fprintf(stderr, "kernel_launch: launch failed: %s\n", hipGetErrorName(le));
}
```

```cpp
#include <hip/hip_runtime.h>
#include <cstdio>
#include <cstdint>
namespace pg8 {
#define PG8_LAS __attribute__((address_space(3)))
typedef unsigned short bf16_t;
typedef short bf16x8 __attribute__((ext_vector_type(8)));
typedef float f32x4 __attribute__((ext_vector_type(4)));
typedef unsigned u32x4 __attribute__((ext_vector_type(4)));
constexpr int BM = 256, BK = 64, HALF = 128, HTB = HALF * BK * 2  , STAGE_BYTES = 8 * HTB, NXCD = 8, WGM = 8;

__host__ __device__ __forceinline__ int lds_byte(int r, int c) { const int st = (r >> 4) * 2 + (c >> 5), rr = r & 15, cc = c & 31, ob = rr * 64 + cc * 2; return st * 1024 + (ob ^ (((ob >> 9) & 1) << 5)); }
__host__ __device__ __forceinline__ void stage_rc(int b, int& R, int& C) { const int st = b / 1024, sb = b % 1024, swz = sb ^ (((sb >> 9) & 1) << 5); R = (st >> 1) * 16 + swz / 64; C = (st & 1) * 32 + (swz % 64) / 2; }
__host__ __device__ __forceinline__ int perm32(int rho) { const int n = rho >> 4, i = rho & 15; return 8 * (i >> 2) + 4 * n + (i & 3); }

struct Unit { int pm, pn, ko; };
struct Gemm { const bf16_t* A; const bf16_t* Bt; int M, N, K, lda, ldb; };

struct StaticOrder {
    int nM, nN, nwg, G, c;
    __host__ __device__ void init(int M, int N, int G_, int c_) { nM = M / BM; nN = N / BM; nwg = nM * nN; G = G_; c = c_; }
    __host__ __device__ bool next(int i, Unit& u) const {
        const long L = (long)i * G + c; if (L >= nwg) return false;
        int wgid = (int)L; { const int q = nwg / NXCD, r = nwg % NXCD, xcd = wgid % NXCD, off = wgid / NXCD; wgid = (xcd < r ? xcd * (q + 1) : r * (q + 1) + (xcd - r) * q) + off; }
        const int nig = WGM * nN, gid = wgid / nig, fm = gid * WGM, gsz = (nM - fm) < WGM ? (nM - fm) : WGM;
        u.pm = fm + ((wgid % nig) % gsz); u.pn = (wgid % nig) / gsz; u.ko = 0; return true;
    }
    __device__ __forceinline__ void a_ready(const Unit&) const {}
    __device__ __forceinline__ void done(const Unit&) const {}
};

__device__ __forceinline__ unsigned cvt_pk_bf16(float lo, float hi) { unsigned r; asm volatile("v_cvt_pk_bf16_f32 %0, %1, %2" : "=v"(r) : "v"(lo), "v"(hi)); return r; }
typedef float f32x2 __attribute__((ext_vector_type(2)));
__device__ __forceinline__ f32x2 gelu_pk(f32x2 v) {
    const f32x2 av = __builtin_elementwise_abs(v), d = av * 0.2316418882f + 1.0f;
    f32x2 t; t.x = __builtin_amdgcn_rcpf(d.x); t.y = __builtin_amdgcn_rcpf(d.y);
    f32x2 q = t * 0.5307027145f + (-0.7265760135f); q = q * t + 0.7107068705f; q = q * t + (-0.142248368f); q = q * t + 0.127414796f; q = q * t;
    const f32x2 s = (v * v) * (-0.72134752044f);
    f32x2 e; e.x = __builtin_amdgcn_exp2f(s.x); e.y = __builtin_amdgcn_exp2f(s.y);
    const f32x2 m = v * (q * e), r = v - m;
    f32x2 o; o.x = v.x < 0.f ? m.x : r.x; o.y = v.y < 0.f ? m.y : r.y; return o;
}

template <int ACT  > struct EpiBf16 {
    static constexpr bool PERM = true, AFTER_DRAIN = false; static_assert(ACT == 0 || ACT == 1, "EpiBf16: ACT is 0 (none) or 1 (gelu_pk)");
    bf16_t* O; int ldc; const float* bias; int split_cols; size_t split_stride; float scale0;
    __device__ __forceinline__ void operator()(const f32x4 (&acc)[2][2][4][2], const Unit& u, int wr, int wc, int fr, int fq) const {
        const int row0 = u.pm * BM + wr * 64 + fr; int colt = u.pn * BM; bf16_t* base = O;
        float sc = 1.f; if (split_cols) { const int t = colt / split_cols; base += (size_t)t * split_stride; colt -= t * split_cols; if (t == 0) sc = scale0; }
        const int col0 = colt + wc * 32 + 8 * fq, bcol0 = u.pn * BM + wc * 32 + 8 * fq;
        f32x4 bv[2][2];
#pragma unroll
        for (int bj = 0; bj < 2; ++bj)
#pragma unroll
            for (int n = 0; n < 2; ++n) bv[bj][n] = bias ? *(const f32x4*)(bias + bcol0 + bj * HALF + 4 * n) : (f32x4){0.f, 0.f, 0.f, 0.f};
#pragma unroll
        for (int ai = 0; ai < 2; ++ai)
#pragma unroll
            for (int m = 0; m < 4; ++m) { bf16_t* rowp = base + (size_t)(row0 + ai * HALF + m * 16) * ldc + col0;
#pragma unroll
                for (int bj = 0; bj < 2; ++bj) { f32x4 v0 = acc[ai][bj][m][0] + bv[bj][0], v1 = acc[ai][bj][m][1] + bv[bj][1];
                    if (ACT == 1) { f32x2 a = gelu_pk((f32x2){v0[0], v0[1]}), b = gelu_pk((f32x2){v0[2], v0[3]}), c = gelu_pk((f32x2){v1[0], v1[1]}), d = gelu_pk((f32x2){v1[2], v1[3]});
                        v0 = (f32x4){a.x, a.y, b.x, b.y}; v1 = (f32x4){c.x, c.y, d.x, d.y}; }
                    v0 = v0 * sc; v1 = v1 * sc; u32x4 w; w.x = cvt_pk_bf16(v0[0], v0[1]); w.y = cvt_pk_bf16(v0[2], v0[3]); w.z = cvt_pk_bf16(v1[0], v1[1]); w.w = cvt_pk_bf16(v1[2], v1[3]);
                    *(u32x4*)(rowp + bj * HALF) = w; } }
    }
};

struct PanelStats {
    unsigned* xbuf;
    unsigned* cnt;
    unsigned* tmo;
    int ntn; float eps;
    unsigned code;
    __device__ __forceinline__ bool run(const f32x4 (&v)[2][2][4][2], const Unit& u, int wr, int wc, int fr, int fq, PG8_LAS unsigned char* lds, int wid, int lane) const {
        typedef float f32x2v __attribute__((ext_vector_type(2)));
        PG8_LAS f32x2v* P = (PG8_LAS f32x2v*)lds;
        PG8_LAS f32x2v* S = (PG8_LAS f32x2v*)(lds + 8192);
        PG8_LAS unsigned* flag = (PG8_LAS unsigned*)(lds + 8192 + 2048);
#pragma unroll
        for (int ai = 0; ai < 2; ++ai)
#pragma unroll
            for (int m = 0; m < 4; ++m) {
                float s = 0.f;
#pragma unroll
                for (int bj = 0; bj < 2; ++bj)
#pragma unroll
                    for (int n = 0; n < 2; ++n) { const f32x4 x = v[ai][bj][m][n]; s += (x[0] + x[1]) + (x[2] + x[3]); }
                s += __shfl_xor(s, 16); s += __shfl_xor(s, 32);
                const float mw = s * (1.0f / 64.0f); float q = 0.f;
#pragma unroll
                for (int bj = 0; bj < 2; ++bj)
#pragma unroll
                    for (int n = 0; n < 2; ++n) { const f32x4 d = v[ai][bj][m][n] - mw; q += (d[0] * d[0] + d[1] * d[1]) + (d[2] * d[2] + d[3] * d[3]); }
                q += __shfl_xor(q, 16); q += __shfl_xor(q, 32);
                if (fq == 0) P[(ai * HALF + wr * 64 + m * 16 + fr) * 4 + wc] = (f32x2v){mw, q};
            }
        asm volatile("s_waitcnt lgkmcnt(0)" ::: "memory"); __builtin_amdgcn_s_barrier(); asm volatile("" ::: "memory");
#if defined(BROKEN_EXCHANGE_NO_WAIT)
#warning BROKEN CONTROL BUILD: the row-statistics exchange does not wait; results are wrong by design
        if (blockIdx.x >= 64) { const long long t0_ = clock64(); while (clock64() - t0_ < 60000) __builtin_amdgcn_s_sleep(8); }
#endif
        const int row = wid * 32 + (lane & 31);
        if (lane < 32) {
            const f32x2v a = P[row * 4 + 0], b = P[row * 4 + 1], c = P[row * 4 + 2], d = P[row * 4 + 3];
            const float mt = (a.x + b.x + c.x + d.x) * 0.25f;
            const float da = a.x - mt, db = b.x - mt, dc = c.x - mt, dd = d.x - mt;
            const float m2 = (a.y + b.y) + (c.y + d.y) + 64.0f * ((da * da + db * db) + (dc * dc + dd * dd));
            unsigned long long* slot = (unsigned long long*)xbuf + ((size_t)(u.pm * BM + row) * 4 + u.pn);
            __hip_atomic_store(slot, ((unsigned long long)__float_as_uint(m2) << 32) | __float_as_uint(mt), __ATOMIC_RELAXED, __HIP_MEMORY_SCOPE_AGENT);
        }
        asm volatile("s_waitcnt vmcnt(0)" ::: "memory");
        if (lane == 0) __hip_atomic_fetch_add(cnt + 64 * u.pm, 1u, __ATOMIC_RELAXED, __HIP_MEMORY_SCOPE_AGENT);
        if (wid == 0) {
            bool dead = false; const unsigned long long t0 = __builtin_amdgcn_s_memrealtime(); const unsigned want = 8u * (unsigned)ntn;
            for (;;) {
#if defined(BROKEN_EXCHANGE_NO_WAIT)
                break;
#endif
                if ((unsigned)__builtin_amdgcn_readfirstlane(__hip_atomic_load(cnt + 64 * u.pm, __ATOMIC_RELAXED, __HIP_MEMORY_SCOPE_AGENT)) >= want) break;
                if (__builtin_amdgcn_s_memrealtime() - t0 > 2000000ull) {
                    if (lane == 0) { unsigned expect = 0u; __hip_atomic_compare_exchange_strong(tmo + 1, &expect, code | (unsigned)(u.pm & 0xff), __ATOMIC_RELAXED, __ATOMIC_RELAXED, __HIP_MEMORY_SCOPE_AGENT);
                                     __hip_atomic_store(tmo, 1u, __ATOMIC_RELAXED, __HIP_MEMORY_SCOPE_AGENT); }
                    dead = true; break; }
                __builtin_amdgcn_s_sleep(2);
            }
            __builtin_amdgcn_fence(__ATOMIC_ACQUIRE, "agent");
            if (lane == 0) flag[0] = dead ? 1u : 0u;
        }
        asm volatile("s_waitcnt vmcnt(0) lgkmcnt(0)" ::: "memory"); __builtin_amdgcn_s_barrier(); asm volatile("" ::: "memory");
        const bool bad = flag[0] != 0u;
        if (lane < 32) {
            const unsigned long long* slot = (const unsigned long long*)xbuf + (size_t)(u.pm * BM + row) * 4; float mt[4], m2[4]; float ms = 0.f;
#pragma unroll
            for (int t = 0; t < 4; ++t) { if (t < ntn) { const unsigned long long w = __hip_atomic_load(slot + t, __ATOMIC_RELAXED, __HIP_MEMORY_SCOPE_AGENT); mt[t] = __uint_as_float((unsigned)w); m2[t] = __uint_as_float((unsigned)(w >> 32)); } else { mt[t] = 0.f; m2[t] = 0.f; } ms += mt[t]; }
            const float mean = ms / (float)ntn; float q = 0.f;
#pragma unroll
            for (int t = 0; t < 4; ++t) if (t < ntn) { const float dm = mt[t] - mean; q += m2[t] + 256.0f * dm * dm; }
            S[row] = (f32x2v){mean, 1.0f / sqrtf(q / (256.0f * (float)ntn) + eps)};
        }
        asm volatile("s_waitcnt lgkmcnt(0)" ::: "memory"); __builtin_amdgcn_s_barrier(); asm volatile("" ::: "memory");
        return bad;
    }
};
struct EpiLnRes {
    static constexpr bool PERM = false, AFTER_DRAIN = true;
    const float* base; float* out; int ldc; const float* bias; PanelStats st; unsigned poison;
    __device__ __forceinline__ void fused(f32x4 (&acc)[2][2][4][2], const Unit& u, int wr, int wc, int fr, int fq, PG8_LAS unsigned char* lds, int wid, int lane) const {
        typedef float f32x2v __attribute__((ext_vector_type(2)));
        const PG8_LAS f32x2v* S = (const PG8_LAS f32x2v*)(lds + 8192);
        const int col0 = u.pn * BM + wc * 32 + 4 * fq;
#pragma unroll
        for (int bj = 0; bj < 2; ++bj)
#pragma unroll
            for (int n = 0; n < 2; ++n) { const f32x4 bv = bias ? *(const f32x4*)(bias + col0 + bj * HALF + n * 16) : (f32x4){0.f, 0.f, 0.f, 0.f};
#pragma unroll
                for (int ai = 0; ai < 2; ++ai)
#pragma unroll
                    for (int m = 0; m < 4; ++m) acc[ai][bj][m][n] += bv; }
        f32x4 pre[4][2][2];
#pragma unroll
        for (int m = 0; m < 4; ++m) { const size_t off = (size_t)(u.pm * BM + wr * 64 + m * 16 + fr) * ldc + col0;
#pragma unroll
            for (int bj = 0; bj < 2; ++bj)
#pragma unroll
                for (int n = 0; n < 2; ++n) pre[m][bj][n] = *(const f32x4*)(base + off + bj * HALF + n * 16); }
        const bool bad = st.run(acc, u, wr, wc, fr, fq, lds, wid, lane) || poison != 0u;
        const float qnan = __builtin_nanf("");
#pragma unroll
        for (int ai = 0; ai < 2; ++ai)
#pragma unroll
            for (int m = 0; m < 4; ++m) { const int r = ai * HALF + wr * 64 + m * 16 + fr; const f32x2v sr = S[r]; const size_t off = (size_t)(u.pm * BM + r) * ldc + col0;
#pragma unroll
                for (int bj = 0; bj < 2; ++bj)
#pragma unroll
                    for (int n = 0; n < 2; ++n) { const f32x4 bs = ai == 0 ? pre[m][bj][n] : *(const f32x4*)(base + off + bj * HALF + n * 16); f32x4 o = bs + (acc[ai][bj][m][n] - sr.x) * sr.y;
                        if (bad) o = (f32x4){qnan, qnan, qnan, qnan}; *(f32x4*)(out + off + bj * HALF + n * 16) = o; }
                if (m & 1) asm volatile("" ::: "memory"); }
    }
};
struct EpiLnResLn {
    static constexpr bool PERM = false, AFTER_DRAIN = true;
    const float* base; float* out; bf16_t* xn; int ldc; const float* bias; PanelStats st1, st2; unsigned poison;
    __device__ __forceinline__ void fused(f32x4 (&acc)[2][2][4][2], const Unit& u, int wr, int wc, int fr, int fq, PG8_LAS unsigned char* lds, int wid, int lane) const {
        typedef float f32x2v __attribute__((ext_vector_type(2))); typedef unsigned u32x2v __attribute__((ext_vector_type(2)));
        const PG8_LAS f32x2v* S = (const PG8_LAS f32x2v*)(lds + 8192);
        const int col0 = u.pn * BM + wc * 32 + 4 * fq;
#pragma unroll
        for (int bj = 0; bj < 2; ++bj)
#pragma unroll
            for (int n = 0; n < 2; ++n) { const f32x4 bv = bias ? *(const f32x4*)(bias + col0 + bj * HALF + n * 16) : (f32x4){0.f, 0.f, 0.f, 0.f};
#pragma unroll
                for (int ai = 0; ai < 2; ++ai)
#pragma unroll
                    for (int m = 0; m < 4; ++m) acc[ai][bj][m][n] += bv; }
        bool bad = st1.run(acc, u, wr, wc, fr, fq, lds, wid, lane) || poison != 0u;
        const float qnan = __builtin_nanf("");
#pragma unroll
        for (int ai = 0; ai < 2; ++ai)
#pragma unroll
            for (int m = 0; m < 4; ++m) { const int r = ai * HALF + wr * 64 + m * 16 + fr; const f32x2v sr = S[r]; const size_t off = (size_t)(u.pm * BM + r) * ldc + col0;
#pragma unroll
                for (int bj = 0; bj < 2; ++bj)
#pragma unroll
                    for (int n = 0; n < 2; ++n) { const f32x4 bs = *(const f32x4*)(base + off + bj * HALF + n * 16); acc[ai][bj][m][n] = bs + (acc[ai][bj][m][n] - sr.x) * sr.y; }
                asm volatile("" : "+v"(acc[ai][0][m][0]), "+v"(acc[ai][0][m][1]), "+v"(acc[ai][1][m][0]), "+v"(acc[ai][1][m][1]));
                if (m & 1) asm volatile("" ::: "memory"); }
        const bool bad1 = bad;
        bad = st2.run(acc, u, wr, wc, fr, fq, lds, wid, lane) || bad;
#pragma unroll
        for (int ai = 0; ai < 2; ++ai)
#pragma unroll
            for (int m = 0; m < 4; ++m) { const int r = ai * HALF + wr * 64 + m * 16 + fr; const f32x2v sr = S[r]; const size_t off = (size_t)(u.pm * BM + r) * ldc + col0;
#pragma unroll
                for (int bj = 0; bj < 2; ++bj)
#pragma unroll
                    for (int n = 0; n < 2; ++n) { const f32x4 x1 = acc[ai][bj][m][n]; *(f32x4*)(out + off + bj * HALF + n * 16) = bad1 ? (f32x4){qnan, qnan, qnan, qnan} : x1;
                        const f32x4 o = (x1 - sr.x) * sr.y; u32x2v w; w.x = cvt_pk_bf16(o[0], o[1]); w.y = cvt_pk_bf16(o[2], o[3]);
                        if (bad) { w.x = 0x7fc07fc0u; w.y = 0x7fc07fc0u; } *(u32x2v*)(xn + off + bj * HALF + n * 16) = w; }
                asm volatile("" ::: "memory"); }
    }
};

template <class Epi, class Sched, bool ALIGN_EPI = false, bool SP2 = false>
__device__ __forceinline__ void gemm_phase(PG8_LAS unsigned char* lds, const Gemm g, const Sched& S, const Epi& E, int tid_in) {
    int tid_ = tid_in; asm volatile("" : "+v"(tid_));
    const int tid = tid_, wid = __builtin_amdgcn_readfirstlane(tid >> 6), lane = tid & 63, wr = wid >> 2, wc = wid & 3, fr = lane & 15, fq = lane >> 4;
    int K_ = g.K; asm volatile("" : "+s"(K_)); const int K = K_, nt = K / BK;
    unsigned voffA[2], voffB[2];
#pragma unroll
    for (int i = 0; i < 2; ++i) { int R, C; stage_rc(tid * 16 + i * 8192, R, C); const int Rb = Epi::PERM ? ((R & ~31) + perm32(R & 31)) : R;
        voffA[i] = (unsigned)(R * g.lda + C) * 2u; voffB[i] = (unsigned)(Rb * g.ldb + C) * 2u; }
    const size_t kstep = (size_t)(BK * 2);
    const size_t hstepA = (size_t)HALF * g.lda * 2, hstepB = (size_t)HALF * g.ldb * 2;
    const size_t tstepA = 2 * hstepA, tstepB = 2 * hstepB;
    const unsigned ldsw = (unsigned)wid * 1024u;
    const int aoff = lds_byte(wr * 64 + fr, fq * 8), boff = lds_byte(wc * 32 + fr, fq * 8);
#define PG8_SA(b, h) (((b) * 2 + (h)) * HTB)
#define PG8_SB(b, h) ((4 + (b) * 2 + (h)) * HTB)
#define PG8_STAGE(bufoff, gbase, voff) do { _Pragma("unroll") for (int _i = 0; _i < 2; ++_i) \
        __builtin_amdgcn_global_load_lds((const unsigned*)((const char*)(gbase) + (voff)[_i]), (PG8_LAS unsigned*)(lds + (bufoff) + ldsw + _i * 8192), 16, 0, 0); } while (0)
#define PG8_LDA(dst, b, h) do { _Pragma("unroll") for (int m = 0; m < 4; ++m) _Pragma("unroll") for (int k = 0; k < 2; ++k) dst[m][k] = *(const PG8_LAS bf16x8*)(lds + PG8_SA(b, h) + aoff + m * 2048 + k * 1024); } while (0)
#define PG8_LDB(dst, b, h) do { _Pragma("unroll") for (int n = 0; n < 2; ++n) _Pragma("unroll") for (int k = 0; k < 2; ++k) dst[n][k] = *(const PG8_LAS bf16x8*)(lds + PG8_SB(b, h) + boff + n * 2048 + k * 1024); } while (0)
#define PG8_MMA(ai, bj, At, Bt) do { __builtin_amdgcn_s_setprio(1); _Pragma("unroll") for (int m = 0; m < 4; ++m) _Pragma("unroll") for (int n = 0; n < 2; ++n) _Pragma("unroll") for (int k = 0; k < 2; ++k) \
        acc[ai][bj][m][n] = __builtin_amdgcn_mfma_f32_16x16x32_bf16(Bt[n][k], At[m][k], acc[ai][bj][m][n], 0, 0, 0); __builtin_amdgcn_s_setprio(0); } while (0)
#define PG8_WAIT_V(n) asm volatile("s_waitcnt vmcnt(" #n ")" ::: "memory")
#define PG8_WAIT_L(n) asm volatile("s_waitcnt lgkmcnt(" #n ")" ::: "memory")
#define PG8_BAR __builtin_amdgcn_s_barrier()
#define PG8_SCHED __builtin_amdgcn_sched_barrier(0)
    Unit cur, nxt; int ui = 0;
    if (!S.next(0, cur)) return;
    f32x4 acc[2][2][4][2];
#pragma unroll
    for (int a = 0; a < 2; ++a)
#pragma unroll
        for (int b = 0; b < 2; ++b)
#pragma unroll
            for (int m = 0; m < 4; ++m)
#pragma unroll
                for (int n = 0; n < 2; ++n) acc[a][b][m][n] = (f32x4){0.f, 0.f, 0.f, 0.f};
    bf16x8 At[4][2], B0[2][2], B1[2][2];
    const char* cA = (const char*)g.A + (size_t)cur.pm * tstepA + (size_t)cur.ko * 2; const char* cB = (const char*)g.Bt + (size_t)cur.pn * tstepB + (size_t)cur.ko * 2;
    S.a_ready(cur);
    if constexpr (SP2) {
        PG8_STAGE(PG8_SB(0, 0), cB, voffB); PG8_STAGE(PG8_SB(0, 1), cB + hstepB, voffB); PG8_STAGE(PG8_SA(0, 0), cA, voffA); PG8_STAGE(PG8_SA(0, 1), cA + hstepA, voffA);
        if (wr == 1) PG8_BAR;
        PG8_WAIT_V(2); PG8_BAR;
        PG8_STAGE(PG8_SB(1, 0), cB + kstep, voffB); PG8_STAGE(PG8_SA(1, 0), cA + kstep, voffA); PG8_STAGE(PG8_SB(1, 1), cB + hstepB + kstep, voffB);
        PG8_WAIT_V(6); PG8_BAR;
    } else {
        PG8_STAGE(PG8_SB(0, 0), cB, voffB); PG8_STAGE(PG8_SA(0, 0), cA, voffA); PG8_STAGE(PG8_SB(0, 1), cB + hstepB, voffB); PG8_STAGE(PG8_SA(0, 1), cA + hstepA, voffA);
        if (wr == 1) PG8_BAR;
        PG8_WAIT_V(4); PG8_BAR;
        PG8_STAGE(PG8_SB(1, 0), cB + kstep, voffB); PG8_STAGE(PG8_SA(1, 0), cA + kstep, voffA); PG8_STAGE(PG8_SB(1, 1), cB + hstepB + kstep, voffB);
        PG8_WAIT_V(6); PG8_BAR;
    }
    for (;;) {
        const bool has_next = S.next(ui + 1, nxt);
        const char* nA = has_next ? (const char*)g.A + (size_t)nxt.pm * tstepA + (size_t)nxt.ko * 2 : cA; const char* nB = has_next ? (const char*)g.Bt + (size_t)nxt.pn * tstepB + (size_t)nxt.ko * 2 : cB;
#pragma unroll 1
        for (int t = 0; t < nt; t += 2) {
            const bool last = (t == nt - 2);
            const char* a1 = cA + (size_t)(t + 1) * kstep;
            const char* a2 = last ? nA : cA + (size_t)(t + 2) * kstep; const char* b2 = last ? nB : cB + (size_t)(t + 2) * kstep;
            const char* a3 = a2 + kstep; const char* b3 = b2 + kstep;
            if (last && has_next) S.a_ready(nxt);
            if constexpr (SP2) {
            PG8_LDB(B0, 0, 0); PG8_LDB(B1, 0, 1); PG8_SCHED; PG8_LDA(At, 0, 0); PG8_STAGE(PG8_SA(1, 1), a1 + hstepA, voffA);
            PG8_WAIT_V(8); PG8_WAIT_L(0); PG8_BAR; PG8_MMA(0, 0, At, B0); PG8_MMA(0, 1, At, B1); PG8_BAR; PG8_SCHED;
            PG8_LDA(At, 0, 1); PG8_STAGE(PG8_SB(0, 0), b2, voffB); PG8_STAGE(PG8_SB(0, 1), b2 + hstepB, voffB); PG8_STAGE(PG8_SA(0, 0), a2, voffA);
            PG8_WAIT_V(8); PG8_WAIT_L(0); PG8_BAR; PG8_MMA(1, 0, At, B0); PG8_MMA(1, 1, At, B1); PG8_BAR; PG8_SCHED;
            PG8_LDB(B0, 1, 0); PG8_LDB(B1, 1, 1); PG8_SCHED; PG8_LDA(At, 1, 0); PG8_STAGE(PG8_SA(0, 1), a2 + hstepA, voffA);
            PG8_WAIT_V(8); PG8_WAIT_L(0); PG8_BAR; PG8_MMA(0, 0, At, B0); PG8_MMA(0, 1, At, B1); PG8_BAR; PG8_SCHED;
            PG8_LDA(At, 1, 1); PG8_STAGE(PG8_SB(1, 0), b3, voffB); PG8_STAGE(PG8_SB(1, 1), b3 + hstepB, voffB); PG8_STAGE(PG8_SA(1, 0), a3, voffA);
            PG8_WAIT_V(8); PG8_WAIT_L(0); PG8_BAR; PG8_MMA(1, 0, At, B0); PG8_MMA(1, 1, At, B1); PG8_BAR; PG8_SCHED;
            } else {
            PG8_LDB(B0, 0, 0); PG8_SCHED; PG8_LDA(At, 0, 0); PG8_STAGE(PG8_SA(1, 1), a1 + hstepA, voffA);
            PG8_WAIT_L(8); PG8_BAR; PG8_WAIT_L(0); PG8_MMA(0, 0, At, B0); PG8_BAR; PG8_SCHED;
            PG8_LDB(B1, 0, 1); PG8_STAGE(PG8_SB(0, 0), b2, voffB);
            PG8_BAR; PG8_WAIT_L(0); PG8_MMA(0, 1, At, B1); PG8_BAR;
            PG8_LDA(At, 0, 1); PG8_STAGE(PG8_SA(0, 0), a2, voffA);
            PG8_BAR; PG8_WAIT_L(0); PG8_MMA(1, 0, At, B0); PG8_BAR; PG8_SCHED;
            PG8_STAGE(PG8_SB(0, 1), b2 + hstepB, voffB);
            PG8_WAIT_V(6); PG8_BAR; PG8_MMA(1, 1, At, B1); PG8_BAR;
            PG8_LDB(B0, 1, 0); PG8_SCHED; PG8_LDA(At, 1, 0); PG8_STAGE(PG8_SA(0, 1), a2 + hstepA, voffA);
            PG8_WAIT_L(8); PG8_BAR; PG8_WAIT_L(0); PG8_MMA(0, 0, At, B0); PG8_BAR; PG8_SCHED;
            PG8_LDB(B1, 1, 1); PG8_STAGE(PG8_SB(1, 0), b3, voffB);
            PG8_BAR; PG8_WAIT_L(0); PG8_MMA(0, 1, At, B1); PG8_BAR;
            PG8_LDA(At, 1, 1); PG8_STAGE(PG8_SA(1, 0), a3, voffA);
            PG8_BAR; PG8_WAIT_L(0); PG8_MMA(1, 0, At, B0); PG8_BAR; PG8_SCHED;
            PG8_STAGE(PG8_SB(1, 1), b3 + hstepB, voffB);
            PG8_WAIT_V(6); PG8_BAR; PG8_MMA(1, 1, At, B1); PG8_BAR;
            }
        }
        if constexpr (ALIGN_EPI) { if (wr == 0) PG8_BAR; }
        if constexpr (!Epi::AFTER_DRAIN) { E(acc, cur, wr, wc, fr, fq); S.done(cur); }
        if (!has_next) break;
#pragma unroll
        for (int a = 0; a < 2; ++a)
#pragma unroll
            for (int b = 0; b < 2; ++b)
#pragma unroll
                for (int m = 0; m < 4; ++m)
#pragma unroll
                    for (int n = 0; n < 2; ++n) acc[a][b][m][n] = (f32x4){0.f, 0.f, 0.f, 0.f};
        cur = nxt; cA = nA; cB = nB; ++ui;
        if constexpr (ALIGN_EPI) { if (wr == 1) PG8_BAR; }
    }
    PG8_WAIT_V(0);
    if constexpr (!ALIGN_EPI) { if (wr == 0) PG8_BAR; }
    PG8_BAR;
    if constexpr (Epi::AFTER_DRAIN) { E.fused(acc, cur, wr, wc, fr, fq, lds, wid, lane); S.done(cur); }
#undef PG8_SA
#undef PG8_SB
#undef PG8_STAGE
#undef PG8_LDA
#undef PG8_LDB
#undef PG8_MMA
#undef PG8_WAIT_V
#undef PG8_WAIT_L
#undef PG8_BAR
#undef PG8_SCHED
}
}
constexpr int D = 1024, NB = 2, SEQ = 16384, LAT = NB * SEQ, CTXL = 256, NCTX = NB * CTXL, MT = LAT + NCTX;
constexpr int DEPTH = 4, NHEAD = 8, DQK = 96, DV = 64, NKEY = CTXL + SEQ;
constexpr int UW = 1792, KVW = 160;
constexpr int C_HY = 0, C_POOL = 768, C_CQ = 1024, C_CKV = 1408, C_KPE = 1664;
constexpr int FF = 2816, NJ_GU = FF / 128, NEXP = 8;
constexpr size_t KV_HEAD_STRIDE = (size_t)NKEY * KVW;
constexpr float QSCALE = 0.10206207261596577f * 1.4426950408889634f;

namespace pg8 {
__device__ __forceinline__ u32x4 pack8(f32x4 v0, f32x4 v1) { u32x4 w; w.x = cvt_pk_bf16(v0[0], v0[1]); w.y = cvt_pk_bf16(v0[2], v0[3]); w.z = cvt_pk_bf16(v1[0], v1[1]); w.w = cvt_pk_bf16(v1[2], v1[3]); return w; }

struct EpiQRope {
    static constexpr bool PERM = true, AFTER_DRAIN = false;
    bf16_t* Q; const float* rstd; const float* ropec; const float* ropes;
    __device__ __forceinline__ void operator()(const f32x4 (&acc)[2][2][4][2], const Unit& u, int wr, int wc, int fr, int fq) const {
        asm volatile("" : "+v"(fr), "+v"(fq));
        const int row0 = u.pm * BM + wr * 64 + fr; const bool lat = u.pm < (LAT / BM);
        int c0[2], j0[2]; bool rp[2];
#pragma unroll
        for (int bj = 0; bj < 2; ++bj) { c0[bj] = u.pn * BM + bj * HALF + wc * 32 + 8 * fq; const int dl = c0[bj] % DQK; rp[bj] = lat && dl >= 64; j0[bj] = rp[bj] ? ((dl - 64) >> 1) : 0; }
#pragma unroll
        for (int ai = 0; ai < 2; ++ai)
#pragma unroll
            for (int m = 0; m < 4; ++m) { const int row = row0 + ai * HALF + m * 16; const float rs = rstd[row] * QSCALE; const int t = row & (SEQ - 1);
#pragma unroll
                for (int bj = 0; bj < 2; ++bj) { f32x4 v0 = acc[ai][bj][m][0] * rs, v1 = acc[ai][bj][m][1] * rs;
                    if (rp[bj]) { const f32x4 c = *(const f32x4*)(ropec + t * 16 + j0[bj]), s = *(const f32x4*)(ropes + t * 16 + j0[bj]);
                        const f32x4 a = v0 * c - v1 * s, b = v0 * s + v1 * c; v0 = a; v1 = b; }
                    *(u32x4*)(Q + (unsigned)(row * 768 + c0[bj])) = pack8(v0, v1); }
                asm volatile("" ::: "memory"); }
    }
};
struct EpiKV {
    static constexpr bool PERM = true, AFTER_DRAIN = false;
    bf16_t* KV; const float* rstd;
    __device__ __forceinline__ void operator()(const f32x4 (&acc)[2][2][4][2], const Unit& u, int wr, int wc, int fr, int fq) const {
        asm volatile("" : "+v"(fr), "+v"(fq));
        const int row0 = u.pm * BM + wr * 64 + fr; const bool lat = u.pm < (LAT / BM);
        const int d = wc * 32 + 8 * fq, off = d < 64 ? d : d + 32;
#pragma unroll
        for (int ai = 0; ai < 2; ++ai)
#pragma unroll
            for (int m = 0; m < 4; ++m) { const int row = row0 + ai * HALF + m * 16; const float rs = rstd[row];
                int b, key; if (lat) { b = row >> 14; key = CTXL + (row & (SEQ - 1)); } else { const int rc = row - LAT; b = rc >> 8; key = rc & (CTXL - 1); }
                const unsigned ro = (unsigned)((b * NHEAD + 2 * u.pn) * NKEY + key) * KVW + off;
#pragma unroll
                for (int bj = 0; bj < 2; ++bj) *(u32x4*)(KV + ro + bj * (unsigned)KV_HEAD_STRIDE) = pack8(acc[ai][bj][m][0] * rs, acc[ai][bj][m][1] * rs);
                asm volatile("" ::: "memory"); }
    }
};
struct EpiColScale {
    static constexpr bool PERM = true, AFTER_DRAIN = false;
    bf16_t* O; int ldc; const float* cs;
    __device__ __forceinline__ void operator()(const f32x4 (&acc)[2][2][4][2], const Unit& u, int wr, int wc, int fr, int fq) const {
        asm volatile("" : "+v"(fr), "+v"(fq));
        const int row0 = u.pm * BM + wr * 64 + fr;
#pragma unroll
        for (int bj = 0; bj < 2; ++bj) { const int c = u.pn * BM + bj * HALF + wc * 32 + 8 * fq; const f32x4 s0 = *(const f32x4*)(cs + c), s1 = *(const f32x4*)(cs + c + 4);
#pragma unroll
            for (int ai = 0; ai < 2; ++ai)
#pragma unroll
                for (int m = 0; m < 4; ++m) { *(u32x4*)(O + (unsigned)((row0 + ai * HALF + m * 16) * ldc + c)) = pack8(acc[ai][bj][m][0] * s0, acc[ai][bj][m][1] * s1); if (m & 1) asm volatile("" ::: "memory"); } }
    }
};
struct EpiSwiGLU {
    static constexpr bool PERM = true, AFTER_DRAIN = false;
    bf16_t* H;
    __device__ __forceinline__ void operator()(const f32x4 (&acc)[2][2][4][2], const Unit& u, int wr, int wc, int fr, int fq) const {
        asm volatile("" : "+v"(fr), "+v"(fq));
        const int row0 = u.pm * BM + wr * 64 + fr; const int hc = (u.pn % NJ_GU) * HALF + wc * 32 + 8 * fq;
#pragma unroll
        for (int ai = 0; ai < 2; ++ai)
#pragma unroll
            for (int m = 0; m < 4; ++m) { f32x4 h[2];
#pragma unroll
                for (int n = 0; n < 2; ++n) { const f32x4 g = acc[ai][0][m][n], up = acc[ai][1][m][n];
#pragma unroll
                    for (int j = 0; j < 4; ++j) { const float e = __builtin_amdgcn_exp2f(g[j] * -1.4426950408889634f); h[n][j] = g[j] * __builtin_amdgcn_rcpf(1.0f + e) * up[j]; } }
                *(u32x4*)(H + (size_t)(row0 + ai * HALF + m * 16) * FF + hc) = pack8(h[0], h[1]); if (m & 1) asm volatile("" ::: "memory"); }
    }
};
typedef unsigned u32x2g __attribute__((ext_vector_type(2)));
constexpr int XBP = 2 * D;
struct EpiResGate {
    static constexpr bool PERM = false, AFTER_DRAIN = false;
    const float* src_f32; unsigned short* xb; const float* gate;
    __device__ __forceinline__ void operator()(const f32x4 (&acc)[2][2][4][2], const Unit& u, int wr, int wc, int fr, int fq) const {
        asm volatile("" : "+v"(fr), "+v"(fq));
        const int vsel = u.pm < (SEQ / BM) ? 0 : 1;
        unsigned short* base = xb + (size_t)u.pm * BM * XBP; const float* sbase = src_f32 ? src_f32 + (size_t)u.pm * BM * D : nullptr;
        const int col0 = u.pn * BM + wc * 32 + 4 * fq; const float* gp = gate + vsel * 6 * D + col0;
        f32x4 gv[2][2];
#pragma unroll
        for (int bj = 0; bj < 2; ++bj)
#pragma unroll
            for (int n = 0; n < 2; ++n) gv[bj][n] = *(const f32x4*)(gp + bj * HALF + n * 16);
#pragma unroll
        for (int ai = 0; ai < 2; ++ai)
#pragma unroll
            for (int m = 0; m < 4; ++m) { const unsigned rr = (unsigned)(ai * HALF + wr * 64 + m * 16 + fr);
#pragma unroll
                for (int bj = 0; bj < 2; ++bj)
#pragma unroll
                    for (int n = 0; n < 2; ++n) { const unsigned c = (unsigned)(col0 + bj * HALF + n * 16); f32x4 xi;
                        if (sbase) xi = *(const f32x4*)(sbase + rr * D + c);
                        else { const u32x2g w = *(const u32x2g*)(base + rr * XBP + c); xi = (f32x4){__uint_as_float(w.x << 16), __uint_as_float(w.x & 0xffff0000u), __uint_as_float(w.y << 16), __uint_as_float(w.y & 0xffff0000u)}; }
                        const f32x4 o = xi + gv[bj][n] * acc[ai][bj][m][n]; u32x2g ow; ow.x = cvt_pk_bf16(o[0], o[1]); ow.y = cvt_pk_bf16(o[2], o[3]);
                        *(u32x2g*)(base + rr * XBP + c) = ow; }
                if (m & 1) asm volatile("" ::: "memory"); }
    }
};
template <int NJ> struct MoeOrder {
    int t0, nt, G, c; const PG8_LAS int* tstart;
    __device__ __forceinline__ bool next(int i, Unit& u) const {
        int tile, j;
        if (G == 256) { constexpr int NJH = NJ / 2; const int x = c & 7, r = x & 3, ch = x >> 2, w = c >> 3; const int ntr = (nt - r + 3) >> 2; const int Lx = i * 32 + w;
            if (Lx >= ntr * NJH) return false; tile = t0 + 4 * (Lx / NJH) + r; j = ch * NJH + Lx % NJH; }
        else { const int L = i * G + c; if (L >= nt * NJ) return false; tile = t0 + L / NJ; j = L % NJ; }
        int e = 0;
#pragma unroll
        for (int k = 1; k < NEXP; ++k) e += (tile >= tstart[k]) ? 1 : 0;
        u.pm = __builtin_amdgcn_readfirstlane(tile); u.pn = __builtin_amdgcn_readfirstlane(e * NJ + j); u.ko = 0; return true;
    }
    __device__ __forceinline__ void a_ready(const Unit&) const {}
    __device__ __forceinline__ void done(const Unit&) const {}
};
template <int S> struct CtxSplitOrder {
    int G, c, Kp;
    __device__ __forceinline__ bool next(int i, Unit& u) const {
        const int L = i * G + c; if (L >= 8 * S) return false;
        const int ks = L % S, t = L / S; u.pm = LAT / BM + (t >> 2); u.pn = t & 3; u.ko = ks * Kp; return true;
    }
    __device__ __forceinline__ void a_ready(const Unit&) const {}
    __device__ __forceinline__ void done(const Unit&) const {}
};
struct EpiCtxSlab {
    static constexpr bool PERM = false, AFTER_DRAIN = false;
    float* slab; const float* gate; int Kp;
    __device__ __forceinline__ void operator()(const f32x4 (&acc)[2][2][4][2], const Unit& u, int wr, int wc, int fr, int fq) const {
        asm volatile("" : "+v"(fr), "+v"(fq));
        float* base = slab + ((size_t)(u.ko / Kp) * NCTX + (size_t)(u.pm - LAT / BM) * BM) * D;
        const int col0 = u.pn * BM + wc * 32 + 4 * fq; const float* gp = gate + 2 * 6 * D + col0;
        f32x4 gv[2][2];
#pragma unroll
        for (int bj = 0; bj < 2; ++bj)
#pragma unroll
            for (int n = 0; n < 2; ++n) gv[bj][n] = *(const f32x4*)(gp + bj * HALF + n * 16);
#pragma unroll
        for (int ai = 0; ai < 2; ++ai)
#pragma unroll
            for (int m = 0; m < 4; ++m) { const unsigned ro = (unsigned)((ai * HALF + wr * 64 + m * 16 + fr) * D + col0);
#pragma unroll
                for (int bj = 0; bj < 2; ++bj)
#pragma unroll
                    for (int n = 0; n < 2; ++n) *(f32x4*)(base + ro + bj * HALF + n * 16) = gv[bj][n] * acc[ai][bj][m][n];
                if (m & 1) asm volatile("" ::: "memory"); }
    }
};
}
#ifndef ATT_W64
#define ATT_W64 1
#endif
namespace att {
using bf16x8 = __attribute__((ext_vector_type(8))) short;
using s16x4  = __attribute__((ext_vector_type(4))) short;
using f32x16 = __attribute__((ext_vector_type(16))) float;
using u32x4  = __attribute__((ext_vector_type(4))) unsigned;
constexpr int NW = 8, QBLK = 32, KVBLK = 64;
constexpr float SCALE = 0.10206207261596577f;
constexpr float THR = 8.f;
constexpr int SHM_K = KVBLK * 256, SHM_V = KVBLK * DV * 2, BUF = SHM_K + SHM_V, SHM_ATTN = 2 * BUF + NW * 64 * 4 + 16;
#define ATT_KSWZ(row, colB) ((row) * 256 + ((colB) ^ (((row) & 7) << 4)))
#define ATT_SBAR() __builtin_amdgcn_sched_barrier(0)
__device__ __forceinline__ int crow(int r, int hi) { return (r & 3) + 8 * (r >> 2) + 4 * hi; }
__device__ __forceinline__ unsigned cvtpk(float lo, float hi) { unsigned r; asm("v_cvt_pk_bf16_f32 %0, %1, %2" : "=v"(r) : "v"(lo), "v"(hi)); return r; }
constexpr float THRL = THR * 1.4426950408889634f;
template <bool FIRST> __device__ __forceinline__ void partialSM_a(f32x16& p0, f32x16& p1, float& m_ref, f32x16& negm, float& alpha) {
  float pmax = p0[0];
#pragma unroll
  for (int r = 1; r < 16; ++r) pmax = fmaxf(pmax, p0[r]);
#pragma unroll
  for (int r = 0; r < 16; ++r) pmax = fmaxf(pmax, p1[r]);
  { auto rr = __builtin_amdgcn_permlane32_swap(__float_as_uint(pmax), __float_as_uint(pmax), false, false);
    pmax = fmaxf(__uint_as_float(rr[0]), __uint_as_float(rr[1])); }
  if (!FIRST && __builtin_expect(__all(pmax <= THRL), 1)) { alpha = 1.f; }
  else { const float dl = FIRST ? pmax : fmaxf(pmax, 0.f); m_ref += dl; alpha = FIRST ? 1.f : __builtin_amdgcn_exp2f(-dl);
#pragma unroll
    for (int r = 0; r < 16; ++r) { p0[r] -= dl; p1[r] -= dl; }
#pragma unroll
    for (int r = 0; r < 16; ++r) negm[r] = -m_ref;
    asm volatile("" : "+v"(negm)); }
}
__device__ __forceinline__ void partialSM_b(f32x16& p0) {
#pragma unroll
  for (int r = 0; r < 16; ++r) p0[r] = __builtin_amdgcn_exp2f(p0[r]);
}
template <bool DO_EXP = true> __device__ __forceinline__ void finishSM(f32x16& p0, f32x16& p1, float alpha, float& l_reg, bf16x8& pa0, bf16x8& pa1, bf16x8& pa2, bf16x8& pa3) {
  if (DO_EXP) {
#pragma unroll
  for (int r = 0; r < 16; ++r) p1[r] = __builtin_amdgcn_exp2f(p1[r]); }
  float ps = 0;
#pragma unroll
  for (int r = 0; r < 16; ++r) ps += p0[r];
#pragma unroll
  for (int r = 0; r < 16; ++r) ps += p1[r];
  { auto rr = __builtin_amdgcn_permlane32_swap(__float_as_uint(ps), __float_as_uint(ps), false, false);
    ps = __uint_as_float(rr[0]) + __uint_as_float(rr[1]); }
  l_reg = l_reg * alpha + ps;
#define ATT_PK4(P, BASE, OUT) do { unsigned a0 = cvtpk(P[BASE + 0], P[BASE + 1]), a1 = cvtpk(P[BASE + 2], P[BASE + 3]);   \
    unsigned b0 = cvtpk(P[BASE + 4], P[BASE + 5]), b1 = cvtpk(P[BASE + 6], P[BASE + 7]);                              \
    auto r0 = __builtin_amdgcn_permlane32_swap(a0, b0, false, false); auto r1 = __builtin_amdgcn_permlane32_swap(a1, b1, false, false); \
    u32x4 w = {r0[0], r1[0], r0[1], r1[1]}; OUT = *reinterpret_cast<bf16x8*>(&w); } while (0)
  ATT_PK4(p0, 0, pa0); ATT_PK4(p0, 8, pa1); ATT_PK4(p1, 0, pa2); ATT_PK4(p1, 8, pa3);
#undef ATT_PK4
}
__device__ __forceinline__ void kload(bf16x8 (&kf)[12], const char* Ks, int r32, int hi) {
#pragma unroll
  for (int d0 = 0; d0 < DQK / 16; ++d0) { const int cb = (d0 * 16 + hi * 8) * 2;
    kf[2 * d0] = *reinterpret_cast<const bf16x8*>(Ks + ATT_KSWZ(r32, cb)); kf[2 * d0 + 1] = *reinterpret_cast<const bf16x8*>(Ks + ATT_KSWZ(32 + r32, cb)); }
}
__device__ __forceinline__ void qk_mma(f32x16& p0, f32x16& p1, const bf16x8 (&kf)[12], const bf16x8* qr, const f32x16& negm) {
  p0 = negm; p1 = negm;
#pragma unroll
  for (int d0 = 0; d0 < DQK / 16; ++d0) { p0 = __builtin_amdgcn_mfma_f32_32x32x16_bf16(kf[2 * d0], qr[d0], p0, 0, 0, 0); p1 = __builtin_amdgcn_mfma_f32_32x32x16_bf16(kf[2 * d0 + 1], qr[d0], p1, 0, 0, 0); }
}
__device__ __forceinline__ void qkt(f32x16& p0, f32x16& p1, const char* Ks, const bf16x8* qr, int r32, int hi, const f32x16& negm) { bf16x8 kf[12]; kload(kf, Ks, r32, hi); qk_mma(p0, p1, kf, qr, negm); }
__device__ __forceinline__ int v_st(int k, int c) { const int kk = (k & ~0xC) | ((k & 4) << 1) | ((k & 8) >> 1); return ((kk >> 3) * 2 + (c >> 5)) * 512 + ((kk & 7) * 32 + (c & 31)) * 2; }
__device__ __forceinline__ int v_rd_base(int lane) { return ((lane & 3) << 3) | (((lane >> 2) & 3) << 6) | (((lane >> 4) & 1) << 5) | (((lane >> 5) & 1) << 8); }
constexpr int v_rd_off(int d0, int ks, int half) { return d0 * 512 + ks * 2048 + half * 1024; }
template <int OFF> __device__ __forceinline__ s16x4 tr_read(int vb) {
  s16x4 r; asm volatile("ds_read_b64_tr_b16 %0, %1 offset:%2" : "=&v"(r) : "v"(vb), "i"(OFF) : "memory"); return r;
}
struct VFrag { s16x4 l[2][4], h[2][4]; };
__device__ __forceinline__ void vload(VFrag& v, int vb) {
#define ATT_VR(D0, KS) v.l[D0][KS] = tr_read<v_rd_off(D0, KS, 0)>(vb); v.h[D0][KS] = tr_read<v_rd_off(D0, KS, 1)>(vb);
  ATT_VR(0, 0) ATT_VR(1, 0) ATT_VR(0, 1) ATT_VR(1, 1) ATT_VR(0, 2) ATT_VR(1, 2) ATT_VR(0, 3) ATT_VR(1, 3)
#undef ATT_VR
}
__device__ __forceinline__ void pv_mma(f32x16* o, const VFrag& v, bf16x8 pa0, bf16x8 pa1, bf16x8 pa2, bf16x8 pa3) {
#define ATT_PK(L, H) (bf16x8){L[0], L[1], L[2], L[3], H[0], H[1], H[2], H[3]}
  o[0] = __builtin_amdgcn_mfma_f32_32x32x16_bf16(pa0, ATT_PK(v.l[0][0], v.h[0][0]), o[0], 0, 0, 0); o[1] = __builtin_amdgcn_mfma_f32_32x32x16_bf16(pa0, ATT_PK(v.l[1][0], v.h[1][0]), o[1], 0, 0, 0);
  o[0] = __builtin_amdgcn_mfma_f32_32x32x16_bf16(pa1, ATT_PK(v.l[0][1], v.h[0][1]), o[0], 0, 0, 0); o[1] = __builtin_amdgcn_mfma_f32_32x32x16_bf16(pa1, ATT_PK(v.l[1][1], v.h[1][1]), o[1], 0, 0, 0);
  o[0] = __builtin_amdgcn_mfma_f32_32x32x16_bf16(pa2, ATT_PK(v.l[0][2], v.h[0][2]), o[0], 0, 0, 0); o[1] = __builtin_amdgcn_mfma_f32_32x32x16_bf16(pa2, ATT_PK(v.l[1][2], v.h[1][2]), o[1], 0, 0, 0);
  o[0] = __builtin_amdgcn_mfma_f32_32x32x16_bf16(pa3, ATT_PK(v.l[0][3], v.h[0][3]), o[0], 0, 0, 0); o[1] = __builtin_amdgcn_mfma_f32_32x32x16_bf16(pa3, ATT_PK(v.l[1][3], v.h[1][3]), o[1], 0, 0, 0);
#undef ATT_PK
}
__device__ __forceinline__ void pv_d0(f32x16* o, int vb, bf16x8 pa0, bf16x8 pa1, bf16x8 pa2, bf16x8 pa3) {
  VFrag v; vload(v, vb); asm volatile("s_waitcnt lgkmcnt(0)" ::: "memory"); ATT_SBAR(); pv_mma(o, v, pa0, pa1, pa2, pa3);
}
#define ATT_SEGB(P0, P1, AL, VB) do { VFrag v_; if (!(STRIP & 4)) vload(v_, (VB)); else { _Pragma("unroll") for (int a_ = 0; a_ < 2; ++a_) _Pragma("unroll") for (int b_ = 0; b_ < 4; ++b_) { v_.l[a_][b_] = (s16x4){pa0[0], pa1[1], pa2[2], pa3[3]}; v_.h[a_][b_] = (s16x4){pa0[4], pa1[5], pa2[6], pa3[7]}; } } \
    if (!FAST) partialSM_a<false>(P0, P1, m_ref, negm, AL); asm volatile("s_waitcnt lgkmcnt(0)" ::: "memory"); ATT_SBAR(); \
    pv_mma(o, v_, pa0, pa1, pa2, pa3); if (!(STRIP & 1)) partialSM_b(P0); } while (0)
template <bool FAST, int STRIP = 0> __device__ __forceinline__ bool attn_unit(const unsigned short* __restrict__ Qb, const unsigned short* __restrict__ KVh, unsigned short* __restrict__ Ob, int seq, char* lds, int tid) {
  const int wid = __builtin_amdgcn_readfirstlane(tid >> 6), lane = tid & 63, r32 = lane & 31, hi = lane >> 5;
  float* ws = (float*)(lds + 2 * BUF) + wid * 64; float* li_l = ws; float* al_l = ws + 32; unsigned* okflag = (unsigned*)(lds + 2 * BUF + NW * 64 * 4);
  if (FAST && tid == 0) *okflag = 0u;
  float m_ref = 0.f, l_reg = 0; f32x16 o[2] = {}; f32x16 negm = {}; bf16x8 qr[DQK / 16];
  { const unsigned qoff = (unsigned)((wid * QBLK + r32) * 768 + hi * 8);
#pragma unroll
    for (int d0 = 0; d0 < DQK / 16; ++d0) qr[d0] = *reinterpret_cast<const bf16x8*>(Qb + qoff + d0 * 16); }
  int dst[3];
#pragma unroll
  for (int i = 0; i < 3; ++i) { const int c = tid + 512 * i, row = c / 20, part = c % 20; dst[i] = part < 12 ? ATT_KSWZ(row, part * 16) : SHM_K + v_st(row, (part - 12) * 8); }
  const bool third = wid < 4;
  const char* kvb = (const char*)KVh; const unsigned voff = (unsigned)tid * 16u; const unsigned off2 = third ? 16384u : 0u;
  const int vb0 = (int)(uintptr_t)(lds + SHM_K) + v_rd_base(lane);
  bf16x8 sA0, sA1, sA2, sB0, sB1, sB2;
#define ATT_SLOAD(S, k0) do { const char* p_ = kvb + (long)(k0) * (KVW * 2);     \
    S##0 = *reinterpret_cast<const bf16x8*>(p_ + voff); S##1 = *reinterpret_cast<const bf16x8*>(p_ + 8192 + voff); S##2 = *reinterpret_cast<const bf16x8*>(p_ + off2 + voff); } while (0)
#define ATT_SWRITE(b, S) do { char* q_ = lds + (b) * BUF; *reinterpret_cast<bf16x8*>(q_ + dst[0]) = S##0; *reinterpret_cast<bf16x8*>(q_ + dst[1]) = S##1; \
    if (third) *reinterpret_cast<bf16x8*>(q_ + dst[2]) = S##2; } while (0)
#define ATT_RESC(a) do { if (!FAST && __any((a) < 1.f)) { if (hi == 0) al_l[r32] = (a); asm volatile("s_waitcnt lgkmcnt(0)" ::: "memory"); \
    _Pragma("unroll") for (int d = 0; d < 2; ++d) _Pragma("unroll") for (int r = 0; r < 16; ++r) o[d][r] *= al_l[crow(r, hi)]; } } while (0)
#define ATT_FIN(P0, P1, AL) do { if (!(STRIP & 1)) finishSM(P0, P1, AL, l_reg, pa0, pa1, pa2, pa3); else { u32x4 w0_ = {__float_as_uint(P0[0]), __float_as_uint(P0[1]), __float_as_uint(P0[2]), __float_as_uint(P0[3])}, w1_ = {__float_as_uint(P0[4]), __float_as_uint(P0[5]), __float_as_uint(P0[6]), __float_as_uint(P0[7])}, \
           w2_ = {__float_as_uint(P1[0]), __float_as_uint(P1[1]), __float_as_uint(P1[2]), __float_as_uint(P1[3])}, w3_ = {__float_as_uint(P1[4]), __float_as_uint(P1[5]), __float_as_uint(P1[6]), __float_as_uint(P1[7])}; \
           pa0 = *reinterpret_cast<bf16x8*>(&w0_); pa1 = *reinterpret_cast<bf16x8*>(&w1_); pa2 = *reinterpret_cast<bf16x8*>(&w2_); pa3 = *reinterpret_cast<bf16x8*>(&w3_); l_reg += P1[8]; } } while (0)
#define ATT_QKT(P0, P1, KS) do { bf16x8 kf_[12]; if (!(STRIP & 16)) kload(kf_, (KS), r32, hi); else { _Pragma("unroll") for (int i_ = 0; i_ < 12; ++i_) kf_[i_] = qr[i_ % 6]; } qk_mma(P0, P1, kf_, qr, negm); } while (0)
  f32x16 pA0, pA1, pB0, pB1; float alA = 1.f, alB = 1.f; bf16x8 pa0, pa1, pa2, pa3; const int NT = seq / KVBLK;
  ATT_SLOAD(sA, 0); ATT_SWRITE(0, sA); __syncthreads();
  ATT_QKT(pA0, pA1, lds); partialSM_a<true>(pA0, pA1, m_ref, negm, alA); partialSM_b(pA0);
  ATT_SLOAD(sB, KVBLK); if (2 < NT) ATT_SLOAD(sA, 2 * KVBLK);
  ATT_SWRITE(1, sB); __syncthreads();
#define ATT_LBAR() do { if (!(STRIP & 8)) __syncthreads(); } while (0)
  for (int j = 1; j + 1 < NT; j += 2) {
    ATT_SBAR(); if (!(STRIP & 2)) ATT_SLOAD(sB, (STRIP & 32) ? 0 : (j + 2) * KVBLK); ATT_SBAR();
    ATT_QKT(pB0, pB1, lds + BUF);
    ATT_FIN(pA0, pA1, alA); ATT_SBAR();
    ATT_SEGB(pB0, pB1, alB, vb0);
    ATT_LBAR(); if (!(STRIP & 2)) ATT_SWRITE(0, sA);
    ATT_RESC(alB); ATT_LBAR();
    ATT_SBAR(); if (!(STRIP & 2) && j + 3 < NT) ATT_SLOAD(sA, (STRIP & 32) ? 0 : (j + 3) * KVBLK); ATT_SBAR();
    ATT_QKT(pA0, pA1, lds);
    ATT_FIN(pB0, pB1, alB); ATT_SBAR();
    ATT_SEGB(pA0, pA1, alA, vb0 + BUF);
    ATT_LBAR(); if (!(STRIP & 2)) ATT_SWRITE(1, sB);
    ATT_RESC(alA); ATT_LBAR();
  }
#undef ATT_LBAR
  ATT_SBAR(); ATT_QKT(pB0, pB1, lds + BUF);
  ATT_FIN(pA0, pA1, alA); ATT_SBAR();
  ATT_SEGB(pB0, pB1, alB, vb0);
  __syncthreads(); ATT_RESC(alB);
  ATT_FIN(pB0, pB1, alB); ATT_SBAR();
  pv_d0(o, vb0 + BUF, pa0, pa1, pa2, pa3);
  if (FAST) { const bool bad = !(l_reg < 1.3e36f);
    if (__any(bad) && lane == 0) *okflag = 1u;
    __syncthreads(); if (*okflag != 0u) { __syncthreads(); return false; } }
  if (hi == 0) li_l[r32] = l_reg; asm volatile("s_waitcnt lgkmcnt(0)" ::: "memory");
  float rli[16];
#pragma unroll
  for (int r = 0; r < 16; ++r) rli[r] = __builtin_amdgcn_rcpf(li_l[crow(r, hi)]);
  unsigned short* Ow = Ob + (long)(wid * QBLK) * D;
#pragma unroll
  for (int r = 0; r < 16; ++r) { const int orow = crow(r, hi);
    *reinterpret_cast<unsigned*>(Ow + (long)orow * D + 2 * r32) = cvtpk(o[0][r] * rli[r], o[1][r] * rli[r]); }
  __syncthreads();
  return true;
#undef ATT_QKT
#undef ATT_FIN
#undef ATT_SLOAD
#undef ATT_SWRITE
#undef ATT_RESC
}
constexpr int PKP = 192, PSHK = KVBLK * PKP, PBUF = PSHK + SHM_V;
#ifndef ATT_PNB
#define ATT_PNB 5
#endif
constexpr int PNB = ATT_PNB;
#ifdef ATT_PP_SETPRIO
#define PP_PRIO(x) __builtin_amdgcn_s_setprio(x)
#else
#define PP_PRIO(x) do {} while (0)
#endif
typedef __attribute__((address_space(3))) unsigned lds_u32;
typedef __attribute__((address_space(3))) unsigned char lds_u8;
__device__ __forceinline__ void kload_pp(bf16x8 (&kf)[12], const char* Ks, int kbe, int kbo) {
#pragma unroll
  for (int d0 = 0; d0 < DQK / 16; ++d0) { const int a = ((d0 & 1) ? kbo : kbe) + (d0 >> 1) * 64;
    kf[2 * d0] = *reinterpret_cast<const bf16x8*>(Ks + a); kf[2 * d0 + 1] = *reinterpret_cast<const bf16x8*>(Ks + a + 32 * PKP); }
}
template <int STRIP = 0> __device__ __forceinline__ bool attn_unit_pp(const unsigned short* __restrict__ Qb, const unsigned short* __restrict__ KVh, unsigned short* __restrict__ Ob, int seq, lds_u8* ldsl, int tid) {
  char* lds = (char*)ldsl;
  const int wid = __builtin_amdgcn_readfirstlane(tid >> 6), lane = tid & 63, r32 = lane & 31, hi = lane >> 5;
  float* ws = (float*)(lds + PNB * PBUF) + wid * 64; float* li_l = ws; unsigned* okflag = (unsigned*)(lds + PNB * PBUF + NW * 64 * 4);
  if (tid == 0) *okflag = 0u;
  float m_ref = 0.f, l_reg = 0.f, alpha = 1.f; f32x16 o[2] = {}; f32x16 negm = {}; bf16x8 qr[DQK / 16];
  { const unsigned qoff = (unsigned)((wid * QBLK + r32) * 768 + hi * 8);
#pragma unroll
    for (int d0 = 0; d0 < DQK / 16; ++d0) qr[d0] = *reinterpret_cast<const bf16x8*>(Qb + qoff + d0 * 16); }
  const bool third = wid < 4;
  unsigned g0, g1, g2;
  { const int q0 = wid * 64 + lane, r0 = q0 / 12, s0 = q0 % 12; g0 = (unsigned)(r0 * (KVW * 2) + ((s0 ^ ((r0 >> 2) & 3)) << 4));
    const int q1 = (wid + 8) * 64 + lane, r1 = q1 / 12, s1 = q1 % 12; const unsigned g1k = (unsigned)(r1 * (KVW * 2) + ((s1 ^ ((r1 >> 2) & 3)) << 4));
    const int v1 = (wid - 4) * 64 + lane, v2 = (wid + 4) * 64 + lane;
    auto vsrc = [](int v) { const int sub = v >> 5, w = v & 31, kk = (sub >> 1) * 8 + (w >> 2), k = (kk & ~0xC) | ((kk & 4) << 1) | ((kk & 8) >> 1), c = (sub & 1) * 32 + (w & 3) * 8; return (unsigned)(k * (KVW * 2) + 192 + c * 2); };
    g1 = third ? g1k : vsrc(v1); g2 = vsrc(v2 & 511); }
  const int fsw = (r32 >> 2) & 3; const int kbe = r32 * PKP + ((hi ^ fsw) << 4), kbo = r32 * PKP + (((2 + hi) ^ fsw) << 4);
  const int vb0 = (int)(uintptr_t)(lds + PSHK) + v_rd_base(lane);
  const char* kvb = (const char*)KVh; const int NT = seq / KVBLK;
#define PP_DMA(T, OFF) do { const char* tb_ = kvb + (long)(T) * (KVBLK * KVW * 2); lds_u8* sb_ = ldsl + (OFF) + wid * 1024; \
    __builtin_amdgcn_global_load_lds((const unsigned*)(tb_ + g0), (lds_u32*)sb_, 16, 0, 0); \
    __builtin_amdgcn_global_load_lds((const unsigned*)(tb_ + g1), (lds_u32*)(sb_ + 8192), 16, 0, 0); \
    if (third) __builtin_amdgcn_global_load_lds((const unsigned*)(tb_ + g2), (lds_u32*)(sb_ + 16384), 16, 0, 0); } while (0)
#define PP_WAITV() do { if (third) asm volatile("s_waitcnt vmcnt(%0)" :: "n"(3 * (PNB - 3)) : "memory"); else asm volatile("s_waitcnt vmcnt(%0)" :: "n"(2 * (PNB - 3)) : "memory"); } while (0)
  f32x16 p0, p1; bf16x8 pa0, pa1, pa2, pa3; bf16x8 kf[12]; VFrag vf;
#pragma unroll
  for (int T = 0; T < PNB - 1; ++T) { const int Tc = T < NT ? T : NT - 1; PP_DMA(Tc, T * PBUF); }
  PP_WAITV();
  __builtin_amdgcn_s_barrier();
  kload_pp(kf, lds, kbe, kbo); if (STRIP & 4) vload(vf, vb0); asm volatile("s_waitcnt lgkmcnt(0)" ::: "memory");
  if (wid >= 4) __builtin_amdgcn_s_barrier();
  int oK = PBUF, oV = 0, oD = (PNB - 1) * PBUF;
#define PP_ADV(x) do { x += PBUF; if (x == PNB * PBUF) x = 0; } while (0)
#define PP_LSEG(FIRST_, t_) do { ATT_SBAR(); if (!(STRIP & 4)) { kload_pp(kf, lds + oK, kbe, kbo); vload(vf, vb0 + oV); } ATT_SBAR(); \
    if (!(STRIP & 2) && (t_) + PNB - 1 < NT) { PP_DMA((t_) + PNB - 1, oD); } ATT_SBAR(); \
    if (FIRST_) partialSM_a<true>(p0, p1, m_ref, negm, alpha); \
    if (!(STRIP & 1)) { partialSM_b(p0); finishSM(p0, p1, 1.f, l_reg, pa0, pa1, pa2, pa3); } \
    else { u32x4 w0_ = {__float_as_uint(p0[0]), __float_as_uint(p0[1]), __float_as_uint(p0[2]), __float_as_uint(p0[3])}, w1_ = {__float_as_uint(p0[4]), __float_as_uint(p0[5]), __float_as_uint(p0[6]), __float_as_uint(p0[7])}, \
           w2_ = {__float_as_uint(p1[0]), __float_as_uint(p1[1]), __float_as_uint(p1[2]), __float_as_uint(p1[3])}, w3_ = {__float_as_uint(p1[4]), __float_as_uint(p1[5]), __float_as_uint(p1[6]), __float_as_uint(p1[7])}; \
           pa0 = *reinterpret_cast<bf16x8*>(&w0_); pa1 = *reinterpret_cast<bf16x8*>(&w1_); pa2 = *reinterpret_cast<bf16x8*>(&w2_); pa3 = *reinterpret_cast<bf16x8*>(&w3_); l_reg += p1[8]; } ATT_SBAR(); \
    if ((t_) + PNB - 1 < NT) PP_WAITV(); else asm volatile("s_waitcnt vmcnt(0)" ::: "memory"); \
    asm volatile("s_waitcnt lgkmcnt(0)" ::: "memory"); ATT_SBAR(); __builtin_amdgcn_s_barrier(); ATT_SBAR(); PP_ADV(oK); PP_ADV(oV); PP_ADV(oD); } while (0)
  PP_PRIO(1); qk_mma(p0, p1, kf, qr, negm); PP_PRIO(0); ATT_SBAR(); __builtin_amdgcn_s_barrier(); ATT_SBAR();
  PP_LSEG(true, 0);
#pragma unroll 1
  for (int t = 1; t < NT; ++t) {
    if (!(STRIP & 8)) { PP_PRIO(1); qk_mma(p0, p1, kf, qr, negm); pv_mma(o, vf, pa0, pa1, pa2, pa3); PP_PRIO(0); }
    else { _Pragma("unroll") for (int i_ = 0; i_ < 12; ++i_) asm volatile("" :: "v"(kf[i_])); asm volatile("" :: "v"(vf.l[0][0]), "v"(vf.h[1][3]), "v"(pa0), "v"(pa1), "v"(pa2), "v"(pa3)); asm volatile("" : "+v"(p0), "+v"(p1)); }
    ATT_SBAR(); __builtin_amdgcn_s_barrier(); ATT_SBAR();
    PP_LSEG(false, t);
  }
  PP_PRIO(1); pv_mma(o, vf, pa0, pa1, pa2, pa3); PP_PRIO(0); ATT_SBAR();
  if (wid < 4) __builtin_amdgcn_s_barrier();
  { const bool bad = !(l_reg < 1.3e36f);
    if (__any(bad) && lane == 0) *okflag = 1u;
    __syncthreads(); if (*okflag != 0u) { __syncthreads(); return false; } }
  if (hi == 0) li_l[r32] = l_reg; asm volatile("s_waitcnt lgkmcnt(0)" ::: "memory");
  float rli[16];
#pragma unroll
  for (int r = 0; r < 16; ++r) rli[r] = __builtin_amdgcn_rcpf(li_l[crow(r, hi)]);
  unsigned short* Ow = Ob + (long)(wid * QBLK) * D;
#pragma unroll
  for (int r = 0; r < 16; ++r) { const int orow = crow(r, hi);
    *reinterpret_cast<unsigned*>(Ow + (long)orow * D + 2 * r32) = cvtpk(o[0][r] * rli[r], o[1][r] * rli[r]); }
  __syncthreads();
  return true;
#undef PP_DMA
#undef PP_WAITV
#undef PP_ADV
#undef PP_LSEG
}
#ifndef ATT_WNB
#define ATT_WNB 4
#endif
constexpr int WNB = ATT_WNB;
__device__ __forceinline__ bool attn_unit_w64(const unsigned short* __restrict__ Qb, const unsigned short* __restrict__ KVh, unsigned short* __restrict__ Ob, int seq, lds_u8* ldsl, int tid) {
  char* lds = (char*)ldsl;
  const int wid = __builtin_amdgcn_readfirstlane(tid >> 6), lane = tid & 63, r32 = lane & 31, hi = lane >> 5;
  float* ws = (float*)(lds + WNB * PBUF) + wid * 64; unsigned* okflag = (unsigned*)(lds + WNB * PBUF + NW * 64 * 4);
  if (tid == 0) *okflag = 0u;
  float lA = 0.f, lB = 0.f; f32x16 oA[2] = {}, oB[2] = {}; const f32x16 zero = {}; bf16x8 qA[DQK / 16], qB[DQK / 16];
  { const unsigned qoff = (unsigned)((wid * 64 + r32) * 768 + hi * 8);
#pragma unroll
    for (int d0 = 0; d0 < DQK / 16; ++d0) { qA[d0] = *reinterpret_cast<const bf16x8*>(Qb + qoff + d0 * 16); qB[d0] = *reinterpret_cast<const bf16x8*>(Qb + qoff + 32 * 768 + d0 * 16); } }
  const bool third = wid < 4;
  unsigned g0, g1, g2;
  { const int q0 = wid * 64 + lane, r0 = q0 / 12, s0 = q0 % 12; g0 = (unsigned)(r0 * (KVW * 2) + ((s0 ^ ((r0 >> 2) & 3)) << 4));
    const int q1 = (wid + 8) * 64 + lane, r1 = q1 / 12, s1 = q1 % 12; const unsigned g1k = (unsigned)(r1 * (KVW * 2) + ((s1 ^ ((r1 >> 2) & 3)) << 4));
    const int v1 = (wid - 4) * 64 + lane, v2 = (wid + 4) * 64 + lane;
    auto vsrc = [](int v) { const int sub = v >> 5, w = v & 31, kk = (sub >> 1) * 8 + (w >> 2), k = (kk & ~0xC) | ((kk & 4) << 1) | ((kk & 8) >> 1), c = (sub & 1) * 32 + (w & 3) * 8; return (unsigned)(k * (KVW * 2) + 192 + c * 2); };
    g1 = third ? g1k : vsrc(v1 & 511); g2 = vsrc(v2 & 511); }
  const int fsw = (r32 >> 2) & 3; const int kbe = r32 * PKP + ((hi ^ fsw) << 4), kbo = r32 * PKP + (((2 + hi) ^ fsw) << 4);
  const int vb0 = (int)(uintptr_t)(lds + PSHK) + v_rd_base(lane);
  const char* kvb = (const char*)KVh; const int NT = seq / KVBLK;
#define W64_DMA(T, OFF) do { const char* tb_ = kvb + (long)(T) * (KVBLK * KVW * 2); lds_u8* sb_ = ldsl + (OFF) + wid * 1024; \
    __builtin_amdgcn_global_load_lds((const unsigned*)(tb_ + g0), (lds_u32*)sb_, 16, 0, 0); \
    __builtin_amdgcn_global_load_lds((const unsigned*)(tb_ + g1), (lds_u32*)(sb_ + 8192), 16, 0, 0); \
    if (third) __builtin_amdgcn_global_load_lds((const unsigned*)(tb_ + g2), (lds_u32*)(sb_ + 16384), 16, 0, 0); } while (0)
#define W64_WAITV() do { if (third) asm volatile("s_waitcnt vmcnt(%0)" :: "n"(3 * (WNB - 2)) : "memory"); else asm volatile("s_waitcnt vmcnt(%0)" :: "n"(2 * (WNB - 2)) : "memory"); } while (0)
#pragma unroll
  for (int T = 0; T < WNB; ++T) { const int Tc = T < NT ? T : NT - 1; W64_DMA(Tc, T * PBUF); }
  f32x16 pA0, pA1, pB0, pB1; bf16x8 pa0, pa1, pa2, pa3, pb0, pb1, pb2, pb3; bf16x8 kf[12];
  if (third) asm volatile("s_waitcnt vmcnt(%0)" :: "n"(3 * (WNB - 1)) : "memory"); else asm volatile("s_waitcnt vmcnt(%0)" :: "n"(2 * (WNB - 1)) : "memory");
  __builtin_amdgcn_s_barrier(); ATT_SBAR();
  kload_pp(kf, lds, kbe, kbo);
#ifdef W64_V1
  if (wid >= 4) __builtin_amdgcn_s_setprio(1);
#endif
  int oT = 0;
#pragma unroll 1
  for (int t = 0; t < NT; ++t) {
    ATT_SBAR(); qk_mma(pA0, pA1, kf, qA, zero);
    qk_mma(pB0, pB1, kf, qB, zero); partialSM_b(pA0); finishSM(pA0, pA1, 1.f, lA, pa0, pa1, pa2, pa3); ATT_SBAR();
    VFrag vf; vload(vf, vb0 + oT); ATT_SBAR();
    partialSM_b(pB0); partialSM_b(pB1); asm volatile("s_waitcnt lgkmcnt(0)" ::: "memory"); ATT_SBAR();
    pv_mma(oA, vf, pa0, pa1, pa2, pa3); finishSM<false>(pB0, pB1, 1.f, lB, pb0, pb1, pb2, pb3); ATT_SBAR();

    if (t + WNB - 1 < NT) W64_WAITV(); else asm volatile("s_waitcnt vmcnt(0)" ::: "memory");
    __builtin_amdgcn_s_barrier(); ATT_SBAR();
    if (t + WNB < NT) W64_DMA(t + WNB, oT);
    oT += PBUF; if (oT == WNB * PBUF) oT = 0;
    ATT_SBAR(); kload_pp(kf, lds + oT, kbe, kbo); ATT_SBAR();
    pv_mma(oB, vf, pb0, pb1, pb2, pb3); ATT_SBAR();
  }
#ifdef ATT_W64_CHECK_FALLBACK
  lA = -1.f;
#endif
#ifdef W64_V1
  __builtin_amdgcn_s_setprio(0);
#endif
  { const bool bad = !(lA < 1.3e36f) || !(lA > 1e-30f) || !(lB < 1.3e36f) || !(lB > 1e-30f);
    if (__any(bad) && lane == 0) *okflag = 1u;
    __syncthreads(); if (*okflag != 0u) { __syncthreads(); return false; } }
  if (hi == 0) { ws[r32] = lA; ws[32 + r32] = lB; } asm volatile("s_waitcnt lgkmcnt(0)" ::: "memory");
  unsigned short* Ow = Ob + (long)(wid * 64) * D;
#pragma unroll
  for (int r = 0; r < 16; ++r) { const int orow = crow(r, hi); const float ra = __builtin_amdgcn_rcpf(ws[orow]), rb = __builtin_amdgcn_rcpf(ws[32 + orow]);
    *reinterpret_cast<unsigned*>(Ow + (long)orow * D + 2 * r32) = cvtpk(oA[0][r] * ra, oA[1][r] * ra);
    *reinterpret_cast<unsigned*>(Ow + (long)(32 + orow) * D + 2 * r32) = cvtpk(oB[0][r] * rb, oB[1][r] * rb); }
  __syncthreads();
  return true;
#undef W64_DMA
#undef W64_WAITV
}
#undef ATT_SEGB
#undef ATT_KSWZ
#undef ATT_SBAR
}
#define GAS __attribute__((address_space(1)))
#define LAS __attribute__((address_space(3)))
typedef unsigned short bf16;
typedef unsigned v4u __attribute__((ext_vector_type(4)));
typedef unsigned v2u __attribute__((ext_vector_type(2)));
typedef float f32x4 __attribute__((ext_vector_type(4)));
typedef short bf16x8 __attribute__((ext_vector_type(8)));
typedef GAS unsigned gu32;
typedef GAS unsigned long long gu64;
#define RLX_AGENT __ATOMIC_RELAXED, __HIP_MEMORY_SCOPE_AGENT
#define LDS_WAIT() asm volatile("s_waitcnt lgkmcnt(0)" ::: "memory")
#define VM_WAIT() asm volatile("s_waitcnt vmcnt(0)" ::: "memory")
__device__ __forceinline__ unsigned long long rt() { return __builtin_amdgcn_s_memrealtime(); }
__device__ __forceinline__ unsigned f2bf(float f) { unsigned u = __builtin_bit_cast(unsigned, f); return (u + 0x7fffu + ((u >> 16) & 1u)) >> 16; }
__device__ __forceinline__ unsigned pk2(float lo, float hi) { return f2bf(lo) | (f2bf(hi) << 16); }

#define XB_TMO      128
#define XB_XCNT(j)  (256  + 64 * (j))
#define XB_XSUB(j)  (1280 + 64 * (j))
#define XB_XGEN(j)  (2304 + 64 * (j))
#define XB_TOP      3328
#define XB_TOPGEN   3392
#define XCD_BAR_WORDS 3456
#define XB_SPIN_CAP (1u << 18)

__device__ __forceinline__ unsigned xb_ld(unsigned* p)              { return __hip_atomic_load(p, __ATOMIC_RELAXED, __HIP_MEMORY_SCOPE_AGENT); }
__device__ __forceinline__ unsigned xb_add(unsigned* p, unsigned v) { return __hip_atomic_fetch_add(p, v, __ATOMIC_RELAXED, __HIP_MEMORY_SCOPE_AGENT); }
__device__ __forceinline__ unsigned xb_xcc_id() { return (unsigned)__builtin_amdgcn_s_getreg((3 << 11) | 20) & 0xFu; }
#define XB_SPIN(cond, bar) do { unsigned _sp = 0; while (cond) { __builtin_amdgcn_s_sleep(1); \
    if ((++_sp & 255u) == 0u) { if (xb_ld(&(bar)[XB_TMO])) break; if (_sp > XB_SPIN_CAP) { atomicAdd(&(bar)[XB_TMO], 1u); break; } } } } while (0)

struct XcdBarrier {
    unsigned* bar; unsigned x;
    volatile LAS unsigned* st;
};

__device__ __forceinline__ XcdBarrier xcd_barrier_post(unsigned* bar, volatile LAS unsigned* st) {
    XcdBarrier b; b.bar = bar; b.x = xb_xcc_id(); b.st = st;
    if (threadIdx.x == 0) (void)xb_add(&bar[XB_XCNT(b.x)], 1u);
    return b;
}
__device__ __forceinline__ void xcd_barrier_complete(unsigned* bar, unsigned x, unsigned& nloc, unsigned& nx) {
    const unsigned G = gridDim.x * gridDim.y * gridDim.z;
    unsigned sum, cnt, mine, sp = 0u;
    for (;;) {
        sum = 0u; cnt = 0u; mine = 0u;
#pragma unroll
        for (unsigned j = 0; j < 16; ++j) { const unsigned c = xb_ld(&bar[XB_XCNT(j)]); sum += c; cnt += (c > 0u) ? 1u : 0u; mine = (j == x) ? c : mine; }
        if (sum == G) break;
        __builtin_amdgcn_s_sleep(1);
        if ((++sp & 255u) == 0u) { if (xb_ld(&bar[XB_TMO])) break; if (sp > XB_SPIN_CAP) { atomicAdd(&bar[XB_TMO], 1u); break; } }
    }
    nloc = mine > 0u ? mine : 1u; nx = cnt > 0u ? cnt : 1u;
}

__device__ __forceinline__ void xcd_barrier(const XcdBarrier& b, const bool leader_thread  ) {
    asm volatile("s_waitcnt vmcnt(0)" ::: "memory");
    __syncthreads();
    if (leader_thread) {
        unsigned* bar = b.bar;
        __builtin_amdgcn_s_waitcnt(0);
        unsigned nloc = b.st[0], nx = b.st[1];
        if (nloc == 0u) { xcd_barrier_complete(bar, b.x, nloc, nx); b.st[0] = nloc; b.st[1] = nx; }
        const unsigned old = xb_add(&bar[XB_XSUB(b.x)], 1u);
        const unsigned gen = old / nloc;
        if (old + 1u == (gen + 1u) * nloc) {
            __builtin_amdgcn_fence(__ATOMIC_RELEASE, "agent");
            asm volatile("s_waitcnt vmcnt(0)" ::: "memory");
            const unsigned og = xb_add(&bar[XB_TOP], 1u);
            const unsigned tg = og / nx;
            if (og + 1u == (tg + 1u) * nx) xb_add(&bar[XB_TOPGEN], 1u);
            else XB_SPIN(xb_ld(&bar[XB_TOPGEN]) == tg, bar);
            __builtin_amdgcn_fence(__ATOMIC_ACQUIRE, "agent");
            xb_add(&bar[XB_XGEN(b.x)], 1u);
            asm volatile("s_waitcnt vmcnt(0)" ::: "memory");
        } else {
            XB_SPIN(xb_ld(&bar[XB_XGEN(b.x)]) == gen, bar);
            __builtin_amdgcn_fence(__ATOMIC_ACQUIRE, "agent");
            asm volatile("s_waitcnt vmcnt(0)" ::: "memory");
        }
    }
    __syncthreads();
}
constexpr size_t MiB = 1u << 20;
constexpr size_t al4k(size_t x) { return (x + 4095) & ~(size_t)4095; }
constexpr int NFT = 260;
constexpr int XS_TILES = 268, HS_TILES = 140, MOE_CHUNK0 = 128;
constexpr size_t WS_CTL = 0, CTL_BYTES = 1 * MiB;
constexpr size_t WS_MODS = WS_CTL + CTL_BYTES;
constexpr size_t WS_ROPEC = WS_MODS + al4k((size_t)DEPTH * 3 * 6 * D * 4);
constexpr size_t WS_ROPES = WS_ROPEC + al4k((size_t)SEQ * 16 * 4);
constexpr size_t WS_RSQ = WS_ROPES + al4k((size_t)SEQ * 16 * 4);
constexpr size_t WS_RSKV = WS_RSQ + al4k((size_t)MT * 4);
constexpr size_t WS_FPART = WS_RSKV + al4k((size_t)MT * 4);
constexpr size_t WS_TOKE = WS_FPART + al4k((size_t)NFT * 512 * 4);
constexpr size_t WS_TOKP = WS_TOKE + al4k((size_t)MT * 4);
constexpr size_t WS_TOKG = WS_TOKP + al4k((size_t)MT * 8);
constexpr size_t WS_XC = WS_TOKG + al4k((size_t)MT * 8);
constexpr size_t WS_WIN = WS_XC + al4k((size_t)NCTX * D * 4);
constexpr size_t WS_WUQ = WS_WIN + al4k((size_t)DEPTH * UW * D * 2);
constexpr size_t WS_WUKV = WS_WUQ + al4k((size_t)DEPTH * 768 * 384 * 2);
constexpr size_t WS_WPOOL = WS_WUKV + al4k((size_t)DEPTH * 1024 * 256 * 2);
constexpr size_t WS_WOUT = WS_WPOOL + al4k((size_t)DEPTH * 256 * 256 * 2);
constexpr size_t WS_WGU = WS_WOUT + al4k((size_t)DEPTH * D * D * 2);
constexpr size_t WS_WD = WS_WGU + al4k((size_t)2 * 2 * FF * D * 2);
constexpr size_t WS_MGU = WS_WD + al4k((size_t)2 * D * FF * 2);
constexpr size_t WS_MD = WS_MGU + al4k((size_t)2 * NEXP * 2 * FF * D * 2);
constexpr size_t WS_HF = WS_MD + al4k((size_t)2 * NEXP * D * FF * 2);
constexpr size_t WS_HFC = WS_HF + al4k((size_t)512 * SEQ * 4);
constexpr size_t WS_HN = WS_HFC + al4k((size_t)512 * CTXL * 4);
constexpr size_t WS_U = WS_HN + al4k((size_t)MT * D * 2);
constexpr size_t WS_DP = WS_U + al4k((size_t)MT * UW * 2);
constexpr size_t WS_Q = WS_DP + al4k((size_t)MT * 256 * 2);
constexpr size_t WS_KV = WS_Q + al4k((size_t)MT * 768 * 2);
constexpr size_t WS_MIX = WS_KV + al4k((size_t)NB * NHEAD * NKEY * KVW * 2);
constexpr size_t WS_ZT = WS_MIX + al4k((size_t)MT * D * 2);
constexpr size_t WS_ZCT = WS_ZT + al4k((size_t)NB * 256 * SEQ * 4);
constexpr size_t WS_YT = WS_ZCT + al4k((size_t)NB * 256 * CTXL * 4);
constexpr size_t WS_SLAB = WS_YT + al4k((size_t)NB * 256 * SEQ * 4);
constexpr size_t WS_END = WS_SLAB + al4k((size_t)4 * NCTX * D * 4);
constexpr size_t WS_H = WS_U;
constexpr size_t WS_XS = WS_U;
constexpr size_t WS_HS = WS_XS + al4k((size_t)XS_TILES * 256 * D * 2);
static_assert(WS_H + (size_t)MT * FF * 2 <= WS_KV + (size_t)NB * NHEAD * NKEY * KVW * 2, "dense hidden overlay");
static_assert(WS_HS + (size_t)HS_TILES * 256 * FF * 2 <= WS_END, "MoE overlay");
constexpr int CW_TMO = 0, CW_BAR = 4096, CW_GCNT = 16384;
constexpr int RING_BYTES = 131072, MISC_OFF = RING_BYTES + 320, LDS_BYTES = 147456;

struct Args { const float* in[34]; float* out; unsigned char* ws; int ph_lo, ph_hi; };
enum { I_X = 0, I_C, I_CTX, I_CCTX, I_N1G, I_N2G, I_WADA, I_BADA, I_WIN, I_HSW, I_HSB, I_FW1, I_FB1, I_FF1, I_FW2, I_FB2, I_FF2, I_FW3, I_HBIAS, I_POOLW, I_POOLS, I_QNG, I_WUQ, I_KVNG, I_WUKV,
       I_WOUT, I_FWG, I_FWU, I_FWD, I_ROUTER, I_MWG, I_MWU, I_MWD, I_FING };

struct Ctx {
    float* out; unsigned char* ws; LAS unsigned char* lds; volatile LAS unsigned* MISC;
    __device__ __forceinline__ const float* in(int k) const { const __attribute__((address_space(4))) Args* a = (const __attribute__((address_space(4))) Args*)__builtin_amdgcn_kernarg_segment_ptr();
        asm volatile("" : "+s"(a)); return (const float*)(const GAS float*)a->in[k]; }
    int tid, lane, wave, vcu, G;
    template <typename T> __device__ __forceinline__ T* p(size_t off) const { return (T*)(ws + off); }
};

template <int XM> __device__ __forceinline__ float swz_xor(float v) { return __builtin_bit_cast(float, __builtin_amdgcn_ds_swizzle(__builtin_bit_cast(int, v), (XM << 10) | 0x1f)); }
__device__ __forceinline__ float wave_sum(float v) {
    v += swz_xor<1>(v); v += swz_xor<2>(v); v += swz_xor<4>(v); v += swz_xor<8>(v); v += swz_xor<16>(v);
    { auto rr = __builtin_amdgcn_permlane32_swap(__float_as_uint(v), __float_as_uint(v), false, false); v = __uint_as_float(rr[0]) + __uint_as_float(rr[1]); }
    return v;
}
__device__ __forceinline__ float sin_turns(float x) { return __builtin_amdgcn_sinf(x); }
__device__ __forceinline__ float cos_turns(float x) { return __builtin_amdgcn_cosf(x); }
constexpr float INV_2PI = 0.15915494309189535f;
__device__ __forceinline__ float bf2f(unsigned short h) { return __uint_as_float((unsigned)h << 16); }
__device__ __forceinline__ void unpack8(const v4u w, float (&f)[8]) {
    f[0] = __uint_as_float(w.x << 16); f[1] = __uint_as_float(w.x & 0xffff0000u); f[2] = __uint_as_float(w.y << 16); f[3] = __uint_as_float(w.y & 0xffff0000u);
    f[4] = __uint_as_float(w.z << 16); f[5] = __uint_as_float(w.z & 0xffff0000u); f[6] = __uint_as_float(w.w << 16); f[7] = __uint_as_float(w.w & 0xffff0000u);
}
__device__ __forceinline__ v4u pack8f(const float (&f)[8]) { v4u o; o.x = pk2(f[0], f[1]); o.y = pk2(f[2], f[3]); o.z = pk2(f[4], f[5]); o.w = pk2(f[6], f[7]); return o; }

__device__ __forceinline__ int maprow(int mode, int n) {
    if (mode == 1) return 256 * (n >> 7) + (n & 127);
    if (mode == 2) return 256 * (n >> 7) + 128 + (n & 127);
    if (mode == 3) { const int h = n / DQK, d = n % DQK; if (d < 64) return n; const int r = d - 64, j = r & 15, g = j >> 2, i = j & 3; return h * DQK + 64 + 8 * g + (r < 16 ? 0 : 4) + i; }
    if (mode == 4) { const int d = n & 127; if (d < 64) return n; const int c = d - 64; return (n & ~127) + 64 + (c & 1) * 32 + (c >> 1); }
    return n;
}
__device__ __forceinline__ void transpose_item(const float* W, int K, int N, bf16* WT, int mode, const float* kscale, LAS float* scr, int item, int lane) {
    const int nblk = N / 32, kb = item / nblk, nb = item % nblk, k0 = 64 * kb, n0 = 32 * nb;
    float wv[32];
#pragma unroll
    for (int i = 0; i < 32; ++i) { const int kk = 2 * i + (lane >> 5); wv[i] = __builtin_nontemporal_load(W + (size_t)(k0 + kk) * N + n0 + (lane & 31)); }
#pragma unroll
    for (int i = 0; i < 32; ++i) { const int kk = 2 * i + (lane >> 5); float v = wv[i]; if (kscale) v *= kscale[k0 + kk]; scr[kk * 33 + (lane & 31)] = v; }
    LDS_WAIT(); asm volatile("" ::: "memory");
    const int c = lane & 7;
#pragma unroll
    for (int j = 0; j < 4; ++j) { const int n = (lane >> 3) + 8 * j; const LAS float* s = scr + (8 * c) * 33 + n;
        v4u o; o.x = pk2(s[0 * 33], s[1 * 33]); o.y = pk2(s[2 * 33], s[3 * 33]); o.z = pk2(s[4 * 33], s[5 * 33]); o.w = pk2(s[6 * 33], s[7 * 33]);
        *(GAS v4u*)(WT + (size_t)maprow(mode, n0 + n) * K + k0 + 8 * c) = o; }
    LDS_WAIT(); asm volatile("" ::: "memory");
}
struct Cat { int count, per; const float* src; size_t sstride; int K, N; bf16* dst; size_t dstride; int mode; const float* ks; int kstride; };
struct ItemD { const float* W; bf16* WT; const float* ks; int K, N, mode, k0, n0; };
__device__ __forceinline__ void ti_load(const ItemD& d, float (&wv)[32], int lane) {
#pragma unroll
    for (int i = 0; i < 32; ++i) { const int kk = 2 * i + (lane >> 5); wv[i] = __builtin_nontemporal_load(d.W + (size_t)(d.k0 + kk) * d.N + d.n0 + (lane & 31)); }
}
__device__ __forceinline__ void ti_store(const ItemD& d, const float (&wv)[32], LAS float* scr, int lane) {
#pragma unroll
    for (int i = 0; i < 32; ++i) { const int kk = 2 * i + (lane >> 5); float v = wv[i]; if (d.ks) v *= d.ks[d.k0 + kk]; scr[kk * 33 + (lane & 31)] = v; }
    LDS_WAIT(); asm volatile("" ::: "memory");
    const int c = lane & 7;
#pragma unroll
    for (int j = 0; j < 4; ++j) { const int n = (lane >> 3) + 8 * j; const LAS float* s = scr + (8 * c) * 33 + n;
        v4u o; o.x = pk2(s[0 * 33], s[1 * 33]); o.y = pk2(s[2 * 33], s[3 * 33]); o.z = pk2(s[4 * 33], s[5 * 33]); o.w = pk2(s[6 * 33], s[7 * 33]);
        *(GAS v4u*)(d.WT + (size_t)maprow(d.mode, d.n0 + n) * d.K + d.k0 + 8 * c) = o; }
    LDS_WAIT(); asm volatile("" ::: "memory");
}
template <int CLO, int CHI> __device__ __forceinline__ void item_resolve(const Cat (&cats)[11], int it, ItemD& d) {
    int r = it;
#pragma unroll
    for (int k = CLO; k < CHI; ++k) { const int n = cats[k].count * cats[k].per;
        if (r >= 0 && r < n) { const int mi = r / cats[k].per, item = r % cats[k].per; const int nblk = cats[k].N / 32;
            d.W = cats[k].src + mi * cats[k].sstride; d.WT = cats[k].dst + mi * cats[k].dstride; d.ks = cats[k].ks ? cats[k].ks + mi * cats[k].kstride : nullptr;
            d.K = cats[k].K; d.N = cats[k].N; d.mode = cats[k].mode; d.k0 = 64 * (item / nblk); d.n0 = 32 * (item % nblk); }
        r -= n; }
}
template <int CLO, int CHI> __device__ __forceinline__ void convert_cats(const Ctx& F, int gw, int NGW, int lane) {
    LAS float* scr = (LAS float*)(F.lds + F.wave * 16384);
    const Cat cats[11] = {
        {DEPTH, 16 * 53, F.in(I_WIN), (size_t)D * 1696, D, 1696, F.p<bf16>(WS_WIN), (size_t)UW * D, 0, nullptr, 0},
        {DEPTH, 6 * 24, F.in(I_WUQ), (size_t)384 * 768, 384, 768, F.p<bf16>(WS_WUQ), (size_t)768 * 384, 3, F.in(I_QNG), 384},
        {DEPTH, 4 * 32, F.in(I_WUKV), (size_t)256 * 1024, 256, 1024, F.p<bf16>(WS_WUKV), (size_t)1024 * 256, 4, F.in(I_KVNG), 256},
        {DEPTH, 16 * 32, F.in(I_WOUT), (size_t)D * D, D, D, F.p<bf16>(WS_WOUT), (size_t)D * D, 0, nullptr, 0},
        {2, 16 * 88, F.in(I_FWG), (size_t)D * FF, D, FF, F.p<bf16>(WS_WGU), (size_t)2 * FF * D, 1, nullptr, 0},
        {2, 16 * 88, F.in(I_FWU), (size_t)D * FF, D, FF, F.p<bf16>(WS_WGU), (size_t)2 * FF * D, 2, nullptr, 0},
        {2, 44 * 32, F.in(I_FWD), (size_t)FF * D, FF, D, F.p<bf16>(WS_WD), (size_t)D * FF, 0, nullptr, 0},
        {2 * NEXP, 16 * 88, F.in(I_MWG), (size_t)D * FF, D, FF, F.p<bf16>(WS_MGU), (size_t)2 * FF * D, 1, nullptr, 0},
        {2 * NEXP, 16 * 88, F.in(I_MWU), (size_t)D * FF, D, FF, F.p<bf16>(WS_MGU), (size_t)2 * FF * D, 2, nullptr, 0},
        {2 * NEXP, 44 * 32, F.in(I_MWD), (size_t)FF * D, FF, D, F.p<bf16>(WS_MD), (size_t)D * FF, 0, nullptr, 0},
        {0, 1, nullptr, 0, 0, 0, nullptr, 0, 0, nullptr, 0}};
    int total = 0;
#pragma unroll
    for (int k = CLO; k < CHI; ++k) total += cats[k].count * cats[k].per;
    int it = 2 * gw; ItemD dA, dB, dC, dD; float wA[32], wB[32], wC[32], wD[32]; bool hA, hC;
#define CV_LD(X, Y) do { h##X = it < total; if (h##X) { item_resolve<CLO, CHI>(cats, it, d##X); ti_load(d##X, w##X, lane); item_resolve<CLO, CHI>(cats, it + 1, d##Y); ti_load(d##Y, w##Y, lane); } it += 2 * NGW; } while (0)
    CV_LD(A, B); CV_LD(C, D);
    while (hA) {
        ti_store(dA, wA, scr, lane); ti_store(dB, wB, scr, lane); CV_LD(A, B); if (!hC) break;
        ti_store(dC, wC, scr, lane); ti_store(dD, wD, scr, lane); CV_LD(C, D);
    }
#undef CV_LD
}
__device__ __forceinline__ void p0_prologue(const Ctx& F) {
    convert_cats<0, 3>(F, F.vcu * 8 + F.wave, F.G * 8, F.lane);
    const int gt = F.vcu * 512 + F.tid, NGT = F.G * 512;
    for (int i = gt; i < DEPTH * 96 * (D / 8); i += NGT) { const int l = i / (96 * (D / 8)), r = i % (96 * (D / 8)); *(GAS v4u*)(F.p<bf16>(WS_WIN) + ((size_t)l * UW + 1696) * D + (size_t)r * 8) = (v4u){0u, 0u, 0u, 0u}; }
    { const float* poolw = F.in(I_POOLW);
    for (int i = gt; i < DEPTH * 256 * 256; i += NGT) { const int l = i >> 16, n = (i >> 8) & 255, k = i & 255, g = n >> 6;
        const float v = (k >> 6) == g ? poolw[(((size_t)l * 4 + g) * 64 + (k & 63)) * 64 + (n & 63)] : 0.f; F.p<bf16>(WS_WPOOL)[i] = (bf16)f2bf(v); } }
    for (int i = gt; i < SEQ * 16; i += NGT) { const int t = i >> 4, j = i & 15; const int pos = j < 8 ? (t >> 6) : (t & 63);
        const float invf[8] = {1.0f, 0.31622776601683794f, 0.1f, 0.031622776601683791f, 0.01f, 0.0031622776601683794f, 0.001f, 0.00031622776601683794f};
        const float ang = (float)pos * invf[j & 7];
        const double tr = (double)ang * 0.15915494309189535; const float fr = (float)(tr - __builtin_floor(tr));
        F.p<float>(WS_ROPEC)[i] = cos_turns(fr); F.p<float>(WS_ROPES)[i] = sin_turns(fr); }
    { const GAS f32x4* s2 = (const GAS f32x4*)F.in(I_CTX); GAS f32x4* d2 = (GAS f32x4*)F.p<float>(WS_XC); for (int i = gt; i < NCTX * D / 4; i += NGT) d2[i] = s2[i]; }
    __syncthreads();
    LAS float* red = (LAS float*)F.lds;
    const float* cvec = F.in(I_C); const float* cctx = F.in(I_CCTX); const float* wada = F.in(I_WADA); const float* bada = F.in(I_BADA);
    LAS float* sl = (LAS float*)(F.lds + 8192);
    for (int i = F.tid; i < 3 * D; i += 512) { const float c0 = i < 2 * D ? cvec[i] : cctx[i - 2 * D]; sl[i] = c0 * __builtin_amdgcn_rcpf(1.f + __expf(-c0)); }
    __syncthreads();
    for (int it = F.vcu; it < DEPTH * 96; it += F.G) {
        const int l = it / 96, n = (it % 96) * 64 + F.lane; const float* W = wada + (size_t)l * D * 6 * D + n;
        float a0 = 0.f, a1 = 0.f, a2 = 0.f;
#pragma unroll 1
        for (int kb = 0; kb < 128; kb += 32) {
            float wv[32];
#pragma unroll
            for (int j = 0; j < 32; ++j) wv[j] = __builtin_nontemporal_load(W + (size_t)(F.wave * 128 + kb + j) * 6 * D);
#pragma unroll
            for (int j = 0; j < 32; ++j) { const int k = F.wave * 128 + kb + j; a0 += wv[j] * sl[k]; a1 += wv[j] * sl[D + k]; a2 += wv[j] * sl[2 * D + k]; }
        }
        red[(F.wave * 3 + 0) * 64 + F.lane] = a0; red[(F.wave * 3 + 1) * 64 + F.lane] = a1; red[(F.wave * 3 + 2) * 64 + F.lane] = a2;
        __syncthreads();
        if (F.tid < 192) { const int v = F.tid >> 6, ln = F.tid & 63; float s = 0.f;
#pragma unroll
            for (int w = 0; w < 8; ++w) s += red[(w * 3 + v) * 64 + ln];
            const int nn = (it % 96) * 64 + ln; F.p<float>(WS_MODS)[((size_t)l * 3 + v) * 6 * D + nn] = s + bada[(size_t)l * 6 * D + nn]; }
        __syncthreads();
    }
}

__device__ __forceinline__ void filter_tile(const Ctx& F, int l, int tile) {
    LAS float* feat = (LAS float*)F.lds;
    LAS float* h1 = feat + 64 * 33;
    constexpr int H2P = 65;
    LAS float* h2 = h1 + 64 * 64;
    const bool lat = tile < 256; const int L = lat ? SEQ : CTXL; const int p0 = (lat ? tile : tile - 256) * 64;
    const float invLm1 = 1.0f / (float)(L - 1), invL = 1.0f / (float)L;
    for (int idx = F.tid; idx < 64 * 33; idx += 512) { const int p = idx / 33, k = idx % 33; const float pos = (float)(p0 + p);
        float v;
        if (k == 0) v = pos * invLm1;
        else { const int j = (k - 1) & 15; const float fj = 1e-4f + (float)j * ((15.0f - 1e-4f) / 15.0f); const float x = fj * pos * invL; const float fr = x - __builtin_floorf(x);
            v = k <= 16 ? cos_turns(fr) : -sin_turns(fr); }
        feat[idx] = v; }
    __syncthreads();
    { const int j = F.tid & 63, pg = F.tid >> 6; const float* w1 = F.in(I_FW1) + (size_t)l * 33 * 64 + j; float w[33];
#pragma unroll
      for (int k = 0; k < 33; ++k) w[k] = w1[k * 64];
      const float b = F.in(I_FB1)[l * 64 + j], fq = F.in(I_FF1)[l * 64 + j];
#pragma unroll 1
      for (int pp = 0; pp < 8; ++pp) { const int p = pg * 8 + pp; float a = b;
#pragma unroll
          for (int k = 0; k < 33; ++k) a += feat[p * 33 + k] * w[k];
          const float x = fq * a * INV_2PI; h1[p * 64 + j] = sin_turns(x - __builtin_floorf(x)); } }
    __syncthreads();
    { const int j = F.tid & 63, pg = F.tid >> 6; const float* w2 = F.in(I_FW2) + (size_t)l * 64 * 64 + j; float w[64];
#pragma unroll
      for (int k = 0; k < 64; ++k) w[k] = w2[k * 64];
      const float b = F.in(I_FB2)[l * 64 + j], fq = F.in(I_FF2)[l * 64 + j];
#pragma unroll 1
      for (int pp = 0; pp < 8; ++pp) { const int p = pg * 8 + pp; float a = b;
#pragma unroll
          for (int k = 0; k < 64; ++k) a += h1[p * 64 + k] * w[k];
          const float x = fq * a * INV_2PI; h2[p * H2P + j] = sin_turns(x - __builtin_floorf(x)); } }
    __syncthreads();
    {
      typedef float f32x16v __attribute__((ext_vector_type(16)));
      const int r32 = F.lane & 31, hi = F.lane >> 5;
      const float* w3 = F.in(I_FW3) + (size_t)l * 64 * 512 + F.wave * 64 + r32 + hi * 512;
      const LAS float* ha = h2 + r32 * H2P + hi;
      f32x16v acc[2][2] = {};
      float wb0[32], wb1[32];
#pragma unroll
      for (int s2 = 0; s2 < 32; ++s2) { wb0[s2] = w3[(size_t)(2 * s2) * 512]; wb1[s2] = w3[(size_t)(2 * s2) * 512 + 32]; }
#pragma unroll
      for (int s2 = 0; s2 < 32; ++s2) {
          const float a0 = ha[2 * s2], a1 = ha[32 * H2P + 2 * s2], b0 = wb0[s2], b1 = wb1[s2];
          acc[0][0] = __builtin_amdgcn_mfma_f32_32x32x2f32(a0, b0, acc[0][0], 0, 0, 0); acc[0][1] = __builtin_amdgcn_mfma_f32_32x32x2f32(a0, b1, acc[0][1], 0, 0, 0);
          acc[1][0] = __builtin_amdgcn_mfma_f32_32x32x2f32(a1, b0, acc[1][0], 0, 0, 0); acc[1][1] = __builtin_amdgcn_mfma_f32_32x32x2f32(a1, b1, acc[1][1], 0, 0, 0); }
      LAS float* T = h2 + 64 * H2P;
      float* dst = lat ? F.p<float>(WS_HF) + p0 : F.p<float>(WS_HFC) + p0; const int pitch = lat ? SEQ : CTXL;
      float asum[2] = {0.f, 0.f};
#pragma unroll
      for (int pb = 0; pb < 2; ++pb) {
#pragma unroll
          for (int cb = 0; cb < 2; ++cb) { const int n = F.wave * 64 + 32 * cb + r32, c = n & 255; const float dl = 3.0701134573253946f + (float)c * ((15.350567286626973f - 3.0701134573253946f) / 255.0f);
#pragma unroll
              for (int r = 0; r < 16; ++r) { const int pq = (r & 3) + 8 * (r >> 2) + 4 * hi, p = 32 * pb + pq; const float tt = (float)(p0 + p) * invLm1; const float v = acc[pb][cb][r] * __expf(-tt * dl);
                  T[n * 33 + pq] = v; if (!(n >= 256 && p0 + p == 0)) asum[cb] += __builtin_fabsf(v); } }
          __syncthreads();
#pragma unroll 4
          for (int i = 0; i < 32; ++i) { const int row = F.wave * 64 + 2 * i + (F.lane >> 5), pl = F.lane & 31; dst[(size_t)row * pitch + pb * 32 + pl] = T[row * 33 + pl]; }
          __syncthreads(); }
#pragma unroll
      for (int cb = 0; cb < 2; ++cb) { auto rr = __builtin_amdgcn_permlane32_swap(__float_as_uint(asum[cb]), __float_as_uint(asum[cb]), false, false); const float tot = __uint_as_float(rr[0]) + __uint_as_float(rr[1]);
          if (hi == 0) F.p<float>(WS_FPART)[(size_t)tile * 512 + F.wave * 64 + 32 * cb + r32] = tot; } }
    __syncthreads();
}

template <int WHICH, bool COMBINE, bool ROUTE, bool FROM_INPUT = false, int NSLAB = 0  >
__device__ __forceinline__ void norm_phase(const Ctx& F, int l, int lprev  , int moe_idx  ) {
    const float* xin = FROM_INPUT ? F.in(I_X) : nullptr;
    const int gw = F.vcu * 8 + F.wave, NGW = F.G * 8;
    const float* gain = WHICH == 0 ? F.in(I_N1G) + l * D : WHICH == 1 ? F.in(I_N2G) + l * D : F.in(I_FING);
    const float* mods = F.p<float>(WS_MODS) + (size_t)l * 3 * 6 * D;
    const float* modp = F.p<float>(WS_MODS) + (size_t)lprev * 3 * 6 * D + 5 * D;
    const int rows = WHICH == 2 ? LAT : MT;
    LAS float* wr_l = (LAS float*)F.lds;
    LAS int* lcnt = (LAS int*)(F.lds + 32768);
    LAS int* rec = (LAS int*)(F.lds + 32768 + 64);
    if (ROUTE) {
        const float* wr = F.in(I_ROUTER) + (size_t)moe_idx * D * NEXP;
        for (int i = F.tid; i < D * NEXP / 4; i += 512) ((LAS f32x4*)wr_l)[i] = ((const f32x4*)wr)[i];
        if (F.tid < 16) lcnt[F.tid] = 0;
        __syncthreads();
    }
    int ri = 0;
    int nd0 = 0, nd1 = 0; float ng0 = 0.f, ng1 = 0.f;
    if (COMBINE && gw < rows) { nd0 = F.p<int>(WS_TOKP)[2 * gw]; nd1 = F.p<int>(WS_TOKP)[2 * gw + 1]; ng0 = F.p<float>(WS_TOKG)[2 * gw]; ng1 = F.p<float>(WS_TOKG)[2 * gw + 1]; }
    f32x4 vn[4];
    const bf16* xbf = (const bf16*)F.out;
#define NRM_LOAD(r) do { const int r_ = (r); if ((FROM_INPUT && r_ < LAT) || r_ >= LAT) { const float* xs_ = (FROM_INPUT && r_ < LAT) ? xin + (size_t)r_ * D : F.p<float>(WS_XC) + (size_t)(r_ - LAT) * D; \
        _Pragma("unroll") for (int j = 0; j < 4; ++j) vn[j] = ((const GAS f32x4*)xs_)[F.lane + 64 * j]; } \
      else { const bf16* xs_ = xbf + (size_t)r_ * (2 * D); \
        _Pragma("unroll") for (int j = 0; j < 4; ++j) { const v2u w_ = ((const GAS v2u*)xs_)[F.lane + 64 * j]; vn[j] = (f32x4){__uint_as_float(w_.x), __uint_as_float(w_.y), 0.f, 0.f}; } } } while (0)
#define NRM_UNPACK(r, V) do { const int r_ = (r); if (!((FROM_INPUT && r_ < LAT) || r_ >= LAT)) { _Pragma("unroll") for (int j = 0; j < 4; ++j) { const unsigned a_ = __float_as_uint(V[j].x), b_ = __float_as_uint(V[j].y); \
        V[j] = (f32x4){__uint_as_float(a_ << 16), __uint_as_float(a_ & 0xffff0000u), __uint_as_float(b_ << 16), __uint_as_float(b_ & 0xffff0000u)}; } } } while (0)
    if (gw < rows) NRM_LOAD(gw);
    for (int row = gw; row < rows; row += NGW, ++ri) {
        const int vsel = row < SEQ ? 0 : (row < LAT ? 1 : 2);
        float* xr = row < LAT ? F.out + (size_t)row * D : F.p<float>(WS_XC) + (size_t)(row - LAT) * D;
        bf16* xrb = (bf16*)F.out + (size_t)row * (2 * D);
        f32x4 v[4];
#pragma unroll
        for (int j = 0; j < 4; ++j) v[j] = vn[j];
        NRM_UNPACK(row, v);
        if (NSLAB > 0 && row >= LAT) { const float* sl = F.p<float>(WS_SLAB) + (size_t)(row - LAT) * D;
#pragma unroll
            for (int k = 0; k < NSLAB; ++k)
#pragma unroll
                for (int j = 0; j < 4; ++j) v[j] = v[j] + ((const GAS f32x4*)(sl + (size_t)k * NCTX * D))[F.lane + 64 * j];
#pragma unroll
            for (int j = 0; j < 4; ++j) ((GAS f32x4*)xr)[F.lane + 64 * j] = v[j]; }
        if (COMBINE) {
            const int d0 = nd0, d1 = nd1; const float g0 = ng0, g1 = ng1;
            if (row + NGW < rows) { const int rn = row + NGW; nd0 = F.p<int>(WS_TOKP)[2 * rn]; nd1 = F.p<int>(WS_TOKP)[2 * rn + 1]; ng0 = F.p<float>(WS_TOKG)[2 * rn]; ng1 = F.p<float>(WS_TOKG)[2 * rn + 1]; }
            const bf16* y0 = F.p<bf16>(WS_XS) + (size_t)d0 * D, *y1 = F.p<bf16>(WS_XS) + (size_t)d1 * D;
#pragma unroll
            for (int j = 0; j < 4; ++j) { const int col = 4 * F.lane + 256 * j; const uint2 a = *(const uint2*)(y0 + col), b = *(const uint2*)(y1 + col); const f32x4 m5 = *(const f32x4*)(modp + vsel * 6 * D + col);
                f32x4 ya = {__uint_as_float(a.x << 16), __uint_as_float(a.x & 0xffff0000u), __uint_as_float(a.y << 16), __uint_as_float(a.y & 0xffff0000u)};
                f32x4 yb = {__uint_as_float(b.x << 16), __uint_as_float(b.x & 0xffff0000u), __uint_as_float(b.y << 16), __uint_as_float(b.y & 0xffff0000u)};
                v[j] = v[j] + m5 * (ya * g0 + yb * g1);
                if (WHICH != 2) { if (row < LAT) ((GAS v2u*)xrb)[F.lane + 64 * j] = (v2u){pk2(v[j].x, v[j].y), pk2(v[j].z, v[j].w)}; else ((GAS f32x4*)xr)[F.lane + 64 * j] = v[j]; } }
        }
        float s = 0.f;
#pragma unroll
        for (int j = 0; j < 4; ++j) s += (v[j].x * v[j].x + v[j].y * v[j].y) + (v[j].z * v[j].z + v[j].w * v[j].w);
        const float* sh = mods + vsel * 6 * D + (WHICH == 0 ? 0 : 3) * D; const float* sc = sh + D;
        f32x4 gv[4], av[4], bv[4];
#pragma unroll
        for (int j = 0; j < 4; ++j) { const int col = 4 * F.lane + 256 * j; gv[j] = *(const f32x4*)(gain + col); if (WHICH != 2) { av[j] = *(const f32x4*)(sh + col); bv[j] = *(const f32x4*)(sc + col); } }
        asm volatile("" ::: "memory");
        if (row + NGW < rows) NRM_LOAD(row + NGW);
        asm volatile("" ::: "memory");
        const float rstd = 1.0f / sqrtf(wave_sum(s) * (1.0f / D) + 1e-6f);
        if (WHICH == 2) {
#pragma unroll
            for (int j = 0; j < 4; ++j) { const f32x4 g = gv[j]; ((GAS f32x4*)xr)[F.lane + 64 * j] = v[j] * rstd * g; }
        } else {
            bf16* hn = F.p<bf16>(WS_HN) + (size_t)row * D;
            float lg[8] = {0.f, 0.f, 0.f, 0.f, 0.f, 0.f, 0.f, 0.f};
#pragma unroll
            for (int j = 0; j < 4; ++j) { const int col = 4 * F.lane + 256 * j; const f32x4 g = gv[j], a = av[j], b = bv[j];
                const f32x4 h = v[j] * rstd * g * (b + 1.0f) + a;
                *(uint2*)(hn + col) = make_uint2(pk2(h.x, h.y), pk2(h.z, h.w));
                if (ROUTE) {
#pragma unroll
                    for (int q = 0; q < 4; ++q) { const f32x4 w0 = *(const LAS f32x4*)(wr_l + (col + q) * 8), w1 = *(const LAS f32x4*)(wr_l + (col + q) * 8 + 4);
                        lg[0] += h[q] * w0.x; lg[1] += h[q] * w0.y; lg[2] += h[q] * w0.z; lg[3] += h[q] * w0.w; lg[4] += h[q] * w1.x; lg[5] += h[q] * w1.y; lg[6] += h[q] * w1.z; lg[7] += h[q] * w1.w; } } }
            if (ROUTE) {
#pragma unroll
                for (int e = 0; e < 8; ++e) lg[e] = wave_sum(lg[e]);
                int e0 = 0; float v0 = lg[0];
#pragma unroll
                for (int e = 1; e < 8; ++e) if (lg[e] > v0) { v0 = lg[e]; e0 = e; }
                int e1 = -1; float v1 = -3.0e38f;
#pragma unroll
                for (int e = 0; e < 8; ++e) if (e != e0 && lg[e] > v1) { v1 = lg[e]; e1 = e; }
                const float g1 = 1.0f / (1.0f + __expf(v0 - v1)), g0 = 1.0f - g1;
                if (F.lane == 0) { const int p0 = __hip_atomic_fetch_add(lcnt + e0, 1, __ATOMIC_RELAXED, __HIP_MEMORY_SCOPE_WORKGROUP), p1 = __hip_atomic_fetch_add(lcnt + e1, 1, __ATOMIC_RELAXED, __HIP_MEMORY_SCOPE_WORKGROUP);
                    LAS int* rc = rec + (F.wave * 20 + ri) * 3; rc[0] = e0 | (e1 << 8); rc[1] = p0; rc[2] = p1;
                    F.p<float>(WS_TOKG)[2 * row] = g0; F.p<float>(WS_TOKG)[2 * row + 1] = g1; }
            }
        }
    }
    if (ROUTE) {
        __syncthreads();
        if (F.tid < 8) lcnt[8 + F.tid] = (int)__hip_atomic_fetch_add(F.p<unsigned>(WS_CTL) + CW_GCNT + 64 * (8 * moe_idx + F.tid), (unsigned)lcnt[F.tid], __ATOMIC_RELAXED, __HIP_MEMORY_SCOPE_AGENT);
        __syncthreads();
        if (F.lane == 0) { int k = 0; for (int row = gw; row < rows; row += NGW, ++k) { const LAS int* rc = rec + (F.wave * 20 + k) * 3; const int ee = rc[0], e0 = ee & 255, e1 = ee >> 8;
            F.p<int>(WS_TOKE)[row] = ee; F.p<int>(WS_TOKP)[2 * row] = lcnt[8 + e0] + rc[1]; F.p<int>(WS_TOKP)[2 * row + 1] = lcnt[8 + e1] + rc[2]; } }
        __syncthreads();
    }
}
__device__ __forceinline__ void moe_tile_starts(const Ctx& F, int moe_idx, int (&ts)[9]) {
    int acc = 0;
#pragma unroll
    for (int e = 0; e < 8; ++e) { ts[e] = acc; const unsigned c = (unsigned)__builtin_amdgcn_readfirstlane((int)__hip_atomic_load(F.p<unsigned>(WS_CTL) + CW_GCNT + 64 * (8 * moe_idx + e), __ATOMIC_RELAXED, __HIP_MEMORY_SCOPE_AGENT)); acc += (int)((c + 255u) >> 8); }
    ts[8] = acc;
}
__device__ __forceinline__ void moe_scatter(const Ctx& F, int moe_idx) {
    int ts[9]; moe_tile_starts(F, moe_idx, ts);
    const int gw = F.vcu * 8 + F.wave, NGW = F.G * 8;
    for (int row0 = gw; row0 < MT; row0 += 4 * NGW) {
        int ee[4], p0[4], p1[4]; bool ok[4];
#pragma unroll
        for (int q = 0; q < 4; ++q) { const int row = row0 + q * NGW; ok[q] = row < MT; const int r = ok[q] ? row : row0; ee[q] = F.p<int>(WS_TOKE)[r]; p0[q] = F.p<int>(WS_TOKP)[2 * r]; p1[q] = F.p<int>(WS_TOKP)[2 * r + 1]; }
        v4u a[4], b[4]; int d0[4], d1[4];
#pragma unroll
        for (int q = 0; q < 4; ++q) { const int row = ok[q] ? row0 + q * NGW : row0; const GAS v4u* src = (const GAS v4u*)(F.p<bf16>(WS_HN) + (size_t)row * D); a[q] = src[F.lane]; b[q] = src[64 + F.lane];
            const int e0 = ee[q] & 255, e1 = ee[q] >> 8; int s0 = 0, s1 = 0;
#pragma unroll
            for (int e = 0; e < 8; ++e) { s0 = e == e0 ? ts[e] : s0; s1 = e == e1 ? ts[e] : s1; }
            d0[q] = s0 * 256 + p0[q]; d1[q] = s1 * 256 + p1[q]; }
#pragma unroll
        for (int q = 0; q < 4; ++q) if (ok[q]) { const int row = row0 + q * NGW;
            GAS v4u* o0 = (GAS v4u*)(F.p<bf16>(WS_XS) + (size_t)d0[q] * D); GAS v4u* o1 = (GAS v4u*)(F.p<bf16>(WS_XS) + (size_t)d1[q] * D);
            o0[F.lane] = a[q]; o0[64 + F.lane] = b[q]; o1[F.lane] = a[q]; o1[64 + F.lane] = b[q];
            if (F.lane == 0) { F.p<int>(WS_TOKP)[2 * row] = d0[q]; F.p<int>(WS_TOKP)[2 * row + 1] = d1[q]; } }
    }
}
struct TileInfo { int r0, b, t0, L; bool lat; };
__device__ __forceinline__ TileInfo tile_info(int T) {
    TileInfo ti; ti.lat = T < 512;
    if (ti.lat) { ti.r0 = T * 64; ti.b = T >> 8; ti.t0 = (T & 255) * 64; ti.L = SEQ; }
    else { const int rc = (T - 512) * 64; ti.r0 = LAT + rc; ti.b = rc >> 8; ti.t0 = rc & 255; ti.L = CTXL; }
    return ti;
}
__device__ __forceinline__ void sconv8(const bf16* Urow0  , int t, int L, int col, const float* sw, const float* sb, float (&o)[8]) {
    float a[8], b[8], c[8];
    const v4u z = {0u, 0u, 0u, 0u};
    const v4u um = t > 0 ? *(const GAS v4u*)(Urow0 + (size_t)(t - 1) * UW + col) : z;
    const v4u u0 = *(const GAS v4u*)(Urow0 + (size_t)t * UW + col);
    const v4u up = t + 1 < L ? *(const GAS v4u*)(Urow0 + (size_t)(t + 1) * UW + col) : z;
    unpack8(um, a); unpack8(u0, b); unpack8(up, c);
    const f32x4 w0a = *(const f32x4*)(sw + col), w0b = *(const f32x4*)(sw + col + 4), w1a = *(const f32x4*)(sw + 768 + col), w1b = *(const f32x4*)(sw + 768 + col + 4),
                w2a = *(const f32x4*)(sw + 1536 + col), w2b = *(const f32x4*)(sw + 1536 + col + 4), ba = *(const f32x4*)(sb + col), bb = *(const f32x4*)(sb + col + 4);
#pragma unroll
    for (int i = 0; i < 4; ++i) { o[i] = a[i] * w0a[i] + b[i] * w1a[i] + c[i] * w2a[i] + ba[i]; o[4 + i] = a[4 + i] * w0b[i] + b[4 + i] * w1b[i] + c[4 + i] * w2b[i] + bb[i]; }
}
__device__ __forceinline__ void prep_item(const Ctx& F, const bf16* Us, int t, int L, int row, int j, const float* sw, const float* sb, float (&z)[8]) {
    float x1[8], vv[8]; sconv8(Us, t, L, C_HY + 256 + 8 * j, sw, sb, x1); sconv8(Us, t, L, C_HY + 512 + 8 * j, sw, sb, vv);
#pragma unroll
    for (int q = 0; q < 8; ++q) z[q] = x1[q] * vv[q];
}
template <int HALF> __device__ __forceinline__ void pool_item(const Ctx& F, const bf16* Us, int t, int L, int row, int col  , int dcol) {
    v4u w[2 * HALF];
#pragma unroll
    for (int k = 0; k < 2 * HALF; ++k) { int s = t - HALF + k; s = s < 0 ? 0 : (s >= L ? L - 1 : s); w[k] = *(const GAS v4u*)(Us + (size_t)s * UW + col); }
    float acc[8] = {0.f, 0.f, 0.f, 0.f, 0.f, 0.f, 0.f, 0.f}, pt[8];
#pragma unroll
    for (int k = 0; k < 2 * HALF; ++k) { const int s = t - HALF + k; const float m = (s >= 0 && s < L) ? 1.0f : 0.0f; float f[8]; unpack8(w[k], f);
#pragma unroll
        for (int q = 0; q < 8; ++q) acc[q] += m * f[q]; }
    unpack8(w[HALF], pt);
    const int lo = t - HALF < 0 ? 0 : t - HALF, hi = t + HALF > L ? L : t + HALF; const float inv = 1.0f / (float)(hi - lo);
#pragma unroll
    for (int q = 0; q < 8; ++q) acc[q] = acc[q] * inv - pt[q];
    *(GAS v4u*)(F.p<bf16>(WS_DP) + (size_t)row * 256 + dcol) = pack8f(acc);
}
__device__ __forceinline__ void pool_item_g(const Ctx& F, int g, const bf16* Us, int t, int L, int row, int chunk  ) {
    const int dcol = 64 * g + 8 * chunk, col = C_POOL + dcol;
    if (g == 0) pool_item<1>(F, Us, t, L, row, col, dcol); else if (g == 1) pool_item<2>(F, Us, t, L, row, col, dcol); else if (g == 2) pool_item<4>(F, Us, t, L, row, col, dcol); else pool_item<8>(F, Us, t, L, row, col, dcol);
}
__device__ __forceinline__ void prep_row(const Ctx& F, int row, int t, int b, bool lat) {
    const bf16* ur = F.p<bf16>(WS_U) + (size_t)row * UW;
    float sq = 0.f, skv = 0.f;
    if (F.lane < 48) { float f[8]; unpack8(*(const GAS v4u*)(ur + C_CQ + 8 * F.lane), f);
#pragma unroll
        for (int q = 0; q < 8; ++q) sq += f[q] * f[q]; }
    if (F.lane < 32) { float f[8]; unpack8(*(const GAS v4u*)(ur + C_CKV + 8 * F.lane), f);
#pragma unroll
        for (int q = 0; q < 8; ++q) skv += f[q] * f[q]; }
    sq = wave_sum(sq); skv = wave_sum(skv);
    if (F.lane == 0) { F.p<float>(WS_RSQ)[row] = 1.0f / sqrtf(sq * (1.0f / 384.0f) + 1e-6f); F.p<float>(WS_RSKV)[row] = 1.0f / sqrtf(skv * (1.0f / 256.0f) + 1e-6f); }
    if (F.lane < 16) { const int h = F.lane >> 1, i = F.lane & 1; float x1[8], x2[8];
        unpack8(*(const GAS v4u*)(ur + C_KPE + 8 * i), x1); unpack8(*(const GAS v4u*)(ur + C_KPE + 16 + 8 * i), x2);
        if (lat) { const float* cp = F.p<float>(WS_ROPEC) + t * 16 + 8 * i; const float* sp = F.p<float>(WS_ROPES) + t * 16 + 8 * i;
#pragma unroll
            for (int q = 0; q < 8; ++q) { const float c = cp[q], s = sp[q], a = x1[q] * c - x2[q] * s, bb = x1[q] * s + x2[q] * c; x1[q] = a; x2[q] = bb; } }
        const float o0[8] = {x1[0], x1[1], x1[2], x1[3], x2[0], x2[1], x2[2], x2[3]}, o1[8] = {x1[4], x1[5], x1[6], x1[7], x2[4], x2[5], x2[6], x2[7]};
        const int key = lat ? CTXL + t : t;
        bf16* dst = F.p<bf16>(WS_KV) + ((size_t)(b * NHEAD + h) * NKEY + key) * KVW + 64 + 16 * i;
        *(GAS v4u*)dst = pack8f(o0); *(GAS v4u*)(dst + 8) = pack8f(o1); }
}
__device__ __forceinline__ void prep_phase(const Ctx& F, int l) {
    LAS float* zs = (LAS float*)F.lds;
    const bf16* U = F.p<bf16>(WS_U);
    const float* sw = F.in(I_HSW) + (size_t)l * 3 * 768; const float* sb = F.in(I_HSB) + (size_t)l * 768;
    for (int T = F.vcu; T < LAT / 64; T += F.G) {
        const TileInfo ti = tile_info(T); const bf16* Us = U + (size_t)(ti.r0 - ti.t0) * UW;
#pragma unroll
        for (int i = 0; i < 4; ++i) { const int item = F.tid + 512 * i, tl = item >> 5, j = item & 31; float z[8];
            prep_item(F, Us, ti.t0 + tl, ti.L, ti.r0 + tl, j, sw, sb, z);
#pragma unroll
            for (int q = 0; q < 8; ++q) zs[tl * 257 + 8 * j + q] = z[q]; }
        { const int g = F.wave & 3, chunk = F.lane & 7;
#pragma unroll 1
          for (int i = 0; i < 4; ++i) { const int tl = 32 * (F.wave >> 2) + 8 * i + (F.lane >> 3); pool_item_g(F, g, Us, ti.t0 + tl, ti.L, ti.r0 + tl, chunk); } }
#pragma unroll 2
        for (int rr = 0; rr < 8; ++rr) { const int tl = F.wave * 8 + rr; prep_row(F, ti.r0 + tl, ti.t0 + tl, ti.b, true); }
        __syncthreads();
        { float* zt = F.p<float>(WS_ZT) + (size_t)ti.b * 256 * SEQ + ti.t0;
#pragma unroll 8
          for (int cc = 0; cc < 32; ++cc) { const int c = F.wave * 32 + cc; zt[(size_t)c * SEQ + F.lane] = zs[F.lane * 257 + c]; } }
        __syncthreads();
    }
    for (int P = F.vcu; P < NCTX / 2; P += F.G) {
        const int rc = 2 * P, b = rc >> 8, t0 = rc & (CTXL - 1); const bf16* Us = U + (size_t)(LAT + b * CTXL) * UW;
        if (F.wave == 0) { const int tl = F.lane >> 5, j = F.lane & 31, t = t0 + tl; float z[8];
            prep_item(F, Us, t, CTXL, LAT + rc + tl, j, sw, sb, z);
            float* zc = F.p<float>(WS_ZCT) + ((size_t)b * 256 + 8 * j) * CTXL + t;
#pragma unroll
            for (int q = 0; q < 8; ++q) zc[(size_t)q * CTXL] = z[q]; }
        else if (F.wave <= 2) { const int tl = F.wave - 1; prep_row(F, LAT + rc + tl, t0 + tl, b, false); }
        else if (F.wave == 3) { const int tl = F.lane >> 5, j = F.lane & 31; pool_item_g(F, j >> 3, Us, t0 + tl, CTXL, LAT + rc + tl, j & 7); }
    }
}
__device__ __forceinline__ void hyena_finalize(const Ctx& F, int l) {
    LAS float* ys = (LAS float*)F.lds;
    const bf16* U = F.p<bf16>(WS_U);
    const float* sw = F.in(I_HSW) + (size_t)l * 3 * 768; const float* sb = F.in(I_HSB) + (size_t)l * 768;
    for (int T = F.vcu; T < MT / 64; T += F.G) {
        const TileInfo ti = tile_info(T); const bf16* Us = U + (size_t)(ti.r0 - ti.t0) * UW;
        { const float* zt = ti.lat ? F.p<float>(WS_YT) + (size_t)ti.b * 256 * SEQ + ti.t0 : F.p<float>(WS_ZCT) + (size_t)ti.b * 256 * CTXL + ti.t0; const int pitch = ti.lat ? SEQ : CTXL;
#pragma unroll 8
          for (int cc = 0; cc < 32; ++cc) { const int c = F.wave * 32 + cc; ys[F.lane * 257 + c] = zt[(size_t)c * pitch + F.lane]; } }
        __syncthreads();
#pragma unroll
        for (int i = 0; i < 4; ++i) { const int item = F.tid + 512 * i, tl = item >> 5, j = item & 31, t = ti.t0 + tl;
            float x0[8]; sconv8(Us, t, ti.L, C_HY + 8 * j, sw, sb, x0);
#pragma unroll
            for (int q = 0; q < 8; ++q) x0[q] *= ys[tl * 257 + 8 * j + q];
            *(GAS v4u*)(F.p<bf16>(WS_MIX) + (size_t)(ti.r0 + tl) * D + 8 * j) = pack8f(x0); }
        __syncthreads();
    }
}

typedef float c32 __attribute__((ext_vector_type(2)));
__device__ __forceinline__ c32 cmul(c32 a, c32 b) { return (c32){a.x * b.x - a.y * b.y, a.x * b.y + a.y * b.x}; }
__device__ __forceinline__ c32 cis_turns(float x) { return (c32){cos_turns(x), sin_turns(x)}; }
constexpr int FN = SEQ;
template <int Q, bool INV> __device__ __forceinline__ void fft_stage(LAS c32* X, int tid) {
    asm volatile("" : "+v"(tid));
    constexpr float invLs = (INV ? 1.0f : -1.0f) / (float)(4 * Q);
#pragma unroll 4
    for (int it = 0; it < 8; ++it) { const int i = tid + 512 * it, j = i & (Q - 1), base = ((i - j) << 2) + j;
        c32 w1, w2, w3;
        if (Q > 1) { w1 = cis_turns((float)j * invLs); w2 = cmul(w1, w1); w3 = cmul(w2, w1); }
        if (!INV) {
            const c32 a0 = X[base], a1 = X[base + Q], a2 = X[base + 2 * Q], a3 = X[base + 3 * Q];
            const c32 t0 = a0 + a2, t1 = a0 - a2, t2 = a1 + a3, t3 = a1 - a3;
            const c32 b0 = t0 + t2, b2 = t0 - t2, b1 = (c32){t1.x + t3.y, t1.y - t3.x}, b3 = (c32){t1.x - t3.y, t1.y + t3.x};
            X[base] = b0;
            if (Q > 1) { X[base + Q] = cmul(b1, w1); X[base + 2 * Q] = cmul(b2, w2); X[base + 3 * Q] = cmul(b3, w3); } else { X[base + Q] = b1; X[base + 2 * Q] = b2; X[base + 3 * Q] = b3; }
        } else {
            c32 a0 = X[base], a1 = X[base + Q], a2 = X[base + 2 * Q], a3 = X[base + 3 * Q];
            if (Q > 1) { a1 = cmul(a1, w1); a2 = cmul(a2, w2); a3 = cmul(a3, w3); }
            const c32 t0 = a0 + a2, t1 = a0 - a2, t2 = a1 + a3, t3 = a1 - a3;
            X[base] = t0 + t2; X[base + 2 * Q] = t0 - t2; X[base + Q] = (c32){t1.x - t3.y, t1.y + t3.x}; X[base + 3 * Q] = (c32){t1.x + t3.y, t1.y - t3.x};
        } }
    __syncthreads();
}
__device__ __forceinline__ void fft_fwd(LAS c32* X, int tid) {
    fft_stage<4096, false>(X, tid); fft_stage<1024, false>(X, tid); fft_stage<256, false>(X, tid); fft_stage<64, false>(X, tid); fft_stage<16, false>(X, tid); fft_stage<4, false>(X, tid); fft_stage<1, false>(X, tid);
}
__device__ __forceinline__ void fft_inv(LAS c32* X, int tid) {
    fft_stage<1, true>(X, tid); fft_stage<4, true>(X, tid); fft_stage<16, true>(X, tid); fft_stage<64, true>(X, tid); fft_stage<256, true>(X, tid); fft_stage<1024, true>(X, tid); fft_stage<4096, true>(X, tid);
}
__device__ __forceinline__ void hyena_fft_channel(const Ctx& F, int l, int c) {
    LAS c32* X = (LAS c32*)F.lds; const int tid = F.tid;
    const float* hf = F.p<float>(WS_HF) + (size_t)c * SEQ + tid; const float* hb = F.p<float>(WS_HF) + (size_t)(256 + c) * SEQ + SEQ - tid;
    const float* z0 = F.p<float>(WS_ZT) + (size_t)c * SEQ + tid; const float* z1 = z0 + (size_t)256 * SEQ;
    float* y0 = F.p<float>(WS_YT) + (size_t)c * SEQ + tid; float* y1 = y0 + (size_t)256 * SEQ;
    float nrm = 0.f; { const float* fp = F.p<float>(WS_FPART);
#pragma unroll
        for (int k = 0; k < 4; ++k) { const int tile = F.lane + 64 * k; nrm += fp[(size_t)tile * 512 + c] + fp[(size_t)tile * 512 + 256 + c]; }
        nrm = wave_sum(nrm); }
    const float scale = 1.0f / (nrm * 2.0f * (float)FN); const float bias = F.in(I_HBIAS)[l * 256 + c];
    c32 G[32];
#pragma unroll 1
    for (int pass = 0; pass < 2; ++pass) {
        const float sgn = pass == 0 ? 1.0f : -1.0f; const float tw = pass == 0 ? 0.0f : -1.0f / 32768.0f;
#pragma unroll 1
        for (int kb = 0; kb < 32; kb += 8) { float fa[8], fb[8];
#pragma unroll
            for (int q = 0; q < 8; ++q) { fa[q] = hf[512 * (kb + q)]; fb[q] = hb[-512 * (kb + q)]; }
#pragma unroll
            for (int q = 0; q < 8; ++q) { const int n = tid + 512 * (kb + q); const float g = fa[q] + sgn * (n > 0 ? fb[q] : 0.f); X[n] = cis_turns((float)n * tw) * g; } }
        __syncthreads(); fft_fwd(X, tid);
#pragma unroll
        for (int k = 0; k < 32; ++k) G[k] = X[tid + 512 * k];
        __syncthreads();
#pragma unroll 1
        for (int kb = 0; kb < 32; kb += 8) { float ua[8], ub[8];
#pragma unroll
            for (int q = 0; q < 8; ++q) { ua[q] = z0[512 * (kb + q)]; ub[q] = z1[512 * (kb + q)]; }
#pragma unroll
            for (int q = 0; q < 8; ++q) { const int n = tid + 512 * (kb + q); const c32 u = {ua[q], ub[q]}; X[n] = cmul(u, cis_turns((float)n * tw)); } }
        __syncthreads(); fft_fwd(X, tid);
#pragma unroll
        for (int k = 0; k < 32; ++k) { const int n = tid + 512 * k; X[n] = cmul(X[n], G[k]); if ((k & 7) == 7) asm volatile("" ::: "memory"); }
        __syncthreads(); fft_inv(X, tid);
        if (pass == 0) {
#pragma unroll 1
            for (int kb = 0; kb < 32; kb += 8) { float ua[8], ub[8];
#pragma unroll
                for (int q = 0; q < 8; ++q) { ua[q] = z0[512 * (kb + q)]; ub[q] = z1[512 * (kb + q)]; }
#pragma unroll
                for (int q = 0; q < 8; ++q) { const c32 y = X[tid + 512 * (kb + q)] * scale; y0[512 * (kb + q)] = y.x + bias * ua[q]; y1[512 * (kb + q)] = y.y + bias * ub[q]; } }
        } else {
#pragma unroll 1
            for (int kb = 0; kb < 32; kb += 8) { float ya[8], yb[8];
#pragma unroll
                for (int q = 0; q < 8; ++q) { ya[q] = y0[512 * (kb + q)]; yb[q] = y1[512 * (kb + q)]; }
#pragma unroll
                for (int q = 0; q < 8; ++q) { const int n = tid + 512 * (kb + q); const c32 y = cmul(X[n], cis_turns((float)n * (1.0f / 32768.0f))) * scale; y0[512 * (kb + q)] = ya[q] + y.x; y1[512 * (kb + q)] = yb[q] + y.y; } }
        }
        __syncthreads();
    }
}
__device__ __forceinline__ void hyena_ctx_item(const Ctx& F, int l, int item) {
    LAS float* zs = (LAS float*)F.lds;
    LAS float* fs = zs + 256 * 32;
    LAS float* nr = fs + 511 * 32;
    const int b = item >> 3, c0 = (item & 7) * 32; float* zc = F.p<float>(WS_ZCT) + ((size_t)b * 256 + c0) * CTXL;
#pragma unroll 8
    for (int i = F.tid; i < 32 * 256; i += 512) { const int c = i >> 8, s = i & 255; zs[s * 32 + c] = zc[(size_t)c * CTXL + s]; }
#pragma unroll 8
    for (int i = F.tid; i < 32 * 511; i += 512) { const int c = i / 511, lg = i % 511 - 255;
        fs[(lg + 255) * 32 + c] = lg >= 0 ? F.p<float>(WS_HFC)[(size_t)(c0 + c) * CTXL + lg] : F.p<float>(WS_HFC)[(size_t)(256 + c0 + c) * CTXL - lg]; }
    if (F.tid < 32) { float s = 0.f; for (int tl = 256; tl < 260; ++tl) s += F.p<float>(WS_FPART)[(size_t)tl * 512 + c0 + F.tid] + F.p<float>(WS_FPART)[(size_t)tl * 512 + 256 + c0 + F.tid]; nr[F.tid] = 1.0f / s; }
    __syncthreads();
    const int c = F.tid & 31, tg = F.tid >> 5; const float bias = F.in(I_HBIAS)[l * 256 + c0 + c];
    float acc[16];
#pragma unroll
    for (int i = 0; i < 16; ++i) acc[i] = 0.f;
#pragma unroll 1
    for (int sb = 0; sb < 16; ++sb) { float w[31];
        const int lag0 = 16 * tg - (16 * sb + 15);
#pragma unroll
        for (int k = 0; k < 31; ++k) w[k] = fs[(lag0 + k + 255) * 32 + c];
#pragma unroll
        for (int ss = 0; ss < 16; ++ss) { const float zv = zs[(16 * sb + ss) * 32 + c];
#pragma unroll
            for (int i = 0; i < 16; ++i) acc[i] += zv * w[i - ss + 15]; } }
    const float inv = nr[c];
    float outv[16];
#pragma unroll
    for (int i = 0; i < 16; ++i) outv[i] = acc[i] * inv + bias * zs[(16 * tg + i) * 32 + c];
    __syncthreads();
#pragma unroll
    for (int i = 0; i < 16; ++i) zc[(size_t)c * CTXL + 16 * tg + i] = outv[i];
    __syncthreads();
}
#ifndef MK_PER_PHASE
#define MK_PER_PHASE 0
#endif
#ifndef MK_EN
#define MK_EN 0xFFFFFFFFu
#endif
#define EN(k) (((MK_EN) >> (k)) & 1u)
#ifndef MK_DUP
#define MK_DUP 0u
#endif
#define REP(k) _Pragma("unroll 1") for (int rep_ = 0; rep_ < ((((MK_DUP) >> (k)) & 1u) ? 2 : 1); ++rep_)
#ifdef ATT_USE_PP
#define ATT_MAIN(q, k, o, s, l, t) att::attn_unit_pp(q, k, o, s, (att::lds_u8*)l, t)
#define ATT_PROBE(q, k, o, s, l, t) att::attn_unit_pp<PROBE_ATT>(q, k, o, s, (att::lds_u8*)l, t)
#else
#define ATT_MAIN(q, k, o, s, l, t) att::attn_unit<true>(q, k, o, s, (char*)l, t)
#define ATT_PROBE(q, k, o, s, l, t) att::attn_unit<true, PROBE_ATT>(q, k, o, s, (char*)l, t)
#endif
constexpr int N_PHASES = 1 + 2 * 9 + 2 * 12 + 1;

__global__ void __launch_bounds__(512, 2) mk_fwd(Args args) {
    extern __shared__ __attribute__((aligned(16))) unsigned char lds[];
    Ctx F0;
    F0.out = args.out; F0.ws = args.ws; F0.lds = (LAS unsigned char*)lds; F0.MISC = (volatile LAS unsigned*)(F0.lds + MISC_OFF);
    F0.tid = threadIdx.x; F0.lane = F0.tid & 63; F0.wave = __builtin_amdgcn_readfirstlane(F0.tid >> 6);
    F0.G = gridDim.x; { const int bx = blockIdx.x; F0.vcu = (F0.G % 8 == 0) ? (bx % 8) * (F0.G / 8) + bx / 8 : bx; }
#define PHASE_CTX() Ctx F = F0; { unsigned m_ = ~0u; int w_ = F0.wave, v_ = F0.vcu; unsigned wl_ = (unsigned)(uintptr_t)F0.ws, wh_ = (unsigned)((uintptr_t)F0.ws >> 32), ol_ = (unsigned)(uintptr_t)F0.out, oh_ = (unsigned)((uintptr_t)F0.out >> 32); \
        asm volatile("" : "+s"(m_), "+s"(w_), "+s"(v_), "+s"(wl_), "+s"(wh_), "+s"(ol_), "+s"(oh_)); \
        F.lane = (int)__builtin_amdgcn_mbcnt_hi(m_, __builtin_amdgcn_mbcnt_lo(m_, 0u)); F.wave = w_; F.tid = w_ * 64 + F.lane; F.vcu = v_;     \
        F.ws = (unsigned char*)(GAS unsigned char*)(((uintptr_t)wh_ << 32) | wl_); F.out = (float*)(GAS float*)(((uintptr_t)oh_ << 32) | ol_); }
    { Ctx& F = F0;
    for (int u = F.tid; u < (LDS_BYTES - RING_BYTES) / 4; u += 512) ((LAS unsigned*)(F.lds + RING_BYTES))[u] = 0u;
    __syncthreads(); }
    gu32* ctl = (gu32*)(args.ws + WS_CTL);
    XcdBarrier bar = xcd_barrier_post((unsigned*)(ctl + CW_BAR), F0.MISC + 8);
    const int lo = args.ph_lo, hi = args.ph_hi; int pid = 0;
#define RUN() (lo <= pid && pid < hi)
#define SEAM() do { if (pid + 1 < hi) { unsigned ms_ = ~0u; asm volatile("" : "+s"(ms_)); xcd_barrier(bar, F.wave == 0 && __builtin_amdgcn_mbcnt_hi(ms_, __builtin_amdgcn_mbcnt_lo(ms_, 0u)) == 0u); } } while (0)
    LAS unsigned char* ring = F0.lds;
    LAS int* tsl = (LAS int*)(F0.lds + MISC_OFF + 64);
    const int bid = (int)blockIdx.x;

    if (RUN()) { PHASE_CTX(); if (EN(0)) REP(0) p0_prologue(F); SEAM(); } ++pid;

#pragma unroll 1
    for (int l = 0; l < DEPTH; ++l) {
        const bool moe = (l & 1) != 0; const int mi = l >> 1;
        if (RUN()) { PHASE_CTX();
            if (EN(1)) REP(1) for (int tile = F.vcu; tile < 256; tile += F.G) filter_tile(F, l, tile);
            if (EN(19)) REP(19) { if (l == 0) norm_phase<0, false, false, true>(F, 0, 0, 0); else if ((l - 1) & 1) norm_phase<0, true, false>(F, l, l - 1, 0); else norm_phase<0, false, false, false, 2>(F, l, 0, 0); }
            SEAM(); } ++pid;
        if (RUN()) { PHASE_CTX(); if (EN(2)) REP(2) {
            pg8::Gemm g{F.p<bf16>(WS_HN), F.p<bf16>(WS_WIN) + (size_t)l * UW * D, MT, UW, D, D, D}; pg8::StaticOrder S; S.init(MT, UW, F.G, bid);
            pg8::EpiBf16<0> E{F.p<bf16>(WS_U), UW, nullptr, 0, 0, 1.f};
            pg8::gemm_phase<pg8::EpiBf16<0>, pg8::StaticOrder, true, true>(ring, g, S, E, F.tid); }
            if (EN(1)) for (int tile = 256 + (F.G - 1 - bid); tile < NFT; tile += F.G) filter_tile(F, l, tile);
            SEAM(); } ++pid;
        if (RUN()) { PHASE_CTX(); if (EN(3)) REP(3) prep_phase(F, l); SEAM(); } ++pid;
        if (RUN()) { PHASE_CTX();
            if (EN(4)) REP(4) for (int c = F.vcu; c < 256; c += F.G) hyena_fft_channel(F, l, c);
            if (EN(5)) REP(5) for (int it = bid - 8; it >= 0 && it < 2 * 8; it += F.G) hyena_ctx_item(F, l, it);
            if (EN(6)) REP(6) { pg8::Gemm g{F.p<bf16>(WS_U) + C_CQ, F.p<bf16>(WS_WUQ) + (size_t)l * 768 * 384, MT, 768, 384, UW, 384}; pg8::StaticOrder S; S.init(MT, 768, F.G, (bid + F.G / 2) % F.G);
              pg8::EpiQRope E{F.p<bf16>(WS_Q), F.p<float>(WS_RSQ), F.p<float>(WS_ROPEC), F.p<float>(WS_ROPES)};
              pg8::gemm_phase<pg8::EpiQRope, pg8::StaticOrder, true, true>(ring, g, S, E, F.tid); }
            if (EN(7)) REP(7) { pg8::Gemm g{F.p<bf16>(WS_U) + C_CKV, F.p<bf16>(WS_WUKV) + (size_t)l * 1024 * 256, MT, 1024, 256, UW, 256}; pg8::StaticOrder S; S.init(MT, 1024, F.G, bid);
              pg8::EpiKV E{F.p<bf16>(WS_KV), F.p<float>(WS_RSKV)};
              pg8::gemm_phase<pg8::EpiKV, pg8::StaticOrder, true, true>(ring, g, S, E, F.tid); }
            if (EN(8)) REP(8) { pg8::Gemm g{F.p<bf16>(WS_DP), F.p<bf16>(WS_WPOOL) + (size_t)l * 256 * 256, MT, 256, 256, 256, 256}; pg8::StaticOrder S; S.init(MT, 256, F.G, F.G - 1 - bid);
              pg8::EpiColScale E{F.p<bf16>(WS_MIX) + 256, D, F.in(I_POOLS) + l * 256};
              pg8::gemm_phase<pg8::EpiColScale, pg8::StaticOrder, true, true>(ring, g, S, E, F.tid); }
            SEAM(); } ++pid;
        if (RUN()) { PHASE_CTX();
            if (EN(9)) REP(9) hyena_finalize(F, l);
#if ATT_W64
            if (EN(10)) REP(10) for (int u = F.vcu, uidx = 0; u < 512 + 16; u += F.G, ++uidx) {
                int b, h, row0, seq, nh;
                if (u < 512) { const int pair = u >> 5, qb = u & 31; b = pair >> 3; h = pair & 7; row0 = b * SEQ + qb * 512; seq = NKEY; nh = 2; }
                else { const int pair = u - 512; b = pair >> 3; h = pair & 7; row0 = LAT + b * CTXL; seq = CTXL; nh = 1; }
                const bf16* qp = F.p<bf16>(WS_Q) + (size_t)row0 * 768 + h * DQK; const bf16* kvp = F.p<bf16>(WS_KV) + (size_t)(b * NHEAD + h) * KV_HEAD_STRIDE; bf16* op = F.p<bf16>(WS_MIX) + (size_t)row0 * D + 512 + h * DV;
                unsigned mk_ = ~0u; asm volatile("" : "+s"(mk_)); const int tf = F.wave * 64 + (int)__builtin_amdgcn_mbcnt_hi(mk_, __builtin_amdgcn_mbcnt_lo(mk_, 0u));
                if (!(u < 512 && att::attn_unit_w64(qp, kvp, op, seq, (att::lds_u8*)lds, tf))) {
#pragma unroll 1
                    for (int hf = 0; hf < nh; ++hf) { unsigned mk2_ = ~0u; asm volatile("" : "+s"(mk2_)); const int ts = F.wave * 64 + (int)__builtin_amdgcn_mbcnt_hi(mk2_, __builtin_amdgcn_mbcnt_lo(mk2_, 0u));
                        att::attn_unit<false>(qp + (size_t)hf * 256 * 768, kvp, op + (size_t)hf * 256 * D, seq, (char*)lds, ts); } }
                if (l == 0 && uidx == ((F.vcu >> 5) & 1)) { unsigned mk3_ = ~0u; asm volatile("" : "+s"(mk3_)); const int ln3 = (int)__builtin_amdgcn_mbcnt_hi(mk3_, __builtin_amdgcn_mbcnt_lo(mk3_, 0u)); int gw3 = F.vcu * 8 + F.wave; asm volatile("" : "+s"(gw3)); convert_cats<3, 10>(F, gw3, F.G * 8, ln3); __syncthreads(); }
            }
#else
            if (EN(10)) REP(10) for (int u = F.vcu, uidx = 0; u < 1024 + 16; u += F.G, ++uidx) {
                int b, h, row0, seq;
                if (u < 1024) { const int pair = u >> 6, qb = u & 63; b = pair >> 3; h = pair & 7; row0 = b * SEQ + qb * 256; seq = NKEY; }
                else { const int pair = u - 1024; b = pair >> 3; h = pair & 7; row0 = LAT + b * CTXL; seq = CTXL; }
                const bf16* qp = F.p<bf16>(WS_Q) + (size_t)row0 * 768 + h * DQK; const bf16* kvp = F.p<bf16>(WS_KV) + (size_t)(b * NHEAD + h) * KV_HEAD_STRIDE; bf16* op = F.p<bf16>(WS_MIX) + (size_t)row0 * D + 512 + h * DV;
                unsigned mk_ = ~0u; asm volatile("" : "+s"(mk_)); const int tf = F.wave * 64 + (int)__builtin_amdgcn_mbcnt_hi(mk_, __builtin_amdgcn_mbcnt_lo(mk_, 0u));
                if (!ATT_MAIN(qp, kvp, op, seq, lds, tf)) { unsigned mk2_ = ~0u; asm volatile("" : "+s"(mk2_)); const int ts = F.wave * 64 + (int)__builtin_amdgcn_mbcnt_hi(mk2_, __builtin_amdgcn_mbcnt_lo(mk2_, 0u)); att::attn_unit<false>(qp, kvp, op, seq, (char*)lds, ts); }
                if (l == 0 && uidx == ((F.vcu >> 6) & 3)) { unsigned mk3_ = ~0u; asm volatile("" : "+s"(mk3_)); const int ln3 = (int)__builtin_amdgcn_mbcnt_hi(mk3_, __builtin_amdgcn_mbcnt_lo(mk3_, 0u)); int gw3 = F.vcu * 8 + F.wave; asm volatile("" : "+s"(gw3)); convert_cats<3, 10>(F, gw3, F.G * 8, ln3); __syncthreads(); }
            }
#endif
#ifdef PROBE_ATT
            for (int u = F.vcu; u < 1024; u += F.G) { const int pair = u >> 6, qb = u & 63; const int b = pair >> 3, h = pair & 7, row0 = b * SEQ + qb * 256;
                const bf16* qp = F.p<bf16>(WS_Q) + (size_t)row0 * 768 + h * DQK; const bf16* kvp = F.p<bf16>(WS_KV) + (size_t)(b * NHEAD + h) * KV_HEAD_STRIDE; bf16* op = (bf16*)F.p<float>(WS_ZT) + (size_t)(row0 & 8191) * D + h * DV;
                unsigned mk_ = ~0u; asm volatile("" : "+s"(mk_)); const int tf = F.wave * 64 + (int)__builtin_amdgcn_mbcnt_hi(mk_, __builtin_amdgcn_mbcnt_lo(mk_, 0u));
                ATT_PROBE(qp, kvp, op, NKEY, lds, tf); }
#endif
            SEAM(); } ++pid;
        if (RUN()) { PHASE_CTX(); if (EN(11)) REP(11) {
            pg8::Gemm g{F.p<bf16>(WS_MIX), F.p<bf16>(WS_WOUT) + (size_t)l * D * D, LAT, D, D, D, D}; pg8::StaticOrder S; S.init(LAT, D, F.G, bid);
            pg8::EpiResGate E{l == 0 ? F.in(I_X) : nullptr, (unsigned short*)F.out, F.p<float>(WS_MODS) + (size_t)l * 3 * 6 * D + 2 * D};
            pg8::gemm_phase<pg8::EpiResGate, pg8::StaticOrder, true, true>(ring, g, S, E, F.tid);
            { pg8::Gemm gc{F.p<bf16>(WS_MIX), F.p<bf16>(WS_WOUT) + (size_t)l * D * D, NCTX, D, D / 4, D, D}; pg8::CtxSplitOrder<4> Sc{F.G, bid, D / 4};
              pg8::EpiCtxSlab Ec{F.p<float>(WS_SLAB), F.p<float>(WS_MODS) + (size_t)l * 3 * 6 * D + 2 * D, D / 4};
              pg8::gemm_phase<pg8::EpiCtxSlab, pg8::CtxSplitOrder<4>, true, true>(ring, gc, Sc, Ec, F.tid); } }
            SEAM(); } ++pid;
        if (RUN()) { PHASE_CTX(); if (EN(12)) REP(12) { if (moe) norm_phase<1, false, true, false, 4>(F, l, 0, mi); else norm_phase<1, false, false, false, 4>(F, l, 0, 0); }   SEAM(); } ++pid;
        if (!moe) {
            if (RUN()) { PHASE_CTX(); if (EN(13)) REP(13) {
                pg8::Gemm g{F.p<bf16>(WS_HN), F.p<bf16>(WS_WGU) + (size_t)mi * 2 * FF * D, MT, 2 * FF, D, D, D}; pg8::StaticOrder S; S.init(MT, 2 * FF, F.G, bid);
                pg8::EpiSwiGLU E{F.p<bf16>(WS_H)};
                pg8::gemm_phase<pg8::EpiSwiGLU, pg8::StaticOrder, true, true>(ring, g, S, E, F.tid); }
                SEAM(); } ++pid;
            if (RUN()) { PHASE_CTX(); if (EN(14)) REP(14) {
                pg8::Gemm g{F.p<bf16>(WS_H), F.p<bf16>(WS_WD) + (size_t)mi * D * FF, LAT, D, FF, FF, FF}; pg8::StaticOrder S; S.init(LAT, D, F.G, bid);
                pg8::EpiResGate E{nullptr, (unsigned short*)F.out, F.p<float>(WS_MODS) + (size_t)l * 3 * 6 * D + 5 * D};
                pg8::gemm_phase<pg8::EpiResGate, pg8::StaticOrder, true, true>(ring, g, S, E, F.tid);
                { pg8::Gemm gc{F.p<bf16>(WS_H), F.p<bf16>(WS_WD) + (size_t)mi * D * FF, NCTX, D, FF / 2, FF, FF}; pg8::CtxSplitOrder<2> Sc{F.G, bid, FF / 2};
                  pg8::EpiCtxSlab Ec{F.p<float>(WS_SLAB), F.p<float>(WS_MODS) + (size_t)l * 3 * 6 * D + 5 * D, FF / 2};
                  pg8::gemm_phase<pg8::EpiCtxSlab, pg8::CtxSplitOrder<2>, true, true>(ring, gc, Sc, Ec, F.tid); } }
                SEAM(); } ++pid;
        } else {
            if (RUN()) { PHASE_CTX(); if (EN(15)) REP(15) moe_scatter(F, mi); SEAM(); } ++pid;
#pragma unroll 1
            for (int ch = 0; ch < 2; ++ch) {
                int ts[9]; { PHASE_CTX(); moe_tile_starts(F, mi, ts); }
                const int Tn = ts[8] < XS_TILES ? ts[8] : XS_TILES, Th = Tn < MOE_CHUNK0 ? Tn : MOE_CHUNK0; const int t0 = ch == 0 ? 0 : Th, nt = ch == 0 ? Th : Tn - Th;
                bf16* hs = F0.p<bf16>(WS_HS) - (size_t)t0 * 256 * FF;
                if (RUN()) { PHASE_CTX(); if (EN(16)) REP(16) {
                    if (F.tid == 0) {
#pragma unroll
                        for (int e = 0; e < 9; ++e) tsl[e] = ts[e]; }
                    __syncthreads();
                    pg8::Gemm g{F.p<bf16>(WS_XS), F.p<bf16>(WS_MGU) + (size_t)mi * NEXP * 2 * FF * D, 0, 0, D, D, D}; pg8::MoeOrder<NJ_GU> S{t0, nt, F.G, bid, tsl};
                    pg8::EpiSwiGLU E{hs};
                    pg8::gemm_phase<pg8::EpiSwiGLU, pg8::MoeOrder<NJ_GU>, true, true>(ring, g, S, E, F.tid); }
                    SEAM(); } ++pid;
                if (RUN()) { PHASE_CTX(); if (EN(17)) REP(17) {
                    if (F.tid == 0) {
#pragma unroll
                        for (int e = 0; e < 9; ++e) tsl[e] = ts[e]; }
                    __syncthreads();
                    pg8::Gemm g{hs, F.p<bf16>(WS_MD) + (size_t)mi * NEXP * D * FF, 0, 0, FF, FF, FF}; pg8::MoeOrder<4> S{t0, nt, F.G, bid, tsl};
                    pg8::EpiBf16<0> E{F.p<bf16>(WS_XS), D, nullptr, D, 0, 1.f};
                    pg8::gemm_phase<pg8::EpiBf16<0>, pg8::MoeOrder<4>, true, true>(ring, g, S, E, F.tid); }
                    SEAM(); } ++pid;
            }
        }
    }
#ifdef PROBE_BARS
    if (RUN()) { PHASE_CTX(); for (int q_ = 0; q_ < 40; ++q_) { unsigned ms_ = ~0u; asm volatile("" : "+s"(ms_)); xcd_barrier(bar, F.wave == 0 && __builtin_amdgcn_mbcnt_hi(ms_, __builtin_amdgcn_mbcnt_lo(ms_, 0u)) == 0u); } }
#endif
    if (RUN()) { PHASE_CTX(); if (EN(18)) REP(18) norm_phase<2, true, false>(F, 0, DEPTH - 1, 0); } ++pid;
#undef RUN
#undef SEAM
}

extern "C" void kernel_launch(void* const* d_in, const int* in_sizes, int n_in, void* d_out, int out_size, void* d_ws, size_t ws_size, hipStream_t stream) {
    static int grid = 0;
    if (grid == 0) {
        if (n_in != 34 || in_sizes[0] != LAT * D || out_size != LAT * D || ws_size < WS_END) {
            fprintf(stderr, "kernel_launch: shape mismatch: n_in %d in0 %d out %d ws %zu (need %zu); nothing launched\n", n_in, n_in > 0 ? in_sizes[0] : -1, out_size, ws_size, (size_t)WS_END); grid = -1; return; }
        if (hipFuncSetAttribute((const void*)mk_fwd, hipFuncAttributeMaxDynamicSharedMemorySize, LDS_BYTES) != hipSuccess) { fprintf(stderr, "kernel_launch: hipFuncSetAttribute failed\n"); grid = -1; return; }
        int dev = 0, cus = 0; (void)hipGetDevice(&dev); (void)hipDeviceGetAttribute(&cus, hipDeviceAttributeMultiprocessorCount, dev);
        int per_cu = 0; (void)hipOccupancyMaxActiveBlocksPerMultiprocessor(&per_cu, (const void*)mk_fwd, 512, LDS_BYTES); (void)hipGetLastError();
        grid = (cus >= 256 && per_cu >= 1) ? 256 : (cus > 8 ? (cus / 8) * 8 : 8);
    }
    if (grid < 0) return;
    (void)hipMemsetAsync((char*)d_ws + WS_CTL, 0, CTL_BYTES, stream);
    Args a{};
    for (int i = 0; i < 34; ++i) a.in[i] = (const float*)d_in[i];
    a.out = (float*)d_out; a.ws = (unsigned char*)d_ws;
#if MK_PER_PHASE
    for (int p = 0; p < N_PHASES; ++p) { a.ph_lo = p; a.ph_hi = p + 1; hipLaunchKernelGGL(mk_fwd, dim3(grid), dim3(512), LDS_BYTES, stream, a); }
#else
    a.ph_lo = 0; a.ph_hi = N_PHASES; hipLaunchKernelGGL(mk_fwd, dim3(grid), dim3(512), LDS_BYTES, stream, a);
#endif
    const hipError_t le = hipPeekAtLastError();
    if (le != hipSuccess) fprintf(stderr, "kernel_launch: launch failed: %s\n", hipGetErrorName(le));
}
```
